# Optimizing an MI355X kernel written in HIP

```python
import math
import jax
import jax.numpy as jnp
from jax import lax
import numpy as np

D_MODEL = 2048
BATCH = 8
SEQ = 2048
DEPTH = 1

CTX_LEN = 256
GRID_W = 64
D_MIX = D_MODEL
MLSTM_WIDTH = D_MIX // 2
MLSTM_HEADS = 4
MLSTM_DV = MLSTM_WIDTH // MLSTM_HEADS
MLSTM_DQK = MLSTM_DV // 2
CHUNK = 64
CONV_K = 3
GATE_CAP = 15.0
S5_WIDTH = D_MIX - MLSTM_WIDTH
S5_GROUP_CH = 16
S5_GROUPS = S5_WIDTH // S5_GROUP_CH
S5_STATE = 64
N_EXPERTS = 32
TOP_K = 4
D_FF = D_MODEL
SWIGLU_LIMIT = 7.0
SWIGLU_ALPHA = 1.702
RMS_EPS = 1e-6

QK_W = MLSTM_HEADS * MLSTM_DQK
K0 = QK_W
V0 = 2 * QK_W
O0 = V0 + MLSTM_WIDTH
G0 = O0 + MLSTM_WIDTH
S0 = G0 + 4 * MLSTM_HEADS
D_IN = S0 + S5_WIDTH

kernel_name = 'hybrid_mlstm_s5_moe_diffusion_block'

F32 = jnp.float32


def rms_norm(x, g):
    xf = x.astype(F32)
    return xf * lax.rsqrt(jnp.mean(xf * xf, axis=-1, keepdims=True) + RMS_EPS) * g.astype(F32)


def modulation(cvec, w_ada, b_ada):
    mod = jax.nn.silu(cvec.astype(F32)) @ w_ada.astype(F32) + b_ada.astype(F32)
    return jnp.split(mod[..., None, :], 6, axis=-1)


def dwconv2d(t, w):
    return lax.conv_general_dilated(t, w[:, :, None, :], (1, 1), 'SAME',
                                    dimension_numbers=('NHWC', 'HWIO', 'NHWC'),
                                    feature_group_count=t.shape[-1])


def split_heads(t, d):
    b, l, _ = t.shape
    return t.reshape(b, l, -1, d).transpose(0, 2, 1, 3)


def prep_stream(u, rows, w_in, conv_qk, gate_bias):
    b, l, _ = u.shape
    z = u @ w_in.astype(F32)
    qk = dwconv2d(z[..., :V0].reshape(b, rows, l // rows, 2 * QK_W), conv_qk.astype(F32))
    qk = jax.nn.silu(qk.reshape(b, l, 2 * QK_W))
    q = split_heads(qk[..., :K0], MLSTM_DQK)
    k = split_heads(qk[..., K0:], MLSTM_DQK) * (MLSTM_DQK ** -0.5)
    v = split_heads(z[..., V0:O0], MLSTM_DV)
    o = z[..., O0:G0]
    gates = z[..., G0:S0] + gate_bias.astype(F32)
    gates = GATE_CAP * jnp.tanh(gates / GATE_CAP)
    gates = gates.reshape(b, l, 4, MLSTM_HEADS).transpose(2, 0, 3, 1)
    dirs = ((gates[0], jax.nn.log_sigmoid(gates[1])), (gates[2], jax.nn.log_sigmoid(gates[3])))
    s5_u = z[..., S0:]
    return q, k, v, o, dirs, s5_u


def _to_chunks(t, reverse):
    if reverse:
        t = jnp.flip(t, axis=2)
    b, h, l = t.shape[:3]
    return t.reshape((b, h, l // CHUNK, CHUNK) + t.shape[3:])


def _from_chunks(t, reverse):
    b, h, nc, kk = t.shape[:4]
    t = t.reshape((b, h, nc * kk) + t.shape[4:])
    return jnp.flip(t, axis=2) if reverse else t


def mlstm_states(k, v, ig, lf, state0, reverse):
    k, v, ig, lf = (_to_chunks(t, reverse) for t in (k, v, ig, lf))
    bcum = jnp.cumsum(lf, axis=-1)
    gtot = bcum[..., -1]
    a = gtot[..., None] - bcum + ig
    m_loc = jnp.max(a, axis=-1)
    wk = jnp.exp(a - m_loc[..., None])[..., None] * k
    c_loc = jnp.einsum('bhcsd,bhcsv->bhcdv', wk, v)
    n_loc = wk.sum(axis=3)

    def step(carry, inp):
        c_prev, n_prev, m_prev = carry
        c_l, n_l, m_l, g_c = inp
        m_new = jnp.maximum(g_c + m_prev, m_l)
        s_prev = jnp.exp(g_c + m_prev - m_new)
        s_loc = jnp.exp(m_l - m_new)
        c_new = s_prev[..., None, None] * c_prev + s_loc[..., None, None] * c_l
        n_new = s_prev[..., None] * n_prev + s_loc[..., None] * n_l
        return (c_new, n_new, m_new), (c_prev, n_prev, m_prev)

    xs = tuple(jnp.moveaxis(t, 2, 0) for t in (c_loc, n_loc, m_loc, gtot))
    final, entering = lax.scan(step, state0, xs)
    entering = tuple(jnp.moveaxis(t, 0, 2) for t in entering)
    return entering, final


def mlstm_outputs(q, k, v, ig, lf, entering, reverse):
    q, k, v, ig, lf = (_to_chunks(t, reverse) for t in (q, k, v, ig, lf))
    c0, n0, m0 = entering
    bcum = jnp.cumsum(lf, axis=-1)
    kk = q.shape[3]
    lower = jnp.tril(jnp.ones((kk, kk), dtype=bool))
    logd = jnp.where(lower, bcum[..., :, None] - bcum[..., None, :] + ig[..., None, :], -jnp.inf)
    inter = bcum + m0[..., None]
    m = jnp.maximum(inter, jnp.max(logd, axis=-1))
    w_inter = jnp.exp(inter - m)
    s = jnp.einsum('bhcjd,bhcsd->bhcjs', q, k) * jnp.exp(logd - m[..., None])
    num = (w_inter[..., None] * jnp.einsum('bhcjd,bhcdv->bhcjv', q, c0)
           + jnp.einsum('bhcjs,bhcsv->bhcjv', s, v))
    den = w_inter * jnp.einsum('bhcjd,bhcd->bhcj', q, n0) + s.sum(axis=-1)
    h = num / jnp.maximum(jnp.abs(den), jnp.exp(-m))[..., None]
    return _from_chunks(h, reverse)


def s5_discretize(lam_re, lam_im, log_dt, b_re, b_im):
    lam_re = jnp.minimum(lam_re.astype(F32), -1e-4)
    lam_im = lam_im.astype(F32)
    dt = jnp.exp(log_dt.astype(F32))[:, None]
    mag = jnp.exp(lam_re * dt)
    ang = lam_im * dt
    lb_re = mag * jnp.cos(ang)
    lb_im = mag * jnp.sin(ang)
    den = lam_re * lam_re + lam_im * lam_im
    nr = lb_re - 1.0
    coef_re = (nr * lam_re + lb_im * lam_im) / den
    coef_im = (lb_im * lam_re - nr * lam_im) / den
    b_re = b_re.astype(F32)
    b_im = b_im.astype(F32)
    bb_re = coef_re[..., None] * b_re - coef_im[..., None] * b_im
    bb_im = coef_re[..., None] * b_im + coef_im[..., None] * b_re
    return lb_re, lb_im, bb_re, bb_im


def _complex_affine_combine(e1, e2):
    a1r, a1i, b1r, b1i = e1
    a2r, a2i, b2r, b2i = e2
    return (a2r * a1r - a2i * a1i,
            a2r * a1i + a2i * a1r,
            a2r * b1r - a2i * b1i + b2r,
            a2r * b1i + a2i * b1r + b2i)


def s5_scan(u, disc, h0, reverse):
    lb_re, lb_im, bb_re, bb_im = disc
    h_re, h_im = h0
    bu_re = jnp.einsum('blgh,gph->blgp', u, bb_re)
    bu_im = jnp.einsum('blgh,gph->blgp', u, bb_im)
    first = -1 if reverse else 0
    bu_re = bu_re.at[:, first].add(lb_re * h_re - lb_im * h_im)
    bu_im = bu_im.at[:, first].add(lb_re * h_im + lb_im * h_re)
    seq = u.shape[1]
    a_re = jnp.broadcast_to(lb_re, (1, seq) + lb_re.shape)
    a_im = jnp.broadcast_to(lb_im, (1, seq) + lb_im.shape)
    _, _, x_re, x_im = lax.associative_scan(_complex_affine_combine, (a_re, a_im, bu_re, bu_im),
                                            reverse=reverse, axis=1)
    return x_re, x_im


def s5_readout(xs, c_re, c_im):
    x_re, x_im = xs
    y = (jnp.einsum('blgp,ghp->blgh', x_re, c_re.astype(F32))
         - jnp.einsum('blgp,ghp->blgh', x_im, c_im.astype(F32)))
    return y.reshape(y.shape[0], y.shape[1], -1)


def merge_groups(h, o, y, u_s5, head_g, s5_d, w_glu, w_out):
    b, nh, l, dv = h.shape
    h = rms_norm(h.transpose(0, 2, 1, 3), head_g.reshape(nh, dv)).reshape(b, l, nh * dv)
    h = h * jax.nn.sigmoid(o)
    s = jax.nn.gelu(y + s5_d.astype(F32) * u_s5)
    s = s * jax.nn.sigmoid(s @ w_glu.astype(F32))
    return jnp.concatenate([h, s], axis=-1) @ w_out.astype(F32)


def mixing(u_lat, u_ctx, ctx_out, w_in, conv_qk, gate_bias, head_g, lam_re, lam_im, log_dt,
           b_re, b_im, c_re, c_im, s5_d, w_glu, w_out):
    bsz, l_lat, _ = u_lat.shape
    l_ctx = u_ctx.shape[1]
    rows = l_lat // GRID_W
    ql, kl, vl, ol, gl, sl = prep_stream(u_lat, rows, w_in, conv_qk, gate_bias)
    qc, kc, vc, oc, gc, sc = prep_stream(u_ctx, 1, w_in, conv_qk, gate_bias)
    zero_mem = (jnp.zeros((bsz, MLSTM_HEADS, MLSTM_DQK, MLSTM_DV), F32),
                jnp.zeros((bsz, MLSTM_HEADS, MLSTM_DQK), F32),
                jnp.zeros((bsz, MLSTM_HEADS), F32))
    zero_ssm = (jnp.zeros((bsz, S5_GROUPS, S5_STATE), F32), jnp.zeros((bsz, S5_GROUPS, S5_STATE), F32))
    sl_g = sl.reshape(bsz, l_lat, S5_GROUPS, S5_GROUP_CH)
    sc_g = sc.reshape(bsz, l_ctx, S5_GROUPS, S5_GROUP_CH)
    h_lat, h_ctx, y_lat, y_ctx = 0.0, 0.0, 0.0, 0.0
    for d, rev in enumerate((False, True)):
        ig_c, lf_c = gc[d]
        ig_l, lf_l = gl[d]
        ent_c, fin_c = mlstm_states(kc, vc, ig_c, lf_c, zero_mem, rev)
        ent_l, _ = mlstm_states(kl, vl, ig_l, lf_l, fin_c, rev)
        h_lat = h_lat + mlstm_outputs(ql, kl, vl, ig_l, lf_l, ent_l, rev)
        disc = s5_discretize(lam_re[d], lam_im[d], log_dt[d], b_re[d], b_im[d])
        xc = s5_scan(sc_g, disc, zero_ssm, rev)
        end = 0 if rev else -1
        xl = s5_scan(sl_g, disc, (xc[0][:, end], xc[1][:, end]), rev)
        y_lat = y_lat + s5_readout(xl, c_re[d], c_im[d])
        if ctx_out:
            h_ctx = h_ctx + mlstm_outputs(qc, kc, vc, ig_c, lf_c, ent_c, rev)
            y_ctx = y_ctx + s5_readout(xc, c_re[d], c_im[d])
    out_lat = merge_groups(h_lat, ol, y_lat, sl, head_g, s5_d, w_glu, w_out)
    if not ctx_out:
        return out_lat, None
    out_ctx = merge_groups(h_ctx, oc, y_ctx, sc, head_g, s5_d, w_glu, w_out)
    return out_lat, out_ctx


def moe(u, w_router, b_router, w_gu, b_gu, w_down, b_down):
    bsz, l, d = u.shape
    t = u.reshape(bsz * l, d).astype(F32)
    logits = t @ w_router.astype(F32) + b_router.astype(F32)
    top_v, top_i = lax.top_k(logits, TOP_K)
    probs = jax.nn.softmax(top_v, axis=-1)
    comb = jnp.einsum('nk,nke->en', probs, jax.nn.one_hot(top_i, N_EXPERTS, dtype=F32))

    def expert(acc, e):
        wgu, bgu, wd, bd, ce = e
        gu = t @ wgu.astype(F32) + bgu.astype(F32)
        gate = jnp.minimum(gu[:, :D_FF], SWIGLU_LIMIT)
        up = jnp.clip(gu[:, D_FF:], -SWIGLU_LIMIT, SWIGLU_LIMIT)
        hid = (up + 1.0) * gate * jax.nn.sigmoid(SWIGLU_ALPHA * gate)
        return acc + ce[:, None] * (hid @ wd.astype(F32) + bd.astype(F32)), None

    out, _ = lax.scan(expert, jnp.zeros_like(t), (w_gu, b_gu, w_down, b_down, comb))
    return out.reshape(bsz, l, d)


def setup_inputs(seed: int = 0) -> dict:
    key = jax.random.key(seed)
    ks = jax.random.split(key, 32)
    H, G, P, HC, E = MLSTM_HEADS, S5_GROUPS, S5_STATE, S5_GROUP_CH, N_EXPERTS

    def nrm(k, shape, s):
        return jax.random.normal(k, shape, F32) * s

    gate_off = jnp.concatenate([jnp.zeros((H,), F32), jnp.linspace(3.0, 6.0, H, dtype=F32),
                                jnp.zeros((H,), F32), jnp.linspace(3.0, 6.0, H, dtype=F32)])
    return {
        'x': nrm(ks[0], (BATCH, SEQ, D_MODEL), 1.0),
        'c': nrm(ks[1], (BATCH, D_MODEL), 1.0),
        'ctx': nrm(ks[2], (BATCH, CTX_LEN, D_MODEL), 1.0),
        'c_ctx': nrm(ks[3], (D_MODEL,), 1.0),
        'w_ada': nrm(ks[4], (DEPTH, D_MODEL, 6 * D_MODEL), 0.5 * D_MODEL ** -0.5),
        'b_ada': nrm(ks[5], (DEPTH, 6 * D_MODEL), 0.02),
        'norm1_g': 1.0 + nrm(ks[6], (DEPTH, D_MODEL), 0.02),
        'w_in': nrm(ks[7], (DEPTH, D_MODEL, D_IN), D_MODEL ** -0.5),
        'conv_qk': nrm(ks[8], (DEPTH, CONV_K, CONV_K, 2 * QK_W), 1.0 / CONV_K),
        'mlstm_gate_bias': gate_off[None, :] + nrm(ks[9], (DEPTH, 4 * H), 0.1),
        'mlstm_head_g': 1.0 + nrm(ks[10], (DEPTH, MLSTM_WIDTH), 0.02),
        's5_lam_re': -0.5 + nrm(ks[11], (DEPTH, 2, G, P), 0.01),
        's5_lam_im': math.pi * jnp.arange(P, dtype=F32) + nrm(ks[12], (DEPTH, 2, G, P), 0.01),
        's5_log_dt': jax.random.uniform(ks[13], (DEPTH, 2, G), F32, math.log(1e-3), math.log(1e-1)),
        's5_b_re': nrm(ks[14], (DEPTH, 2, G, P, HC), HC ** -0.5),
        's5_b_im': nrm(ks[15], (DEPTH, 2, G, P, HC), HC ** -0.5),
        's5_c_re': nrm(ks[16], (DEPTH, 2, G, HC, P), (2 * P) ** -0.5),
        's5_c_im': nrm(ks[17], (DEPTH, 2, G, HC, P), (2 * P) ** -0.5),
        's5_d': nrm(ks[18], (DEPTH, S5_WIDTH), 1.0),
        's5_w_glu': nrm(ks[19], (DEPTH, S5_WIDTH, S5_WIDTH), S5_WIDTH ** -0.5),
        'w_out': nrm(ks[20], (DEPTH, D_MIX, D_MODEL), D_MIX ** -0.5),
        'norm2_g': 1.0 + nrm(ks[21], (DEPTH, D_MODEL), 0.02),
        'w_router': nrm(ks[22], (DEPTH, D_MODEL, E), D_MODEL ** -0.5),
        'b_router': nrm(ks[23], (DEPTH, E), 0.01),
        'w_gu': nrm(ks[24], (DEPTH, E, D_MODEL, 2 * D_FF), D_MODEL ** -0.5),
        'b_gu': nrm(ks[25], (DEPTH, E, 2 * D_FF), 0.01),
        'w_down': nrm(ks[26], (DEPTH, E, D_FF, D_MODEL), D_FF ** -0.5),
        'b_down': nrm(ks[27], (DEPTH, E, D_MODEL), 0.01),
        'final_g': 1.0 + nrm(ks[28], (D_MODEL,), 0.02),
    }


def reference(x, c, ctx, c_ctx, w_ada, b_ada, norm1_g, w_in, conv_qk, mlstm_gate_bias, mlstm_head_g,
              s5_lam_re, s5_lam_im, s5_log_dt, s5_b_re, s5_b_im, s5_c_re, s5_c_im, s5_d, s5_w_glu,
              w_out, norm2_g, w_router, b_router, w_gu, b_gu, w_down, b_down, final_g):
    x_lat = x.astype(F32)
    x_ctx = ctx.astype(F32)
    for layer in range(DEPTH):
        ctx_out = layer < DEPTH - 1
        sh1, sc1, g1, sh2, sc2, g2 = modulation(c, w_ada[layer], b_ada[layer])
        csh1, csc1, cg1, csh2, csc2, cg2 = modulation(c_ctx, w_ada[layer], b_ada[layer])
        u_lat = rms_norm(x_lat, norm1_g[layer]) * (1.0 + sc1) + sh1
        u_ctx = rms_norm(x_ctx, norm1_g[layer]) * (1.0 + csc1) + csh1
        m_lat, m_ctx = mixing(u_lat, u_ctx, ctx_out, w_in[layer], conv_qk[layer], mlstm_gate_bias[layer],
                              mlstm_head_g[layer], s5_lam_re[layer], s5_lam_im[layer], s5_log_dt[layer],
                              s5_b_re[layer], s5_b_im[layer], s5_c_re[layer], s5_c_im[layer], s5_d[layer],
                              s5_w_glu[layer], w_out[layer])
        x_lat = x_lat + g1 * m_lat
        x_lat = x_lat + g2 * moe(rms_norm(x_lat, norm2_g[layer]) * (1.0 + sc2) + sh2, w_router[layer],
                                 b_router[layer], w_gu[layer], b_gu[layer], w_down[layer], b_down[layer])
        if ctx_out:
            x_ctx = x_ctx + cg1 * m_ctx
            x_ctx = x_ctx + cg2 * moe(rms_norm(x_ctx, norm2_g[layer]) * (1.0 + csc2) + csh2, w_router[layer],
                                      b_router[layer], w_gu[layer], b_gu[layer], w_down[layer], b_down[layer])
    return rms_norm(x_lat, final_g).astype(x.dtype)
```

```cpp
#include <hip/hip_runtime.h>
#include <stdint.h>
#include <stdio.h>
#include <string.h>

#define LAS __attribute__((address_space(3)))
typedef unsigned short bf16_t;
typedef short bf16x8 __attribute__((ext_vector_type(8)));
typedef short s16x4 __attribute__((ext_vector_type(4)));
typedef float f32x4 __attribute__((ext_vector_type(4)));
typedef float f32x2 __attribute__((ext_vector_type(2)));
typedef unsigned u32x4 __attribute__((ext_vector_type(4)));
typedef unsigned u32x2 __attribute__((ext_vector_type(2)));

constexpr int D = 2048, NB = 8, SEQ = 2048, CTXL = 256;
constexpr int NLAT = NB * SEQ;
constexpr int NCTX = NB * CTXL;
constexpr int NTOK = NLAT + NCTX;
constexpr int DIN = 4112;
constexpr int NE = 32, TOPK = 4, DFF = 2048;
constexpr int NWG = 256, NTHR = 512;
constexpr int LDS_BYTES = 163840;
constexpr int MOE_ROWS = 73728;

constexpr size_t al256(size_t x) { return (x + 255) & ~(size_t)255; }
constexpr size_t WS_CTRL  = 0;
constexpr size_t CTRL_BYTES = 65536;
constexpr size_t CTRL_CNT = 16384;
constexpr size_t WS_MODP  = WS_CTRL + CTRL_BYTES;
constexpr size_t WS_MOD   = WS_MODP + (size_t)8 * 9 * 12288 * 4;
constexpr size_t WS_LB16  = WS_MOD + (size_t)9 * 12288 * 4;
constexpr size_t WS_WRT   = WS_LB16 + 65536;
constexpr size_t WS_WIN_T = WS_WRT + 262144;
constexpr size_t WS_WGLU_T = WS_WIN_T + (size_t)4096 * 2048 * 2;
constexpr size_t WS_WOUT_T = WS_WGLU_T + (size_t)1024 * 1024 * 2;
constexpr size_t WS_BTV   = WS_WOUT_T + (size_t)2048 * 2048 * 2;
constexpr size_t WS_BTY   = WS_BTV + (size_t)64 * 256 * 256 * 2;
constexpr size_t WS_U1    = WS_BTY + (size_t)64 * 256 * 512 * 2;
constexpr size_t WS_GATES = WS_U1 + (size_t)NTOK * 2048 * 2;
constexpr size_t WS_ZQK   = WS_GATES + (size_t)NTOK * 16 * 4;
constexpr size_t WS_QK    = WS_ZQK + (size_t)NTOK * 1024 * 2;
constexpr size_t WS_VBUF  = WS_QK + (size_t)NTOK * 1024 * 2;
constexpr size_t WS_OBUF  = WS_VBUF + (size_t)NTOK * 1024 * 2;
constexpr size_t WS_AS5   = WS_OBUF + (size_t)NLAT * 1024 * 2;
constexpr size_t WS_VS5   = WS_AS5 + (size_t)64 * 1280 * 512 * 2;
constexpr size_t WS_HBUF  = WS_VS5 + (size_t)64 * 1280 * 256 * 4;
constexpr size_t WS_SBUF  = WS_HBUF + (size_t)2 * NLAT * 1024 * 4;
constexpr size_t WS_CAT   = WS_SBUF + (size_t)NLAT * 1024 * 2;
constexpr size_t WS_X1    = WS_CAT + (size_t)NLAT * 2048 * 2;
constexpr size_t WS_U2    = WS_X1 + (size_t)NLAT * 2048 * 4;
constexpr size_t WS_TKE   = WS_U2 + (size_t)NLAT * 2048 * 2;
constexpr size_t WS_TKP   = WS_TKE + (size_t)NLAT * 16;
constexpr size_t WS_LIST  = WS_TKP + (size_t)NLAT * 16;
constexpr size_t WS_LPROB = WS_LIST + (size_t)32 * 16384 * 4;
constexpr size_t WS_HID   = WS_LPROB + (size_t)32 * 16384 * 4;
constexpr size_t WS_OUT2  = WS_HID + (size_t)MOE_ROWS * 2048 * 2;
constexpr size_t WS_WGU_T = WS_OUT2 + (size_t)MOE_ROWS * 2048 * 2;
constexpr size_t WS_WDN_T = WS_WGU_T + (size_t)32 * 4096 * 2048 * 2;
constexpr size_t WS_END   = WS_WDN_T + (size_t)32 * 2048 * 2048 * 2;

struct Params {
    const float *x, *c, *ctx, *c_ctx, *w_ada, *b_ada, *norm1_g, *w_in, *conv_qk, *gate_bias, *head_g,
                *lam_re, *lam_im, *log_dt, *b_re, *b_im, *c_re, *c_im, *s5_d, *w_glu, *w_out, *norm2_g,
                *w_router, *b_router, *w_gu, *b_gu, *w_down, *b_down, *final_g;
    float* out;
    unsigned char* ws;
};

__device__ __forceinline__ unsigned cvt_pk_bf16(float lo, float hi) { unsigned r; asm volatile("v_cvt_pk_bf16_f32 %0, %1, %2" : "=v"(r) : "v"(lo), "v"(hi)); return r; }
__device__ __forceinline__ bf16_t f2bf(float f) { return (bf16_t)(cvt_pk_bf16(f, 0.f) & 0xffffu); }
__device__ __forceinline__ float bf2f(bf16_t b) { return __uint_as_float(((unsigned)b) << 16); }
__device__ __forceinline__ float bflo(unsigned w) { return __uint_as_float(w << 16); }
__device__ __forceinline__ float bfhi(unsigned w) { return __uint_as_float(w & 0xffff0000u); }
__device__ __forceinline__ float wave_sum(float v) {
#pragma unroll
    for (int o = 32; o >= 1; o >>= 1) v += __shfl_xor(v, o);
    return v;
}
__device__ __forceinline__ float wave_max(float v) {
#pragma unroll
    for (int o = 32; o >= 1; o >>= 1) v = fmaxf(v, __shfl_xor(v, o));
    return v;
}
__device__ __forceinline__ int lane_id() { return (int)__builtin_amdgcn_mbcnt_hi(~0u, __builtin_amdgcn_mbcnt_lo(~0u, 0u)); }
__device__ __forceinline__ int make_tid(int wv) { int l; asm volatile("v_mbcnt_lo_u32_b32 %0, -1, 0\n\tv_mbcnt_hi_u32_b32 %0, -1, %0" : "=v"(l)); return wv * 64 + l; }
__device__ __forceinline__ float sigmoidf_(float x) { return 1.0f / (1.0f + __expf(-x)); }
__device__ __forceinline__ s16x4 tr_read(unsigned lds_addr) { s16x4 r; asm volatile("ds_read_b64_tr_b16 %0, %1\n\ts_waitcnt lgkmcnt(0)" : "=&v"(r) : "v"(lds_addr) : "memory"); return r; }

#define XB_TMO      128
#define XB_XCNT(j)  (256  + 64 * (j))
#define XB_XSUB(j)  (1280 + 64 * (j))
#define XB_XGEN(j)  (2304 + 64 * (j))
#define XB_TOP      3328
#define XB_TOPGEN   3392
#define XCD_BAR_WORDS 3456
#define XB_SPIN_CAP (1u << 18)

__device__ __forceinline__ unsigned xb_ld(unsigned* p)              { return __hip_atomic_load(p, __ATOMIC_RELAXED, __HIP_MEMORY_SCOPE_AGENT); }
__device__ __forceinline__ unsigned xb_add(unsigned* p, unsigned v) { return __hip_atomic_fetch_add(p, v, __ATOMIC_RELAXED, __HIP_MEMORY_SCOPE_AGENT); }
__device__ __forceinline__ unsigned xb_xcc_id() { return (unsigned)__builtin_amdgcn_s_getreg((3 << 11) | 20) & 0xFu; }
#define XB_SPIN(cond, bar) do { unsigned _sp = 0; while (cond) { __builtin_amdgcn_s_sleep(1); \
    if ((++_sp & 255u) == 0u) { if (xb_ld(&(bar)[XB_TMO])) break; if (_sp > XB_SPIN_CAP) { atomicAdd(&(bar)[XB_TMO], 1u); break; } } } } while (0)

struct XcdBarrier { unsigned* bar; unsigned x; volatile LAS unsigned* st; };

__device__ __forceinline__ XcdBarrier xcd_barrier_post(unsigned* bar, volatile LAS unsigned* st, bool t0) {
    XcdBarrier b; b.bar = bar; b.x = xb_xcc_id(); b.st = st;
    if (t0) (void)xb_add(&bar[XB_XCNT(b.x)], 1u);
    return b;
}
__device__ __forceinline__ void xcd_barrier_complete(unsigned* bar, unsigned x, unsigned& nloc, unsigned& nx) {
    const unsigned G = gridDim.x * gridDim.y * gridDim.z;
    unsigned sum, cnt, mine, sp = 0u;
    for (;;) {
        sum = 0u; cnt = 0u; mine = 0u;
#pragma unroll
        for (unsigned j = 0; j < 16; ++j) { const unsigned c = xb_ld(&bar[XB_XCNT(j)]); sum += c; cnt += (c > 0u) ? 1u : 0u; mine = (j == x) ? c : mine; }
        if (sum == G) break;
        __builtin_amdgcn_s_sleep(1);
        if ((++sp & 255u) == 0u) { if (xb_ld(&bar[XB_TMO])) break; if (sp > XB_SPIN_CAP) { atomicAdd(&bar[XB_TMO], 1u); break; } }
    }
    nloc = mine > 0u ? mine : 1u; nx = cnt > 0u ? cnt : 1u;
}
__device__ __forceinline__ void xcd_barrier(const XcdBarrier& b, int wv) {
    asm volatile("s_waitcnt vmcnt(0)" ::: "memory");
    __syncthreads();
    if (wv == 0 && lane_id() == 0) {
        unsigned* bar = b.bar;
        __builtin_amdgcn_s_waitcnt(0);
        unsigned nloc = b.st[0], nx = b.st[1];
        if (nloc == 0u) { xcd_barrier_complete(bar, b.x, nloc, nx); b.st[0] = nloc; b.st[1] = nx; }
        const unsigned old = xb_add(&bar[XB_XSUB(b.x)], 1u);
        const unsigned gen = old / nloc;
        if (old + 1u == (gen + 1u) * nloc) {
            __builtin_amdgcn_fence(__ATOMIC_RELEASE, "agent");
            asm volatile("s_waitcnt vmcnt(0)" ::: "memory");
            const unsigned og = xb_add(&bar[XB_TOP], 1u);
            const unsigned tg = og / nx;
            if (og + 1u == (tg + 1u) * nx) xb_add(&bar[XB_TOPGEN], 1u);
            else XB_SPIN(xb_ld(&bar[XB_TOPGEN]) == tg, bar);
            __builtin_amdgcn_fence(__ATOMIC_ACQUIRE, "agent");
            xb_add(&bar[XB_XGEN(b.x)], 1u);
            asm volatile("s_waitcnt vmcnt(0)" ::: "memory");
        } else {
            XB_SPIN(xb_ld(&bar[XB_XGEN(b.x)]) == gen, bar);
            __builtin_amdgcn_fence(__ATOMIC_ACQUIRE, "agent");
            asm volatile("s_waitcnt vmcnt(0)" ::: "memory");
        }
    }
    __syncthreads();
}
#define DEV_STAGE 9
__device__ __forceinline__ void conv_supertile(const float* __restrict__ src, int ld_src, int srccol, int k0, bf16_t* __restrict__ dst, int K, LAS unsigned* buf, int t) {
    const int c4 = t & 63, kq = t >> 6;
    f32x4 a[4], b[4];
#pragma unroll
    for (int i = 0; i < 4; ++i) { const int kp = kq + 8 * i; const float* r = src + (size_t)(k0 + 2 * kp) * ld_src + srccol; a[i] = *(const f32x4*)r; b[i] = *(const f32x4*)(r + ld_src); }
#pragma unroll
    for (int i = 0; i < 4; ++i) { const int kp = kq + 8 * i;
#pragma unroll
        for (int j = 0; j < 4; ++j) buf[(4 * c4 + j) * 33 + kp] = cvt_pk_bf16(a[i][j], b[i][j]); }
    __syncthreads();
    const int n = t >> 1, hf = t & 1;
    bf16_t* d = dst + (size_t)n * K + k0 + 32 * hf;
#pragma unroll
    for (int q = 0; q < 4; ++q) { u32x4 o;
#pragma unroll
        for (int e = 0; e < 4; ++e) o[e] = buf[n * 33 + 16 * hf + 4 * q + e];
        *(u32x4*)(d + 8 * q) = o; }
    __syncthreads();
}

__device__ __forceinline__ void p0_gemv_item(const Params& p, int id, LAS unsigned char* lds, int t) {
    const int cb = id % 48, ks = id / 48;
    LAS float* sv = (LAS float*)lds;
    LAS float* red = sv + 9 * 256;
    for (int i = t; i < 9 * 256; i += NTHR) { const int r = i >> 8, kk = i & 255; const float cv = (r < 8) ? p.c[r * 2048 + ks * 256 + kk] : p.c_ctx[ks * 256 + kk]; sv[i] = cv / (1.0f + __expf(-cv)); }
    __syncthreads();
    const int col4 = t & 63, w = t >> 6;
    f32x4 acc[9];
#pragma unroll
    for (int r = 0; r < 9; ++r) acc[r] = (f32x4){0.f, 0.f, 0.f, 0.f};
    const float* wp = p.w_ada + (size_t)(ks * 256 + w) * 12288 + cb * 256 + col4 * 4;
#pragma unroll 8
    for (int i = 0; i < 32; ++i) { const f32x4 wv = *(const f32x4*)(wp + (size_t)i * 8 * 12288); const int kk = w + 8 * i;
#pragma unroll
        for (int r = 0; r < 9; ++r) acc[r] += sv[r * 256 + kk] * wv; }
#pragma unroll
    for (int r = 0; r < 9; ++r) *(LAS f32x4*)(red + (w * 9 + r) * 256 + col4 * 4) = acc[r];
    __syncthreads();
    float* modp = (float*)(p.ws + WS_MODP);
    for (int i = t; i < 9 * 256; i += NTHR) { const int r = i >> 8, col = i & 255; float s = 0.f;
#pragma unroll
        for (int ww = 0; ww < 8; ++ww) s += red[(ww * 9 + r) * 256 + col];
        modp[(size_t)(ks * 9 + r) * 12288 + cb * 256 + col] = s; }
    __syncthreads();
}

__device__ __forceinline__ void p0_s5_item(const Params& p, int g, LAS unsigned char* lds, int t) {
    LAS float* LBP = (LAS float*)lds;
    LAS float* BB = LBP + 2 * 17 * 64 * 2;
    LAS float* CC = BB + 2 * 64 * 16 * 2;
    LAS float* KT = CC + 2 * 16 * 64 * 2;
    if (t < 128) {
        const int d = t >> 6, pp = t & 63, gi = (d * 64 + g) * 64 + pp;
        const float lre = fminf(p.lam_re[gi], -1e-4f), lim = p.lam_im[gi], dt = __expf(p.log_dt[d * 64 + g]);
        const float mag = expf(lre * dt), ang = lim * dt;
        float sn, cs; sincosf(ang, &sn, &cs);
        const float lbr = mag * cs, lbi = mag * sn;
        const float den = lre * lre + lim * lim, nr = lbr - 1.0f;
        const float cre = (nr * lre + lbi * lim) / den, cim = (lbi * lre - nr * lim) / den;
        float pr = 1.f, pi = 0.f;
        for (int tau = 0; tau <= 16; ++tau) { LBP[((d * 17 + tau) * 64 + pp) * 2] = pr; LBP[((d * 17 + tau) * 64 + pp) * 2 + 1] = pi; const float nr2 = pr * lbr - pi * lbi, ni2 = pr * lbi + pi * lbr; pr = nr2; pi = ni2; }
        float* lb16 = (float*)(p.ws + WS_LB16);
        lb16[gi * 2] = LBP[((d * 17 + 16) * 64 + pp) * 2]; lb16[gi * 2 + 1] = LBP[((d * 17 + 16) * 64 + pp) * 2 + 1];
        for (int h = 0; h < 16; ++h) { const float br = p.b_re[(size_t)gi * 16 + h], bi = p.b_im[(size_t)gi * 16 + h];
            BB[((d * 64 + pp) * 16 + h) * 2] = cre * br - cim * bi; BB[((d * 64 + pp) * 16 + h) * 2 + 1] = cre * bi + cim * br; }
    }
    for (int i = t; i < 2 * 16 * 64; i += NTHR) { const int d = i >> 10, h = (i >> 6) & 15, pp = i & 63; const size_t gi = ((size_t)(d * 64 + g) * 16 + h) * 64 + pp;
        CC[i * 2] = p.c_re[gi]; CC[i * 2 + 1] = p.c_im[gi]; }
    __syncthreads();
    for (int idx = t; idx < 8192; idx += NTHR) { const int d = idx >> 12, tau = (idx >> 8) & 15, h = (idx >> 4) & 15, h2 = idx & 15; float s = 0.f;
        for (int pp = 0; pp < 64; ++pp) { const float cr = CC[((d * 16 + h) * 64 + pp) * 2], ci = CC[((d * 16 + h) * 64 + pp) * 2 + 1];
            const float lr = LBP[((d * 17 + tau) * 64 + pp) * 2], li = LBP[((d * 17 + tau) * 64 + pp) * 2 + 1];
            const float br = BB[((d * 64 + pp) * 16 + h2) * 2], bi = BB[((d * 64 + pp) * 16 + h2) * 2 + 1];
            const float wr = cr * lr - ci * li, wi = cr * li + ci * lr; s += wr * br - wi * bi; }
        KT[idx] = s; }
    __syncthreads();
    unsigned* bty = (unsigned*)(p.ws + WS_BTY) + (size_t)g * 256 * 256;
    for (int idx = t; idx < 256 * 256; idx += NTHR) { const int n = idx >> 8, kp = idx & 255, tt = n >> 4, h = n & 15; float v[2];
#pragma unroll
        for (int e = 0; e < 2; ++e) { const int k = 2 * kp + e;
            if (k < 256) { const int s = k >> 4, h2 = k & 15; float a = 0.f;
                if (s <= tt) a += KT[((0 * 16 + (tt - s)) * 16 + h) * 16 + h2];
                if (s >= tt) a += KT[((1 * 16 + (s - tt)) * 16 + h) * 16 + h2];
                v[e] = a;
            } else { const int d = (k - 256) >> 7, kk = (k - 256) & 127, reim = kk >> 6, pp = kk & 63, pw = d == 0 ? tt + 1 : 16 - tt;
                const float cr = CC[((d * 16 + h) * 64 + pp) * 2], ci = CC[((d * 16 + h) * 64 + pp) * 2 + 1];
                const float lr = LBP[((d * 17 + pw) * 64 + pp) * 2], li = LBP[((d * 17 + pw) * 64 + pp) * 2 + 1];
                v[e] = reim == 0 ? (cr * lr - ci * li) : -(cr * li + ci * lr); } }
        bty[idx] = cvt_pk_bf16(v[0], v[1]); }
    unsigned* btv = (unsigned*)(p.ws + WS_BTV) + (size_t)g * 256 * 128;
    for (int idx = t; idx < 256 * 128; idx += NTHR) { const int n = idx >> 7, kp = idx & 127, d = n >> 7, reim = (n >> 6) & 1, pp = n & 63; float v[2];
#pragma unroll
        for (int e = 0; e < 2; ++e) { const int k = 2 * kp + e, s = k >> 4, h2 = k & 15, pw = d == 0 ? 15 - s : s;
            const float lr = LBP[((d * 17 + pw) * 64 + pp) * 2], li = LBP[((d * 17 + pw) * 64 + pp) * 2 + 1];
            const float br = BB[((d * 64 + pp) * 16 + h2) * 2], bi = BB[((d * 64 + pp) * 16 + h2) * 2 + 1];
            v[e] = reim == 0 ? (lr * br - li * bi) : (lr * bi + li * br); }
        btv[idx] = cvt_pk_bf16(v[0], v[1]); }
    __syncthreads();
}

constexpr int P0_GEMV = 384, P0_S5 = 64, P0_RT = 1;
constexpr int P0_SPECIAL = P0_GEMV + P0_S5 + P0_RT;
constexpr int P0_WIN = 16 * 32, P0_WGLU = 4 * 16, P0_WOUT = 8 * 32, P0_WGU = 32 * 16 * 32, P0_WDN = 32 * 8 * 32;
constexpr int P0_TOTAL = P0_SPECIAL + P0_WIN + P0_WGLU + P0_WOUT + P0_WGU + P0_WDN;

__device__ __forceinline__ void phase0(const Params& p, LAS unsigned char* lds, int wv) {
    const int t = make_tid(wv);
    LAS unsigned* buf = (LAS unsigned*)lds;
    for (int id = blockIdx.x; id < P0_TOTAL; id += gridDim.x) {
        if (id < P0_GEMV) { p0_gemv_item(p, id, lds, t); continue; }
        if (id < P0_GEMV + P0_S5) { p0_s5_item(p, id - P0_GEMV, lds, t); continue; }
        if (id < P0_SPECIAL) {
            bf16_t* wrt = (bf16_t*)(p.ws + WS_WRT);
            for (int i = t; i < 65536; i += NTHR) { const int k = i >> 5, e = i & 31; const float w = p.w_router[i]; const bf16_t hi = f2bf(w); const bf16_t lo = f2bf(w - bf2f(hi));
                wrt[e * 2048 + k] = hi; wrt[(32 + e) * 2048 + k] = lo; }
            continue;
        }
        int j = id - P0_SPECIAL;
        const int c4 = t & 63;
        if (j < P0_WIN) { const int nb = j & 15, kb = j >> 4; const int n0 = nb * 256, sc0 = n0 < 3072 ? n0 : n0 + 16;
            conv_supertile(p.w_in, DIN, sc0 + 4 * c4, kb * 64, (bf16_t*)(p.ws + WS_WIN_T) + (size_t)n0 * 2048, 2048, buf, t); continue; }
        j -= P0_WIN;
        if (j < P0_WGLU) { const int nb = j & 3, kb = j >> 2;
            conv_supertile(p.w_glu, 1024, nb * 256 + 4 * c4, kb * 64, (bf16_t*)(p.ws + WS_WGLU_T) + (size_t)nb * 256 * 1024, 1024, buf, t); continue; }
        j -= P0_WGLU;
        if (j < P0_WOUT) { const int nb = j & 7, kb = j >> 3;
            conv_supertile(p.w_out, 2048, nb * 256 + 4 * c4, kb * 64, (bf16_t*)(p.ws + WS_WOUT_T) + (size_t)nb * 256 * 2048, 2048, buf, t); continue; }
        j -= P0_WOUT;
        if (j < P0_WGU) { const int nb = j & 15, kb = (j >> 4) & 31, e = j >> 9;
            const int sc = (c4 < 32) ? nb * 128 + 4 * c4 : 2048 + nb * 128 + 4 * (c4 - 32);
            conv_supertile(p.w_gu + (size_t)e * 2048 * 4096, 4096, sc, kb * 64, (bf16_t*)(p.ws + WS_WGU_T) + ((size_t)e * 4096 + nb * 256) * 2048, 2048, buf, t); continue; }
        j -= P0_WGU;
        { const int nb = j & 7, kb = (j >> 3) & 31, e = j >> 8;
            conv_supertile(p.w_down + (size_t)e * 2048 * 2048, 2048, nb * 256 + 4 * c4, kb * 64, (bf16_t*)(p.ws + WS_WDN_T) + ((size_t)e * 2048 + nb * 256) * 2048, 2048, buf, t); }
    }
}

__device__ __forceinline__ void p1_load_vecs(const Params& p, int modrow, LAS float* scv, LAS float* shv, int t) {
    const float* modp = (const float*)(p.ws + WS_MODP);
    for (int d = t; d < 2048; d += NTHR) { float sh = p.b_ada[d], sc = 1.0f + p.b_ada[2048 + d];
#pragma unroll
        for (int ks = 0; ks < 8; ++ks) { sh += modp[(size_t)(ks * 9 + modrow) * 12288 + d]; sc += modp[(size_t)(ks * 9 + modrow) * 12288 + 2048 + d]; }
        scv[d] = sc; shv[d] = sh; }
}
__device__ __forceinline__ void p1_row(const Params& p, const float* __restrict__ xrow, int urow, LAS const unsigned char* wgl, LAS const float* scv, LAS const float* shv, int lane) {
    f32x4 v[8]; float ss = 0.f;
#pragma unroll
    for (int i = 0; i < 8; ++i) { v[i] = *(const f32x4*)(xrow + (i * 64 + lane) * 4); ss += v[i][0] * v[i][0] + v[i][1] * v[i][1] + v[i][2] * v[i][2] + v[i][3] * v[i][3]; }
    ss = wave_sum(ss);
    const float rstd = rsqrtf(ss * (1.0f / 2048.0f) + 1e-6f);
    float acc[16];
#pragma unroll
    for (int j = 0; j < 16; ++j) acc[j] = 0.f;
    bf16_t* urow_p = (bf16_t*)(p.ws + WS_U1) + (size_t)urow * 2048;
#pragma unroll
    for (int i = 0; i < 8; ++i) { const int m = i * 64 + lane;
        const f32x4 g = *(const f32x4*)(p.norm1_g + m * 4), sc = *(LAS const f32x4*)(scv + m * 4), sh = *(LAS const f32x4*)(shv + m * 4);
        const f32x4 u = v[i] * rstd * g * sc + sh;
        u32x2 w; w.x = cvt_pk_bf16(u[0], u[1]); w.y = cvt_pk_bf16(u[2], u[3]);
        *(u32x2*)(urow_p + m * 4) = w;
#pragma unroll
        for (int j = 0; j < 4; ++j) {
#pragma unroll
            for (int q = 0; q < 4; ++q) { const f32x4 wv = *(LAS const f32x4*)(wgl + m * 272 + j * 64 + q * 16);
                acc[q * 4 + 0] += u[j] * wv[0]; acc[q * 4 + 1] += u[j] * wv[1]; acc[q * 4 + 2] += u[j] * wv[2]; acc[q * 4 + 3] += u[j] * wv[3]; } }
    }
    float r8[8], r4[4], r2[2], r1;
    { const bool up = (lane & 32) != 0;
#pragma unroll
      for (int j = 0; j < 8; ++j) { const float keep = up ? acc[j + 8] : acc[j], send = up ? acc[j] : acc[j + 8]; r8[j] = keep + __shfl_xor(send, 32); } }
    { const bool up = (lane & 16) != 0;
#pragma unroll
      for (int j = 0; j < 4; ++j) { const float keep = up ? r8[j + 4] : r8[j], send = up ? r8[j] : r8[j + 4]; r4[j] = keep + __shfl_xor(send, 16); } }
    { const bool up = (lane & 8) != 0;
#pragma unroll
      for (int j = 0; j < 2; ++j) { const float keep = up ? r4[j + 2] : r4[j], send = up ? r4[j] : r4[j + 2]; r2[j] = keep + __shfl_xor(send, 8); } }
    { const bool up = (lane & 4) != 0; const float keep = up ? r2[1] : r2[0], send = up ? r2[0] : r2[1]; r1 = keep + __shfl_xor(send, 4); }
    r1 += __shfl_xor(r1, 2); r1 += __shfl_xor(r1, 1);
    if ((lane & 3) == 0) { const int gi = ((lane >> 5) & 1) * 8 + ((lane >> 4) & 1) * 4 + ((lane >> 3) & 1) * 2 + ((lane >> 2) & 1);
        float gv = 15.0f * tanhf((r1 + p.gate_bias[gi]) * (1.0f / 15.0f));
        if ((gi >> 2) & 1) gv = fminf(gv, 0.f) - log1pf(__expf(-fabsf(gv)));
        ((float*)(p.ws + WS_GATES))[(size_t)urow * 16 + gi] = gv; }
}
__device__ __forceinline__ void phase1(const Params& p, LAS unsigned char* lds, int wv) {
    const int t = make_tid(wv);
    const int lane = t & 63, wid = t >> 6, wg = blockIdx.x;
    { const float* modp = (const float*)(p.ws + WS_MODP); float* mod = (float*)(p.ws + WS_MOD);
      for (int i = wg * NTHR + t; i < 9 * 12288; i += NWG * NTHR) { const int r = i / 12288, j = i - r * 12288; float s = p.b_ada[j];
#pragma unroll
          for (int ks = 0; ks < 8; ++ks) s += modp[(size_t)(ks * 9 + r) * 12288 + j];
          mod[i] = s; } }
    LAS unsigned char* wgl = lds;
    LAS float* scv = (LAS float*)(lds + 139264);
    LAS float* shv = scv + 2048;
    for (int i = t; i < 2048 * 4; i += NTHR) { const int k = i >> 2, q = i & 3; *(LAS f32x4*)(wgl + (k >> 2) * 272 + (k & 3) * 64 + q * 16) = *(const f32x4*)(p.w_in + (size_t)k * DIN + 3072 + q * 4); }
    const int b = wg >> 5;
    p1_load_vecs(p, b, scv, shv, t);
    __syncthreads();
    for (int r = wid; r < 64; r += 8) { const int row = wg * 64 + r; p1_row(p, p.x + (size_t)row * 2048, row, wgl, scv, shv, lane); }
    __syncthreads();
    p1_load_vecs(p, 8, scv, shv, t);
    __syncthreads();
    { const int row = wg * 8 + wid; p1_row(p, p.ctx + (size_t)row * 2048, NLAT + row, wgl, scv, shv, lane); }
    __syncthreads();
}
namespace pg8 {
constexpr int BM = 256, BK = 64, HALF = 128, HTB = HALF * BK * 2, STAGE_BYTES = 8 * HTB, NXCD = 8;
__host__ __device__ __forceinline__ int lds_byte(int r, int c) { const int st = (r >> 4) * 2 + (c >> 5), rr = r & 15, cc = c & 31, ob = rr * 64 + cc * 2; return st * 1024 + (ob ^ (((ob >> 9) & 1) << 5)); }
__host__ __device__ __forceinline__ void stage_rc(int b, int& R, int& C) { const int st = b / 1024, sb = b % 1024, swz = sb ^ (((sb >> 9) & 1) << 5); R = (st >> 1) * 16 + swz / 64; C = (st & 1) * 32 + (swz % 64) / 2; }
__host__ __device__ __forceinline__ int perm32(int rho) { const int n = rho >> 4, i = rho & 15; return 8 * (i >> 2) + 4 * n + (i & 3); }
struct Unit { int pm, pn, g; };
__device__ __forceinline__ int xcd_chunk(int L, int nwg) { const int q = nwg / NXCD, r = nwg % NXCD, xcd = L % NXCD, off = L / NXCD; return (xcd < r ? xcd * (q + 1) : r * (q + 1) + (xcd - r) * q) + off; }

template <class Epi, class Sched, int K, int LDA, bool GATHER>
__device__ __forceinline__ void gemm_phase(LAS unsigned char* lds, const Sched& S, const Epi& E, int wv) {
    const int tid = make_tid(wv);
    const int wid = wv, lane = tid & 63, wr = wid >> 2, wc = wid & 3, fr = lane & 15, fq = lane >> 4;
    constexpr int nt = K / BK;
    int R0, C0, R1, C1; stage_rc(tid * 16, R0, C0); stage_rc(tid * 16 + 8192, R1, C1);
    unsigned voffB[2];
    { const int Rb0 = Epi::PERM ? ((R0 & ~31) + perm32(R0 & 31)) : R0, Rb1 = Epi::PERM ? ((R1 & ~31) + perm32(R1 & 31)) : R1;
      voffB[0] = (unsigned)(Rb0 * K + C0) * 2u; voffB[1] = (unsigned)(Rb1 * K + C1) * 2u; }
    unsigned offC[2][2], offN[2][2];
    constexpr size_t kstep = (size_t)(BK * 2);
    constexpr size_t hstepB = (size_t)HALF * K * 2;
    const unsigned ldsw = (unsigned)wid * 1024u;
    const int aoff = lds_byte(wr * 64 + fr, fq * 8), boff = lds_byte(wc * 32 + fr, fq * 8);
#define PG8_SA(b, h) (((b) * 2 + (h)) * HTB)
#define PG8_SB(b, h) ((4 + (b) * 2 + (h)) * HTB)
#define PG8_STAGE(bufoff, gbase, voff) do { _Pragma("unroll") for (int _i = 0; _i < 2; ++_i) \
        __builtin_amdgcn_global_load_lds((const unsigned*)((const char*)(gbase) + (voff)[_i]), (LAS unsigned*)(lds + (bufoff) + ldsw + _i * 8192), 16, 0, 0); } while (0)
#define PG8_LDA(dst, b, h) do { _Pragma("unroll") for (int m = 0; m < 4; ++m) _Pragma("unroll") for (int k = 0; k < 2; ++k) dst[m][k] = *(const LAS bf16x8*)(lds + PG8_SA(b, h) + aoff + m * 2048 + k * 1024); } while (0)
#define PG8_LDB(dst, b, h) do { _Pragma("unroll") for (int n = 0; n < 2; ++n) _Pragma("unroll") for (int k = 0; k < 2; ++k) dst[n][k] = *(const LAS bf16x8*)(lds + PG8_SB(b, h) + boff + n * 2048 + k * 1024); } while (0)
#define PG8_MMA(ai, bj, At, Bt) do { __builtin_amdgcn_s_setprio(1); _Pragma("unroll") for (int m = 0; m < 4; ++m) _Pragma("unroll") for (int n = 0; n < 2; ++n) _Pragma("unroll") for (int k = 0; k < 2; ++k) \
        acc[ai][bj][m][n] = __builtin_amdgcn_mfma_f32_16x16x32_bf16(Bt[n][k], At[m][k], acc[ai][bj][m][n], 0, 0, 0); __builtin_amdgcn_s_setprio(0); } while (0)
#define PG8_WAIT_V(n) asm volatile("s_waitcnt vmcnt(" #n ")" ::: "memory")
#define PG8_WAIT_L(n) asm volatile("s_waitcnt lgkmcnt(" #n ")" ::: "memory")
#define PG8_BAR __builtin_amdgcn_s_barrier()
#define PG8_SCHED __builtin_amdgcn_sched_barrier(0)
    Unit cur, nxt; int ui = 0;
    if (!S.next(0, cur)) return;
    f32x4 acc[2][2][4][2];
#pragma unroll
    for (int a = 0; a < 2; ++a)
#pragma unroll
        for (int b = 0; b < 2; ++b)
#pragma unroll
            for (int m = 0; m < 4; ++m)
#pragma unroll
                for (int n = 0; n < 2; ++n) acc[a][b][m][n] = (f32x4){0.f, 0.f, 0.f, 0.f};
    bf16x8 At[4][2], B0[2][2], B1[2][2];
    const char* cA = S.a_ptr(cur); const char* cB = S.b_ptr(cur);
    if constexpr (GATHER) S.a_rows(cur, wv, offC);
    else { offC[0][0] = (unsigned)(R0 * LDA + C0) * 2u; offC[0][1] = (unsigned)(R1 * LDA + C1) * 2u; offC[1][0] = (unsigned)((R0 + HALF) * LDA + C0) * 2u; offC[1][1] = (unsigned)((R1 + HALF) * LDA + C1) * 2u; }
    PG8_STAGE(PG8_SB(0, 0), cB, voffB); PG8_STAGE(PG8_SB(0, 1), cB + hstepB, voffB); PG8_STAGE(PG8_SA(0, 0), cA, offC[0]); PG8_STAGE(PG8_SA(0, 1), cA, offC[1]);
    if (wr == 1) PG8_BAR;
    PG8_WAIT_V(2); PG8_BAR;
    PG8_STAGE(PG8_SB(1, 0), cB + kstep, voffB); PG8_STAGE(PG8_SA(1, 0), cA + kstep, offC[0]); PG8_STAGE(PG8_SB(1, 1), cB + hstepB + kstep, voffB);
    PG8_WAIT_V(6); PG8_BAR;
    for (;;) {
        const bool has_next = S.next(ui + 1, nxt);
        const char* nA = has_next ? S.a_ptr(nxt) : cA; const char* nB = has_next ? S.b_ptr(nxt) : cB;
        if constexpr (GATHER) { if (has_next) S.a_rows(nxt, wv, offN); else { offN[0][0] = offC[0][0]; offN[0][1] = offC[0][1]; offN[1][0] = offC[1][0]; offN[1][1] = offC[1][1]; } }
#pragma unroll 1
        for (int t = 0; t < nt; t += 2) {
            const bool last = (t == nt - 2);
            const char* a1 = cA + (size_t)(t + 1) * kstep;
            const char* a2 = last ? nA : cA + (size_t)(t + 2) * kstep; const char* b2 = last ? nB : cB + (size_t)(t + 2) * kstep;
            const char* a3 = a2 + kstep; const char* b3 = b2 + kstep;
            unsigned o2[2][2];
            if constexpr (GATHER) { o2[0][0] = last ? offN[0][0] : offC[0][0]; o2[0][1] = last ? offN[0][1] : offC[0][1]; o2[1][0] = last ? offN[1][0] : offC[1][0]; o2[1][1] = last ? offN[1][1] : offC[1][1]; }
            else { o2[0][0] = offC[0][0]; o2[0][1] = offC[0][1]; o2[1][0] = offC[1][0]; o2[1][1] = offC[1][1]; }
            PG8_LDB(B0, 0, 0); PG8_LDB(B1, 0, 1); PG8_SCHED; PG8_LDA(At, 0, 0); PG8_STAGE(PG8_SA(1, 1), a1, offC[1]);
            PG8_WAIT_V(8); PG8_WAIT_L(0); PG8_BAR; PG8_MMA(0, 0, At, B0); PG8_MMA(0, 1, At, B1); PG8_BAR; PG8_SCHED;
            PG8_LDA(At, 0, 1); PG8_STAGE(PG8_SB(0, 0), b2, voffB); PG8_STAGE(PG8_SB(0, 1), b2 + hstepB, voffB); PG8_STAGE(PG8_SA(0, 0), a2, o2[0]);
            PG8_WAIT_V(8); PG8_WAIT_L(0); PG8_BAR; PG8_MMA(1, 0, At, B0); PG8_MMA(1, 1, At, B1); PG8_BAR; PG8_SCHED;
            PG8_LDB(B0, 1, 0); PG8_LDB(B1, 1, 1); PG8_SCHED; PG8_LDA(At, 1, 0); PG8_STAGE(PG8_SA(0, 1), a2, o2[1]);
            PG8_WAIT_V(8); PG8_WAIT_L(0); PG8_BAR; PG8_MMA(0, 0, At, B0); PG8_MMA(0, 1, At, B1); PG8_BAR; PG8_SCHED;
            PG8_LDA(At, 1, 1); PG8_STAGE(PG8_SB(1, 0), b3, voffB); PG8_STAGE(PG8_SB(1, 1), b3 + hstepB, voffB); PG8_STAGE(PG8_SA(1, 0), a3, o2[0]);
            PG8_WAIT_V(8); PG8_WAIT_L(0); PG8_BAR; PG8_MMA(1, 0, At, B0); PG8_MMA(1, 1, At, B1); PG8_BAR; PG8_SCHED;
        }
        if (wr == 0) PG8_BAR;
        { int fr2 = fr, fq2 = fq; asm volatile("" : "+v"(fr2), "+v"(fq2));
          E(acc, cur, wr, wc, fr2, fq2); }
        if (!has_next) break;
#pragma unroll
        for (int a = 0; a < 2; ++a)
#pragma unroll
            for (int b = 0; b < 2; ++b)
#pragma unroll
                for (int m = 0; m < 4; ++m)
#pragma unroll
                    for (int n = 0; n < 2; ++n) acc[a][b][m][n] = (f32x4){0.f, 0.f, 0.f, 0.f};
        cur = nxt; cA = nA; cB = nB; ++ui;
        if constexpr (GATHER) { offC[0][0] = offN[0][0]; offC[0][1] = offN[0][1]; offC[1][0] = offN[1][0]; offC[1][1] = offN[1][1]; }
        if (wr == 1) PG8_BAR;
    }
    PG8_WAIT_V(0);
    PG8_BAR;
#undef PG8_SA
#undef PG8_SB
#undef PG8_STAGE
#undef PG8_LDA
#undef PG8_LDB
#undef PG8_MMA
#undef PG8_WAIT_V
#undef PG8_WAIT_L
#undef PG8_BAR
#undef PG8_SCHED
}
}
using pg8::Unit;
typedef f32x4 AccT[2][2][4][2];

struct SchedInProj {
    const unsigned char* ws; int c;
    __device__ __forceinline__ bool next(int i, Unit& u) const {
        const int L = i * NWG + c; if (L >= 1104) return false;
        const int w = pg8::xcd_chunk(L, 1104);
        if (w < 1024) { const int gid = w >> 7, r = w & 127; u.pm = gid * 8 + (r & 7); u.pn = r >> 3; }
        else { const int j = w - 1024, q = j >> 3; u.pm = 64 + (j & 7); u.pn = q < 6 ? 2 + q : 6 + q; }
        u.g = 0; return true;
    }
    __device__ __forceinline__ const char* a_ptr(const Unit& u) const { return (const char*)(ws + WS_U1) + (size_t)u.pm * 256 * 2048 * 2; }
    __device__ __forceinline__ const char* b_ptr(const Unit& u) const { return (const char*)(ws + WS_WIN_T) + (size_t)u.pn * 256 * 2048 * 2; }
};
struct EpiInProj {
    static constexpr bool PERM = true;
    unsigned char* ws;
    __device__ __forceinline__ void operator()(const AccT& acc, const Unit& u, int wr, int wc, int fr, int fq) const {
#pragma unroll
        for (int ai = 0; ai < 2; ++ai)
#pragma unroll
            for (int m = 0; m < 4; ++m) {
                const int row = u.pm * 256 + ai * 128 + wr * 64 + m * 16 + fr;
#pragma unroll
                for (int bj = 0; bj < 2; ++bj) {
                    const f32x4 v0 = acc[ai][bj][m][0], v1 = acc[ai][bj][m][1];
                    u32x4 w; w.x = cvt_pk_bf16(v0[0], v0[1]); w.y = cvt_pk_bf16(v0[2], v0[3]); w.z = cvt_pk_bf16(v1[0], v1[1]); w.w = cvt_pk_bf16(v1[2], v1[3]);
                    const int cc = bj * 128 + wc * 32 + 8 * fq;
                    if (u.pn < 4) *(u32x4*)((bf16_t*)(ws + WS_ZQK) + (size_t)row * 1024 + u.pn * 256 + cc) = w;
                    else if (u.pn < 8) *(u32x4*)((bf16_t*)(ws + WS_VBUF) + (size_t)row * 1024 + (u.pn - 4) * 256 + cc) = w;
                    else if (u.pn < 12) *(u32x4*)((bf16_t*)(ws + WS_OBUF) + (size_t)row * 1024 + (u.pn - 8) * 256 + cc) = w;
                    else { const int ch = (u.pn - 12) * 256 + cc, g = ch >> 4, h0 = ch & 15; int crow, tt;
                        if (row < NLAT) { const int b = row >> 11, l = row & 2047; crow = b * 128 + (l >> 4); tt = l & 15; }
                        else { const int rr = row - NLAT, b = rr >> 8, l = rr & 255; crow = 1024 + b * 16 + (l >> 4); tt = l & 15; }
                        *(u32x4*)((bf16_t*)(ws + WS_AS5) + ((size_t)g * 1280 + crow) * 512 + tt * 16 + h0) = w; }
                }
            }
    }
};

struct SchedS5V {
    const unsigned char* ws; int c;
    __device__ __forceinline__ bool next(int i, Unit& u) const { const int L = i * NWG + c; if (L >= 320) return false; const int w = pg8::xcd_chunk(L, 320); u.g = w / 5; u.pm = w % 5; u.pn = 0; return true; }
    __device__ __forceinline__ const char* a_ptr(const Unit& u) const { return (const char*)(ws + WS_AS5) + ((size_t)u.g * 1280 + u.pm * 256) * 512 * 2; }
    __device__ __forceinline__ const char* b_ptr(const Unit& u) const { return (const char*)(ws + WS_BTV) + (size_t)u.g * 256 * 256 * 2; }
};
struct EpiS5V {
    static constexpr bool PERM = false;
    unsigned char* ws;
    __device__ __forceinline__ void operator()(const AccT& acc, const Unit& u, int wr, int wc, int fr, int fq) const {
        float* base = (float*)(ws + WS_VS5) + ((size_t)u.g * 1280 + u.pm * 256) * 256;
#pragma unroll
        for (int ai = 0; ai < 2; ++ai)
#pragma unroll
            for (int m = 0; m < 4; ++m) { float* rowp = base + (size_t)(ai * 128 + wr * 64 + m * 16 + fr) * 256 + wc * 32 + 4 * fq;
#pragma unroll
                for (int bj = 0; bj < 2; ++bj)
#pragma unroll
                    for (int n = 0; n < 2; ++n) *(f32x4*)(rowp + bj * 128 + n * 16) = acc[ai][bj][m][n]; }
    }
};

struct SchedS5Y {
    const unsigned char* ws; int c;
    __device__ __forceinline__ bool next(int i, Unit& u) const { const int L = i * NWG + c; if (L >= 256) return false; const int w = pg8::xcd_chunk(L, 256); u.g = w >> 2; u.pm = w & 3; u.pn = 0; return true; }
    __device__ __forceinline__ const char* a_ptr(const Unit& u) const { return (const char*)(ws + WS_AS5) + ((size_t)u.g * 1280 + u.pm * 256) * 512 * 2; }
    __device__ __forceinline__ const char* b_ptr(const Unit& u) const { return (const char*)(ws + WS_BTY) + (size_t)u.g * 256 * 512 * 2; }
};
__device__ __forceinline__ float gelu_tanh(float x) { const float u = 0.7978845608028654f * (x + 0.044715f * x * x * x); const float e = __expf(2.0f * u); const float th = 1.0f - 2.0f / (e + 1.0f); return 0.5f * x * (1.0f + th); }
struct EpiS5Y {
    static constexpr bool PERM = true;
    unsigned char* ws; const float* s5_d;
    __device__ __forceinline__ void operator()(const AccT& acc, const Unit& u, int wr, int wc, int fr, int fq) const {
#pragma unroll
        for (int ai = 0; ai < 2; ++ai)
#pragma unroll
            for (int m = 0; m < 4; ++m) {
                const int cr = u.pm * 256 + ai * 128 + wr * 64 + m * 16 + fr, b = cr >> 7, cb = cr & 127;
#pragma unroll
                for (int bj = 0; bj < 2; ++bj) {
                    const int nn = bj * 128 + wc * 32 + 8 * fq, tt = nn >> 4, h0 = nn & 15;
                    const u32x4 uw = *(const u32x4*)((const bf16_t*)(ws + WS_AS5) + ((size_t)u.g * 1280 + cr) * 512 + nn);
                    const f32x4 d0 = *(const f32x4*)(s5_d + u.g * 16 + h0), d1 = *(const f32x4*)(s5_d + u.g * 16 + h0 + 4);
                    const f32x4 y0 = acc[ai][bj][m][0], y1 = acc[ai][bj][m][1];
                    float s[8];
                    s[0] = gelu_tanh(y0[0] + d0[0] * bflo(uw.x)); s[1] = gelu_tanh(y0[1] + d0[1] * bfhi(uw.x)); s[2] = gelu_tanh(y0[2] + d0[2] * bflo(uw.y)); s[3] = gelu_tanh(y0[3] + d0[3] * bfhi(uw.y));
                    s[4] = gelu_tanh(y1[0] + d1[0] * bflo(uw.z)); s[5] = gelu_tanh(y1[1] + d1[1] * bfhi(uw.z)); s[6] = gelu_tanh(y1[2] + d1[2] * bflo(uw.w)); s[7] = gelu_tanh(y1[3] + d1[3] * bfhi(uw.w));
                    u32x4 w; w.x = cvt_pk_bf16(s[0], s[1]); w.y = cvt_pk_bf16(s[2], s[3]); w.z = cvt_pk_bf16(s[4], s[5]); w.w = cvt_pk_bf16(s[6], s[7]);
                    *(u32x4*)((bf16_t*)(ws + WS_SBUF) + ((size_t)b * 2048 + cb * 16 + tt) * 1024 + u.g * 16 + h0) = w;
                }
            }
    }
};

template <int NN> struct SchedStatic {
    const char* A; const char* Bt; int c; size_t a_tile_bytes, b_tile_bytes;
    __device__ __forceinline__ bool next(int i, Unit& u) const { constexpr int nwg = 64 * NN; const int L = i * NWG + c; if (L >= nwg) return false;
        const int w = pg8::xcd_chunk(L, nwg); const int nig = 8 * NN, gid = w / nig, r = w % nig; u.pm = gid * 8 + (r & 7); u.pn = r >> 3; u.g = 0; return true; }
    __device__ __forceinline__ const char* a_ptr(const Unit& u) const { return A + (size_t)u.pm * a_tile_bytes; }
    __device__ __forceinline__ const char* b_ptr(const Unit& u) const { return Bt + (size_t)u.pn * b_tile_bytes; }
};
struct EpiGLU {
    static constexpr bool PERM = true;
    unsigned char* ws;
    __device__ __forceinline__ void operator()(const AccT& acc, const Unit& u, int wr, int wc, int fr, int fq) const {
#pragma unroll
        for (int ai = 0; ai < 2; ++ai)
#pragma unroll
            for (int m = 0; m < 4; ++m) {
                const int row = u.pm * 256 + ai * 128 + wr * 64 + m * 16 + fr;
#pragma unroll
                for (int bj = 0; bj < 2; ++bj) {
                    const int col = u.pn * 256 + bj * 128 + wc * 32 + 8 * fq;
                    const u32x4 sw = *(const u32x4*)((const bf16_t*)(ws + WS_SBUF) + (size_t)row * 1024 + col);
                    const f32x4 a0 = acc[ai][bj][m][0], a1 = acc[ai][bj][m][1];
                    u32x4 w;
                    w.x = cvt_pk_bf16(bflo(sw.x) * sigmoidf_(a0[0]), bfhi(sw.x) * sigmoidf_(a0[1])); w.y = cvt_pk_bf16(bflo(sw.y) * sigmoidf_(a0[2]), bfhi(sw.y) * sigmoidf_(a0[3]));
                    w.z = cvt_pk_bf16(bflo(sw.z) * sigmoidf_(a1[0]), bfhi(sw.z) * sigmoidf_(a1[1])); w.w = cvt_pk_bf16(bflo(sw.w) * sigmoidf_(a1[2]), bfhi(sw.w) * sigmoidf_(a1[3]));
                    *(u32x4*)((bf16_t*)(ws + WS_CAT) + (size_t)row * 2048 + 1024 + col) = w;
                }
            }
    }
};
struct EpiOut {
    static constexpr bool PERM = false;
    unsigned char* ws; const float* x;
    __device__ __forceinline__ void operator()(const AccT& acc, const Unit& u, int wr, int wc, int fr, int fq) const {
        const float* g1 = (const float*)(ws + WS_MOD) + (size_t)(u.pm >> 3) * 12288 + 2 * 2048;
        const int col0 = u.pn * 256 + wc * 32 + 4 * fq;
        f32x4 gv[2][2];
#pragma unroll
        for (int bj = 0; bj < 2; ++bj)
#pragma unroll
            for (int n = 0; n < 2; ++n) gv[bj][n] = *(const f32x4*)(g1 + col0 + bj * 128 + n * 16);
#pragma unroll
        for (int ai = 0; ai < 2; ++ai)
#pragma unroll
            for (int m = 0; m < 4; ++m) { const size_t ro = (size_t)(u.pm * 256 + ai * 128 + wr * 64 + m * 16 + fr) * 2048 + col0;
#pragma unroll
                for (int bj = 0; bj < 2; ++bj)
#pragma unroll
                    for (int n = 0; n < 2; ++n) { const f32x4 xv = *(const f32x4*)(x + ro + bj * 128 + n * 16);
                        *(f32x4*)((float*)(ws + WS_X1) + ro + bj * 128 + n * 16) = xv + gv[bj][n] * acc[ai][bj][m][n]; } }
    }
};

struct MoeTables { LAS const int* tp; LAS const int* cnt; };
template <int NN  > struct SchedMoE {
    const unsigned char* ws; int c; MoeTables T; const char* A; const char* Bt; size_t b_expert_bytes;
    __device__ __forceinline__ bool next(int i, Unit& u) const {
        const int nwg = T.tp[32] * NN; const int L = i * NWG + c; if (L >= nwg) return false;
        const int w = pg8::xcd_chunk(L, nwg);
        int e = 0;
#pragma unroll 1
        for (int j = 1; j < 32; ++j) e = (w >= T.tp[j] * NN) ? j : e;
        const int q = w - T.tp[e] * NN, mt = T.tp[e + 1] - T.tp[e];
        u.g = e; u.pm = q % mt; u.pn = q / mt; return true;
    }
    __device__ __forceinline__ const char* a_ptr(const Unit& u) const { return A; }
    __device__ __forceinline__ const char* b_ptr(const Unit& u) const { return Bt + (size_t)u.g * b_expert_bytes + (size_t)u.pn * 256 * 2048 * 2; }
    __device__ __forceinline__ void a_rows(const Unit& u, int wv, unsigned (&off)[2][2]) const {
        const int tid = make_tid(wv); int R0, C0, R1, C1; pg8::stage_rc(tid * 16, R0, C0); pg8::stage_rc(tid * 16 + 8192, R1, C1);
        const int* list = (const int*)(ws + WS_LIST) + u.g * 16384; const int n = T.cnt[u.g], p0 = u.pm * 256;
        const int q00 = p0 + R0, q01 = p0 + R1, q10 = q00 + 128, q11 = q01 + 128;
        const int t00 = q00 < n ? list[q00] : 0, t01 = q01 < n ? list[q01] : 0, t10 = q10 < n ? list[q10] : 0, t11 = q11 < n ? list[q11] : 0;
        off[0][0] = (unsigned)(t00 * 2048 + C0) * 2u; off[0][1] = (unsigned)(t01 * 2048 + C1) * 2u; off[1][0] = (unsigned)(t10 * 2048 + C0) * 2u; off[1][1] = (unsigned)(t11 * 2048 + C1) * 2u;
    }
};
struct SchedMoE2 : SchedMoE<8> {
    __device__ __forceinline__ const char* a_ptr(const Unit& u) const { return A + (size_t)(T.tp[u.g] + u.pm) * 256 * 2048 * 2; }
};
struct EpiMoE1 {
    static constexpr bool PERM = true;
    unsigned char* ws; const float* b_gu; MoeTables T;
    __device__ __forceinline__ void operator()(const AccT& acc, const Unit& u, int wr, int wc, int fr, int fq) const {
        const int hc = u.pn * 128 + wc * 32 + 8 * fq;
        const float* bg = b_gu + (size_t)u.g * 4096 + hc;
        const f32x4 bg0 = *(const f32x4*)bg, bg1 = *(const f32x4*)(bg + 4), bu0 = *(const f32x4*)(bg + 2048), bu1 = *(const f32x4*)(bg + 2052);
        bf16_t* hid = (bf16_t*)(ws + WS_HID) + (size_t)(T.tp[u.g] + u.pm) * 256 * 2048 + hc;
#pragma unroll
        for (int ai = 0; ai < 2; ++ai)
#pragma unroll
            for (int m = 0; m < 4; ++m) {
                const int rr = ai * 128 + wr * 64 + m * 16 + fr;
                const f32x4 g0 = acc[ai][0][m][0] + bg0, g1 = acc[ai][0][m][1] + bg1, u0 = acc[ai][1][m][0] + bu0, u1 = acc[ai][1][m][1] + bu1;
                float h[8];
#pragma unroll
                for (int j = 0; j < 4; ++j) { const float ga = fminf(g0[j], 7.0f), ua = fminf(fmaxf(u0[j], -7.0f), 7.0f); h[j] = (ua + 1.0f) * ga * sigmoidf_(1.702f * ga);
                    const float gb = fminf(g1[j], 7.0f), ub = fminf(fmaxf(u1[j], -7.0f), 7.0f); h[4 + j] = (ub + 1.0f) * gb * sigmoidf_(1.702f * gb); }
                u32x4 w; w.x = cvt_pk_bf16(h[0], h[1]); w.y = cvt_pk_bf16(h[2], h[3]); w.z = cvt_pk_bf16(h[4], h[5]); w.w = cvt_pk_bf16(h[6], h[7]);
                *(u32x4*)(hid + (size_t)rr * 2048) = w;
            }
    }
};
struct EpiMoE2 {
    static constexpr bool PERM = true;
    unsigned char* ws; const float* b_down; MoeTables T;
    __device__ __forceinline__ void operator()(const AccT& acc, const Unit& u, int wr, int wc, int fr, int fq) const {
        const int n = T.cnt[u.g]; const float* lprob = (const float*)(ws + WS_LPROB) + u.g * 16384 + u.pm * 256;
        bf16_t* out2 = (bf16_t*)(ws + WS_OUT2) + (size_t)(T.tp[u.g] + u.pm) * 256 * 2048;
#pragma unroll
        for (int bj = 0; bj < 2; ++bj) {
            const int col = u.pn * 256 + bj * 128 + wc * 32 + 8 * fq;
            const f32x4 b0 = *(const f32x4*)(b_down + (size_t)u.g * 2048 + col), b1 = *(const f32x4*)(b_down + (size_t)u.g * 2048 + col + 4);
#pragma unroll
            for (int ai = 0; ai < 2; ++ai)
#pragma unroll
                for (int m = 0; m < 4; ++m) {
                    const int rr = ai * 128 + wr * 64 + m * 16 + fr;
                    const float pr = (u.pm * 256 + rr < n) ? lprob[rr] : 0.f;
                    const f32x4 v0 = (acc[ai][bj][m][0] + b0) * pr, v1 = (acc[ai][bj][m][1] + b1) * pr;
                    u32x4 w; w.x = cvt_pk_bf16(v0[0], v0[1]); w.y = cvt_pk_bf16(v0[2], v0[3]); w.z = cvt_pk_bf16(v1[0], v1[1]); w.w = cvt_pk_bf16(v1[2], v1[3]);
                    *(u32x4*)(out2 + (size_t)rr * 2048 + col) = w;
                    asm volatile("" ::: "memory");
                }
        }
    }
};
__device__ __forceinline__ void phase_conv(const Params& p, LAS unsigned char* lds, int wv) {
    const int t = make_tid(wv);
    LAS float* cw = (LAS float*)lds;
    for (int i = t; i < 9216; i += NTHR) cw[i] = p.conv_qk[i];
    __syncthreads();
    const bf16_t* z = (const bf16_t*)(p.ws + WS_ZQK);
    bf16_t* qk = (bf16_t*)(p.ws + WS_QK);
    const int cg = t & 127, rsub = t >> 7, ch0 = cg * 8;
    for (int it = 0; it < NTOK / (NWG * 4); ++it) {
        const int row = 4 * (blockIdx.x + NWG * it) + rsub;
        float acc[8];
#pragma unroll
        for (int j = 0; j < 8; ++j) acc[j] = 0.f;
        const bool lat = row < NLAT;
        int bbase, gr, gc, ncol, nrowmax;
        if (lat) { const int l = row & 2047; bbase = row - l; gr = l >> 6; gc = l & 63; ncol = 64; nrowmax = 32; }
        else { const int rr = row - NLAT, l = rr & 255; bbase = row - l; gr = 0; gc = l; ncol = 256; nrowmax = 1; }
#pragma unroll
        for (int dy = -1; dy <= 1; ++dy)
#pragma unroll
            for (int dx = -1; dx <= 1; ++dx) {
                const int r2 = gr + dy, c2 = gc + dx;
                if (r2 >= 0 && r2 < nrowmax && c2 >= 0 && c2 < ncol) {
                    const u32x4 zv = *(const u32x4*)(z + (size_t)(bbase + r2 * ncol + c2) * 1024 + ch0);
                    LAS const float* w = cw + ((dy + 1) * 3 + (dx + 1)) * 1024 + ch0;
                    const f32x4 w0 = *(LAS const f32x4*)w, w1 = *(LAS const f32x4*)(w + 4);
                    acc[0] += w0[0] * bflo(zv.x); acc[1] += w0[1] * bfhi(zv.x); acc[2] += w0[2] * bflo(zv.y); acc[3] += w0[3] * bfhi(zv.y);
                    acc[4] += w1[0] * bflo(zv.z); acc[5] += w1[1] * bfhi(zv.z); acc[6] += w1[2] * bflo(zv.w); acc[7] += w1[3] * bfhi(zv.w);
                }
            }
        const float sc = ch0 >= 512 ? 0.08838834764831845f : 1.0f;
#pragma unroll
        for (int j = 0; j < 8; ++j) acc[j] = acc[j] * sigmoidf_(acc[j]) * sc;
        u32x4 o; o.x = cvt_pk_bf16(acc[0], acc[1]); o.y = cvt_pk_bf16(acc[2], acc[3]); o.z = cvt_pk_bf16(acc[4], acc[5]); o.w = cvt_pk_bf16(acc[6], acc[7]);
        *(u32x4*)(qk + (size_t)row * 1024 + ch0) = o;
    }
    __syncthreads();
}

__device__ __forceinline__ void phase_s5scan(const Params& p, int wv) {
    const int t = make_tid(wv); if (t >= 256) return;
    const int idx = blockIdx.x * 256 + t, pp = idx & 63, b = (idx >> 6) & 7, dir = (idx >> 9) & 1, g = idx >> 10;
    const float* lb16 = (const float*)(p.ws + WS_LB16) + (size_t)((dir * 64 + g) * 64 + pp) * 2;
    const float ar = lb16[0], ai = lb16[1];
    const float* V = (const float*)(p.ws + WS_VS5) + (size_t)g * 1280 * 256 + dir * 128 + pp;
    bf16_t* X = (bf16_t*)(p.ws + WS_AS5) + (size_t)g * 1280 * 512 + 256 + dir * 128 + pp;
    float xr = 0.f, xi = 0.f;
    {   float vr[16], vi[16];
#pragma unroll
        for (int k = 0; k < 16; ++k) { const int cix = dir ? 15 - k : k; const float* v = V + (size_t)(1024 + b * 16 + cix) * 256; vr[k] = v[0]; vi[k] = v[64]; }
#pragma unroll
        for (int k = 0; k < 16; ++k) { const float nr = ar * xr - ai * xi + vr[k], ni = ar * xi + ai * xr + vi[k]; xr = nr; xi = ni; } }
    for (int blk = 0; blk < 16; ++blk) {
        float vr[8], vi[8];
#pragma unroll
        for (int k = 0; k < 8; ++k) { const int cc = blk * 8 + k, cix = dir ? 127 - cc : cc; const float* v = V + (size_t)(b * 128 + cix) * 256; vr[k] = v[0]; vi[k] = v[64]; }
#pragma unroll
        for (int k = 0; k < 8; ++k) { const int cc = blk * 8 + k, cix = dir ? 127 - cc : cc; bf16_t* x = X + (size_t)(b * 128 + cix) * 512; x[0] = f2bf(xr); x[64] = f2bf(xi);
            const float nr = ar * xr - ai * xi + vr[k], ni = ar * xi + ai * xr + vi[k]; xr = nr; xi = ni; }
    }
}

template <int OFF1> __device__ __forceinline__ bf16x8 tr_frag(unsigned addr) {
    s16x4 a, b;
    asm volatile("ds_read_b64_tr_b16 %0, %2\n\tds_read_b64_tr_b16 %1, %2 offset:%3\n\ts_waitcnt lgkmcnt(0)" : "=&v"(a), "=&v"(b) : "v"(addr), "i"(OFF1) : "memory");
    bf16x8 r; r[0] = a[0]; r[1] = a[1]; r[2] = a[2]; r[3] = a[3]; r[4] = b[0]; r[5] = b[1]; r[6] = b[2]; r[7] = b[3]; return r;
}
constexpr int ML_QS = 0, ML_KS = 17408, ML_VS = 34816, ML_WVS = 46080, ML_SS = 57344, ML_CS = 66560, ML_VEC = 89088;
__device__ __forceinline__ void phase_mlstm(const Params& p, LAS unsigned char* lds, int wv) {
    const int t = make_tid(wv);
    const int lane = t & 63, wid = wv, c = blockIdx.x;
    const int bh = c & 31, b = bh >> 2, hd = bh & 3, dq = c >> 5, dir = dq >> 2, qt = dq & 3;
    const int l15 = lane & 15, g4 = lane >> 4, q4 = (lane & 15) >> 2, p4 = lane & 3;
    LAS float* vec = (LAS float*)(lds + ML_VEC);
    const unsigned ldsb = (unsigned)(size_t)lds;
    for (int i = t; i < 128 * 176 / 4; i += NTHR) ((LAS unsigned*)(lds + ML_CS))[i] = 0u;
    for (int i = t; i < 64 * 8; i += NTHR) { const int s = i >> 3, w = i & 7; ((LAS unsigned*)(lds + ML_VS + s * 176 + 128))[w] = (w == 0) ? 0x00003f80u : 0u; ((LAS unsigned*)(lds + ML_WVS + s * 176 + 128))[w] = 0u; }
    const bf16_t* QK = (const bf16_t*)(p.ws + WS_QK); const bf16_t* VB = (const bf16_t*)(p.ws + WS_VBUF); const float* GT = (const float*)(p.ws + WS_GATES);
    float* HB = (float*)(p.ws + WS_HBUF) + (size_t)dir * NLAT * 1024;
    f32x4 accC[5];
#pragma unroll
    for (int v = 0; v < 5; ++v) accC[v] = (f32x4){0.f, 0.f, 0.f, 0.f};
    float m0 = 0.f;
    u32x4 rq[2], rk[2], rv; float rig = 0.f, rlf = 0.f;
    auto tokbase = [&](int st) -> int { if (st < 4) { const int cc = dir ? 3 - st : st; return NLAT + b * 256 + cc * 64; } const int cc = dir ? 31 - (st - 4) : (st - 4); return b * 2048 + cc * 64; };
    auto issue = [&](int st) {
        const int base = tokbase(st);
#pragma unroll
        for (int i = 0; i < 2; ++i) { const int id = t + 512 * i, j = id >> 4, ch = id & 15; const size_t row = (size_t)(base + (dir ? 63 - j : j));
            if (st >= 4) rq[i] = *(const u32x4*)(QK + row * 1024 + hd * 128 + ch * 8);
            rk[i] = *(const u32x4*)(QK + row * 1024 + 512 + hd * 128 + ch * 8); }
        { const int j = t >> 3, ch = t & 7; const size_t row = (size_t)(base + (dir ? 63 - j : j)); rv = *(const u32x4*)(VB + row * 1024 + hd * 256 + qt * 64 + ch * 8); }
        if (t < 64) { const size_t row = (size_t)(base + (dir ? 63 - t : t)); rig = GT[row * 16 + (2 * dir) * 4 + hd]; rlf = GT[row * 16 + (2 * dir + 1) * 4 + hd]; }
    };
    issue(0);
    __syncthreads();
    for (int st = 0; st < 36; ++st) {
        const bool lat = st >= 4;
        const int base = tokbase(st);
#pragma unroll
        for (int i = 0; i < 2; ++i) { const int id = t + 512 * i, j = id >> 4, ch = id & 15;
            if (lat) *(LAS u32x4*)(lds + ML_QS + j * 272 + ch * 16) = rq[i];
            *(LAS u32x4*)(lds + ML_KS + j * 272 + ch * 16) = rk[i]; }
        { const int j = t >> 3, ch = t & 7; *(LAS u32x4*)(lds + ML_VS + j * 176 + ch * 16) = rv; }
        if (wid == 0) {
            float bc = rlf;
#pragma unroll
            for (int o = 1; o < 64; o <<= 1) { const float n = __shfl_up(bc, o); if (lane >= o) bc += n; }
            const float gtot = __shfl(bc, 63);
            const float beta = rig - bc;
            float pm = beta;
#pragma unroll
            for (int o = 1; o < 64; o <<= 1) { const float n = __shfl_up(pm, o); if (lane >= o) pm = fmaxf(pm, n); }
            const float mm = fmaxf(m0, pm);
            const float mloc = gtot + __shfl(pm, 63);
            const float mnew = fmaxf(gtot + m0, mloc);
            vec[lane] = -mm; vec[64 + lane] = beta; vec[128 + lane] = __expf(m0 - mm); vec[192 + lane] = __expf(-(bc + mm)); vec[256 + lane] = __expf(gtot + beta - mnew);
            if (lane == 0) vec[320] = __expf(gtot + m0 - mnew);
            m0 = mnew;
        }
        if (st + 1 < 36) issue(st + 1);
        __syncthreads();
        if (lat) {
#pragma unroll
            for (int ii = 0; ii < 2; ++ii) { const int idx = 2 * wid + ii, jt = idx >> 2, stl = idx & 3;
                f32x4 a4 = (f32x4){0.f, 0.f, 0.f, 0.f};
                if (stl <= jt) {
#pragma unroll
                    for (int ks = 0; ks < 4; ++ks) { const bf16x8 A = *(const LAS bf16x8*)(lds + ML_QS + (jt * 16 + l15) * 272 + (ks * 32 + 8 * g4) * 2);
                        const bf16x8 B = *(const LAS bf16x8*)(lds + ML_KS + (stl * 16 + l15) * 272 + (ks * 32 + 8 * g4) * 2);
                        a4 = __builtin_amdgcn_mfma_f32_16x16x32_bf16(A, B, a4, 0, 0, 0); }
                }
                const int sp = stl * 16 + l15; const float be = vec[64 + sp];
#pragma unroll
                for (int r = 0; r < 4; ++r) { const int jp = jt * 16 + 4 * g4 + r; const float v = (sp <= jp) ? a4[r] * __expf(vec[jp] + be) : 0.f;
                    *(LAS bf16_t*)(lds + ML_SS + jp * 144 + sp * 2) = f2bf(v); }
            }
        }
        { const int s = t >> 3, ch = t & 7; const float w = vec[256 + s]; const u32x4 vv = *(const LAS u32x4*)(lds + ML_VS + s * 176 + ch * 16); u32x4 o;
          o.x = cvt_pk_bf16(w * bflo(vv.x), w * bfhi(vv.x)); o.y = cvt_pk_bf16(w * bflo(vv.y), w * bfhi(vv.y)); o.z = cvt_pk_bf16(w * bflo(vv.z), w * bfhi(vv.z)); o.w = cvt_pk_bf16(w * bflo(vv.w), w * bfhi(vv.w));
          *(LAS u32x4*)(lds + ML_WVS + s * 176 + ch * 16) = o;
          if (t < 64) *(LAS bf16_t*)(lds + ML_WVS + t * 176 + 128) = f2bf(vec[256 + t]); }
        __syncthreads();
        if (lat) {
            const int jt = wid >> 1; f32x4 o3[3];
#pragma unroll
            for (int ti = 0; ti < 3; ++ti) { const int vt = (ti == 2) ? 4 : ((wid & 1) * 2 + ti);
                f32x4 a4 = (f32x4){0.f, 0.f, 0.f, 0.f};
#pragma unroll
                for (int ks = 0; ks < 4; ++ks) { const bf16x8 A = *(const LAS bf16x8*)(lds + ML_QS + (jt * 16 + l15) * 272 + (ks * 32 + 8 * g4) * 2);
                    const bf16x8 B = tr_frag<4 * 176>(ldsb + ML_CS + (ks * 32 + 8 * g4 + q4) * 176 + (vt * 16 + 4 * p4) * 2);
                    a4 = __builtin_amdgcn_mfma_f32_16x16x32_bf16(A, B, a4, 0, 0, 0); }
#pragma unroll
                for (int r = 0; r < 4; ++r) a4[r] *= vec[128 + jt * 16 + 4 * g4 + r];
#pragma unroll
                for (int ks = 0; ks < 2; ++ks) { const bf16x8 A = *(const LAS bf16x8*)(lds + ML_SS + (jt * 16 + l15) * 144 + (ks * 32 + 8 * g4) * 2);
                    const bf16x8 B = tr_frag<4 * 176>(ldsb + ML_VS + (ks * 32 + 8 * g4 + q4) * 176 + (vt * 16 + 4 * p4) * 2);
                    a4 = __builtin_amdgcn_mfma_f32_16x16x32_bf16(A, B, a4, 0, 0, 0); }
                o3[ti] = a4; }
            float inv[4];
#pragma unroll
            for (int r = 0; r < 4; ++r) { const float dn = __shfl(o3[2][r], lane & 48); inv[r] = 1.0f / fmaxf(fabsf(dn), vec[192 + jt * 16 + 4 * g4 + r]); }
#pragma unroll
            for (int ti = 0; ti < 2; ++ti) { const int vt = (wid & 1) * 2 + ti;
#pragma unroll
                for (int r = 0; r < 4; ++r) { const int jp = jt * 16 + 4 * g4 + r; const size_t row = (size_t)(base + (dir ? 63 - jp : jp));
                    HB[row * 1024 + hd * 256 + qt * 64 + vt * 16 + l15] = o3[ti][r] * inv[r]; } }
        }
        { const float sprev = vec[320];
          bf16x8 Bk[2];
#pragma unroll
          for (int ks = 0; ks < 2; ++ks) Bk[ks] = tr_frag<4 * 272>(ldsb + ML_KS + (ks * 32 + 8 * g4 + q4) * 272 + (wid * 16 + 4 * p4) * 2);
#pragma unroll
          for (int vt = 0; vt < 5; ++vt) { accC[vt] *= sprev;
#pragma unroll
              for (int ks = 0; ks < 2; ++ks) { const bf16x8 A = tr_frag<4 * 176>(ldsb + ML_WVS + (ks * 32 + 8 * g4 + q4) * 176 + (vt * 16 + 4 * p4) * 2);
                  accC[vt] = __builtin_amdgcn_mfma_f32_16x16x32_bf16(A, Bk[ks], accC[vt], 0, 0, 0); } } }
        __syncthreads();
#pragma unroll
        for (int vt = 0; vt < 5; ++vt) { u32x2 w; w.x = cvt_pk_bf16(accC[vt][0], accC[vt][1]); w.y = cvt_pk_bf16(accC[vt][2], accC[vt][3]);
            *(LAS u32x2*)(lds + ML_CS + (wid * 16 + l15) * 176 + (vt * 16 + 4 * g4) * 2) = w; }
    }
    __syncthreads();
}

__device__ __forceinline__ void phase_hmerge(const Params& p, int wv) {
    const int t = make_tid(wv);
    const int lane = t & 63, wid = t >> 6;
    const float* H0 = (const float*)(p.ws + WS_HBUF); const float* H1 = H0 + (size_t)NLAT * 1024;
    const bf16_t* O = (const bf16_t*)(p.ws + WS_OBUF); bf16_t* CAT = (bf16_t*)(p.ws + WS_CAT);
    for (int i = 0; i < 8; ++i) { const size_t row = (size_t)blockIdx.x * 64 + wid * 8 + i;
#pragma unroll
        for (int hd = 0; hd < 4; ++hd) { const int col = hd * 256 + lane * 4;
            const f32x4 a = *(const f32x4*)(H0 + row * 1024 + col), bb = *(const f32x4*)(H1 + row * 1024 + col); const f32x4 h = a + bb;
            const float ss = wave_sum(h[0] * h[0] + h[1] * h[1] + h[2] * h[2] + h[3] * h[3]);
            const float rstd = rsqrtf(ss * (1.0f / 256.0f) + 1e-6f);
            const f32x4 gg = *(const f32x4*)(p.head_g + col); const u32x2 ow = *(const u32x2*)(O + row * 1024 + col);
            const float o0 = h[0] * rstd * gg[0] * sigmoidf_(bflo(ow.x)), o1 = h[1] * rstd * gg[1] * sigmoidf_(bfhi(ow.x)), o2 = h[2] * rstd * gg[2] * sigmoidf_(bflo(ow.y)), o3 = h[3] * rstd * gg[3] * sigmoidf_(bfhi(ow.y));
            u32x2 w; w.x = cvt_pk_bf16(o0, o1); w.y = cvt_pk_bf16(o2, o3);
            *(u32x2*)(CAT + row * 2048 + col) = w; } }
}
constexpr int RT_XR = 0, RT_XSTRIDE = 8208, RT_RED = 16 * RT_XSTRIDE  , RT_LG = RT_RED + 8 * 16 * 32 * 4  , RT_RSTD = RT_LG + 2048, RT_SEL = RT_RSTD + 64;
__device__ __forceinline__ void phase_router(const Params& p, LAS unsigned char* lds, int wv) {
    const int t = make_tid(wv);
    const int lane = t & 63, wid = wv, l15 = lane & 15, g4 = lane >> 4;
    const float* X1 = (const float*)(p.ws + WS_X1); bf16_t* U2 = (bf16_t*)(p.ws + WS_U2); const bf16_t* WRT = (const bf16_t*)(p.ws + WS_WRT);
    LAS float* red = (LAS float*)(lds + RT_RED); LAS float* lg = (LAS float*)(lds + RT_LG); LAS float* rstd = (LAS float*)(lds + RT_RSTD);
    LAS int* se = (LAS int*)(lds + RT_SEL); LAS float* sp = (LAS float*)(lds + RT_SEL + 1024); LAS int* sr = (LAS int*)(lds + RT_SEL + 2048); LAS int* lc = (LAS int*)(lds + RT_SEL + 3072); LAS int* lbase = lc + 32;
    const int bidx = blockIdx.x >> 5;
    const float* mod = (const float*)(p.ws + WS_MOD) + (size_t)bidx * 12288; const float* sh2 = mod + 3 * 2048; const float* sc2 = mod + 4 * 2048;
    if (t < 32) lc[t] = 0;
    for (int it = 0; it < 4; ++it) {
        const int row0 = blockIdx.x * 64 + it * 16;
        for (int i = 0; i < 16; ++i) { const int id = t + NTHR * i, r = id >> 9, c4 = id & 511; *(LAS f32x4*)(lds + RT_XR + r * RT_XSTRIDE + c4 * 16) = *(const f32x4*)(X1 + (size_t)(row0 + r) * 2048 + c4 * 4); }
        __syncthreads();
#pragma unroll
        for (int rr = 0; rr < 2; ++rr) { const int r = wid * 2 + rr; float ss = 0.f;
#pragma unroll
            for (int i = 0; i < 8; ++i) { const f32x4 v = *(const LAS f32x4*)(lds + RT_XR + r * RT_XSTRIDE + (i * 64 + lane) * 16); ss += v[0] * v[0] + v[1] * v[1] + v[2] * v[2] + v[3] * v[3]; }
            ss = wave_sum(ss); if (lane == 0) rstd[r] = rsqrtf(ss * (1.0f / 2048.0f) + 1e-6f); }
        __syncthreads();
        f32x4 acc[2]; acc[0] = (f32x4){0.f, 0.f, 0.f, 0.f}; acc[1] = acc[0];
        const float rs = rstd[l15];
#pragma unroll 2
        for (int s = 0; s < 8; ++s) { const int k0 = wid * 256 + s * 32 + 8 * g4;
            const f32x4 x0 = *(const LAS f32x4*)(lds + RT_XR + l15 * RT_XSTRIDE + k0 * 4), x1 = *(const LAS f32x4*)(lds + RT_XR + l15 * RT_XSTRIDE + k0 * 4 + 16);
            const f32x4 ga = *(const f32x4*)(p.norm2_g + k0), gb = *(const f32x4*)(p.norm2_g + k0 + 4), sa = *(const f32x4*)(sc2 + k0), sb = *(const f32x4*)(sc2 + k0 + 4), ha = *(const f32x4*)(sh2 + k0), hb = *(const f32x4*)(sh2 + k0 + 4);
            const f32x4 u0 = x0 * rs * ga * (sa + 1.0f) + ha, u1 = x1 * rs * gb * (sb + 1.0f) + hb;
            u32x4 hi; hi.x = cvt_pk_bf16(u0[0], u0[1]); hi.y = cvt_pk_bf16(u0[2], u0[3]); hi.z = cvt_pk_bf16(u1[0], u1[1]); hi.w = cvt_pk_bf16(u1[2], u1[3]);
            *(u32x4*)(U2 + (size_t)(row0 + l15) * 2048 + k0) = hi;
            u32x4 lo; lo.x = cvt_pk_bf16(u0[0] - bflo(hi.x), u0[1] - bfhi(hi.x)); lo.y = cvt_pk_bf16(u0[2] - bflo(hi.y), u0[3] - bfhi(hi.y));
            lo.z = cvt_pk_bf16(u1[0] - bflo(hi.z), u1[1] - bfhi(hi.z)); lo.w = cvt_pk_bf16(u1[2] - bflo(hi.w), u1[3] - bfhi(hi.w));
            bf16x8 Ah, Al; __builtin_memcpy(&Ah, &hi, 16); __builtin_memcpy(&Al, &lo, 16);
#pragma unroll
            for (int nt = 0; nt < 2; ++nt) { const bf16x8 Bh = *(const bf16x8*)(WRT + (size_t)(nt * 16 + l15) * 2048 + k0), Bl = *(const bf16x8*)(WRT + (size_t)(32 + nt * 16 + l15) * 2048 + k0);
                acc[nt] = __builtin_amdgcn_mfma_f32_16x16x32_bf16(Ah, Bh, acc[nt], 0, 0, 0); acc[nt] = __builtin_amdgcn_mfma_f32_16x16x32_bf16(Ah, Bl, acc[nt], 0, 0, 0); acc[nt] = __builtin_amdgcn_mfma_f32_16x16x32_bf16(Al, Bh, acc[nt], 0, 0, 0); } }
#pragma unroll
        for (int nt = 0; nt < 2; ++nt)
#pragma unroll
            for (int r = 0; r < 4; ++r) red[(wid * 16 + 4 * g4 + r) * 32 + nt * 16 + l15] = acc[nt][r];
        __syncthreads();
        { const int tok = t >> 5, e = t & 31; float s = p.b_router[e];
#pragma unroll
          for (int w = 0; w < 8; ++w) s += red[(w * 16 + tok) * 32 + e];
          lg[tok * 32 + e] = s; }
        __syncthreads();
        if (t < 16) { float v[4]; int ix[4];
#pragma unroll
            for (int k = 0; k < 4; ++k) { float best = -3.0e38f; int bi = 0;
                for (int e = 0; e < 32; ++e) { const float x = lg[t * 32 + e]; bool taken = false;
#pragma unroll
                    for (int k2 = 0; k2 < 4; ++k2) taken = taken || (k2 < k && ix[k2] == e);
                    if (!taken && x > best) { best = x; bi = e; } }
                v[k] = best; ix[k] = bi; }
            const float e1 = __expf(v[1] - v[0]), e2 = __expf(v[2] - v[0]), e3 = __expf(v[3] - v[0]), inv = 1.0f / (1.0f + e1 + e2 + e3);
            const int tl = it * 16 + t;
            se[tl * 4 + 0] = ix[0]; se[tl * 4 + 1] = ix[1]; se[tl * 4 + 2] = ix[2]; se[tl * 4 + 3] = ix[3];
            sp[tl * 4 + 0] = inv; sp[tl * 4 + 1] = e1 * inv; sp[tl * 4 + 2] = e2 * inv; sp[tl * 4 + 3] = e3 * inv; }
        __syncthreads();
    }
    if (t < 256) sr[t] = atomicAdd((int*)&lc[se[t]], 1);
    __syncthreads();
    if (t < 32) lbase[t] = (int)atomicAdd((unsigned*)(p.ws + WS_CTRL + CTRL_CNT) + t, (unsigned)lc[t]);
    __syncthreads();
    if (t < 256) { const int e = se[t], pos = lbase[e] + sr[t], tok = blockIdx.x * 64 + (t >> 2);
        ((int*)(p.ws + WS_LIST))[e * 16384 + pos] = tok; ((float*)(p.ws + WS_LPROB))[e * 16384 + pos] = sp[t];
        ((int*)(p.ws + WS_TKE))[tok * 4 + (t & 3)] = e; ((int*)(p.ws + WS_TKP))[tok * 4 + (t & 3)] = pos; }
    __syncthreads();
}

__device__ __forceinline__ MoeTables moe_tables(const Params& p, LAS unsigned char* lds_tab, int wv) {
    const int t = make_tid(wv);
    LAS int* tp = (LAS int*)lds_tab; LAS int* cnt = tp + 64;
    const unsigned* gc = (const unsigned*)(p.ws + WS_CTRL + CTRL_CNT);
    if (t < 32) cnt[t] = (int)__hip_atomic_load(gc + t, __ATOMIC_RELAXED, __HIP_MEMORY_SCOPE_AGENT);
    __syncthreads();
    if (t == 0) { int s = 0; for (int e = 0; e < 32; ++e) { tp[e] = s; s += (cnt[e] + 255) >> 8; } tp[32] = s; }
    __syncthreads();
    MoeTables T; T.tp = tp; T.cnt = cnt; return T;
}

__device__ __forceinline__ void phase_final(const Params& p, const MoeTables& T, int wv) {
    const int t = make_tid(wv);
    const int lane = t & 63, wid = t >> 6;
    const float* X1 = (const float*)(p.ws + WS_X1); const bf16_t* O2 = (const bf16_t*)(p.ws + WS_OUT2);
    const int* tke = (const int*)(p.ws + WS_TKE); const int* tkp = (const int*)(p.ws + WS_TKP);
    for (int i = 0; i < 8; ++i) { const int row = blockIdx.x * 64 + wid * 8 + i;
        const float* g2 = (const float*)(p.ws + WS_MOD) + (size_t)(row >> 11) * 12288 + 5 * 2048;
        size_t srow[4];
#pragma unroll
        for (int k = 0; k < 4; ++k) { const int e = tke[row * 4 + k], pos = tkp[row * 4 + k]; srow[k] = (size_t)(T.tp[e] * 256 + pos) * 2048; }
        f32x4 v[8]; float ss = 0.f;
#pragma unroll
        for (int j = 0; j < 8; ++j) { const int col = (j * 64 + lane) * 4; f32x4 m = (f32x4){0.f, 0.f, 0.f, 0.f};
#pragma unroll
            for (int k = 0; k < 4; ++k) { const u32x2 w = *(const u32x2*)(O2 + srow[k] + col); m[0] += bflo(w.x); m[1] += bfhi(w.x); m[2] += bflo(w.y); m[3] += bfhi(w.y); }
            const f32x4 x = *(const f32x4*)(X1 + (size_t)row * 2048 + col), gg = *(const f32x4*)(g2 + col);
            v[j] = x + gg * m; ss += v[j][0] * v[j][0] + v[j][1] * v[j][1] + v[j][2] * v[j][2] + v[j][3] * v[j][3]; }
        ss = wave_sum(ss); const float rstd = rsqrtf(ss * (1.0f / 2048.0f) + 1e-6f);
#pragma unroll
        for (int j = 0; j < 8; ++j) { const int col = (j * 64 + lane) * 4; const f32x4 fg = *(const f32x4*)(p.final_g + col); *(f32x4*)(p.out + (size_t)row * 2048 + col) = v[j] * rstd * fg; }
    }
}
#ifndef DEV_STAGE
#define DEV_STAGE 9
#endif
__device__ __forceinline__ void phase_final_simple(const Params& p, const float* src, int wv) {
    const int t = make_tid(wv), lane = t & 63, wid = t >> 6;
    for (int i = 0; i < 8; ++i) { const int row = blockIdx.x * 64 + wid * 8 + i; f32x4 v[8]; float ss = 0.f;
#pragma unroll
        for (int j = 0; j < 8; ++j) { v[j] = *(const f32x4*)(src + (size_t)row * 2048 + (j * 64 + lane) * 4); ss += v[j][0] * v[j][0] + v[j][1] * v[j][1] + v[j][2] * v[j][2] + v[j][3] * v[j][3]; }
        ss = wave_sum(ss); const float rstd = rsqrtf(ss * (1.0f / 2048.0f) + 1e-6f);
#pragma unroll
        for (int j = 0; j < 8; ++j) { const int col = (j * 64 + lane) * 4; *(f32x4*)(p.out + (size_t)row * 2048 + col) = v[j] * rstd * *(const f32x4*)(p.final_g + col); } }
}

__global__ void __launch_bounds__(512, 2) fwd_kernel(Params p) {
    extern __shared__ __attribute__((aligned(16))) unsigned char smem[];
    LAS unsigned char* lds = (LAS unsigned char*)smem;
    volatile LAS unsigned* xbw = (volatile LAS unsigned*)(lds + LDS_BYTES - 16);
    const int wv = __builtin_amdgcn_readfirstlane(threadIdx.x >> 6);
    const bool t0 = (wv == 0 && lane_id() == 0);
    if (t0) { xbw[0] = 0u; xbw[1] = 0u; xbw[2] = 0u; xbw[3] = 0u; }
    __syncthreads();
    XcdBarrier bar = xcd_barrier_post((unsigned*)(p.ws + WS_CTRL), xbw, t0);
    const int c = blockIdx.x;

    phase0(p, lds, wv);
    xcd_barrier(bar, wv);
    phase1(p, lds, wv);
    xcd_barrier(bar, wv);
#if DEV_STAGE == 1
    phase_final_simple(p, p.x, wv);
#else
    { SchedInProj S; S.ws = p.ws; S.c = c; EpiInProj E; E.ws = p.ws; pg8::gemm_phase<EpiInProj, SchedInProj, 2048, 2048, false>(lds, S, E, wv); }
    xcd_barrier(bar, wv);
    { SchedS5V S; S.ws = p.ws; S.c = c; EpiS5V E; E.ws = p.ws; pg8::gemm_phase<EpiS5V, SchedS5V, 256, 512, false>(lds, S, E, wv); }
    phase_conv(p, lds, wv);
    xcd_barrier(bar, wv);
    phase_s5scan(p, wv);
#if DEV_STAGE >= 3
    phase_mlstm(p, lds, wv);
#endif
    xcd_barrier(bar, wv);
    { SchedS5Y S; S.ws = p.ws; S.c = c; EpiS5Y E; E.ws = p.ws; E.s5_d = p.s5_d; pg8::gemm_phase<EpiS5Y, SchedS5Y, 512, 512, false>(lds, S, E, wv); }
#if DEV_STAGE >= 3
    phase_hmerge(p, wv);
#else
    { bf16_t* CAT = (bf16_t*)(p.ws + WS_CAT); for (int i = make_tid(wv); i < 64 * 128; i += NTHR) { const int r = i >> 7, q = i & 127; *(u32x4*)(CAT + ((size_t)blockIdx.x * 64 + r) * 2048 + q * 8) = (u32x4){0u, 0u, 0u, 0u}; } }
#endif
    xcd_barrier(bar, wv);
    { SchedStatic<4> S; S.A = (const char*)(p.ws + WS_SBUF); S.Bt = (const char*)(p.ws + WS_WGLU_T); S.c = c; S.a_tile_bytes = (size_t)256 * 1024 * 2; S.b_tile_bytes = (size_t)256 * 1024 * 2;
      EpiGLU E; E.ws = p.ws; pg8::gemm_phase<EpiGLU, SchedStatic<4>, 1024, 1024, false>(lds, S, E, wv); }
    xcd_barrier(bar, wv);
    { SchedStatic<8> S; S.A = (const char*)(p.ws + WS_CAT); S.Bt = (const char*)(p.ws + WS_WOUT_T); S.c = c; S.a_tile_bytes = (size_t)256 * 2048 * 2; S.b_tile_bytes = (size_t)256 * 2048 * 2;
      EpiOut E; E.ws = p.ws; E.x = p.x; pg8::gemm_phase<EpiOut, SchedStatic<8>, 2048, 2048, false>(lds, S, E, wv); }
    xcd_barrier(bar, wv);
#if DEV_STAGE < 9
    phase_final_simple(p, (const float*)(p.ws + WS_X1), wv);
#else
    phase_router(p, lds, wv);
    xcd_barrier(bar, wv);
    const MoeTables T = moe_tables(p, lds + 139264, wv);
    { SchedMoE<16> S; S.ws = p.ws; S.c = c; S.T = T; S.A = (const char*)(p.ws + WS_U2); S.Bt = (const char*)(p.ws + WS_WGU_T); S.b_expert_bytes = (size_t)4096 * 2048 * 2;
      EpiMoE1 E; E.ws = p.ws; E.b_gu = p.b_gu; E.T = T; pg8::gemm_phase<EpiMoE1, SchedMoE<16>, 2048, 2048, true>(lds, S, E, wv); }
    xcd_barrier(bar, wv);
    { SchedMoE2 S; S.ws = p.ws; S.c = c; S.T = T; S.A = (const char*)(p.ws + WS_HID); S.Bt = (const char*)(p.ws + WS_WDN_T); S.b_expert_bytes = (size_t)2048 * 2048 * 2;
      EpiMoE2 E; E.ws = p.ws; E.b_down = p.b_down; E.T = T; pg8::gemm_phase<EpiMoE2, SchedMoE2, 2048, 2048, false>(lds, S, E, wv); }
    xcd_barrier(bar, wv);
    phase_final(p, T, wv);
#endif
#endif
}

extern "C" void kernel_launch(void* const* d_in, const int* in_sizes, int n_in, void* d_out, int out_size, void* d_ws, size_t ws_size, hipStream_t stream) {
    static int ready = 0;
    if (ready == 0) {
        if (n_in != 29 || out_size != NLAT * D || ws_size < WS_END) { fprintf(stderr, "kernel_launch: unexpected shapes (n_in %d out %d ws %zu need %zu)\n", n_in, out_size, ws_size, (size_t)WS_END); ready = -1; return; }
        if (hipFuncSetAttribute((const void*)fwd_kernel, hipFuncAttributeMaxDynamicSharedMemorySize, LDS_BYTES) != hipSuccess) { fprintf(stderr, "kernel_launch: hipFuncSetAttribute failed\n"); ready = -1; return; }
        ready = 1;
    }
    if (ready < 0) return;
    (void)hipMemsetAsync((char*)d_ws + WS_CTRL, 0, CTRL_BYTES, stream);
    Params p;
    memset(&p, 0, sizeof(p));
    const float** f = (const float**)&p;
    for (int i = 0; i < 29; ++i) f[i] = (const float*)d_in[i];
    p.out = (float*)d_out; p.ws = (unsigned char*)d_ws;
    hipLaunchKernelGGL(fwd_kernel, dim3(NWG), dim3(NTHR), LDS_BYTES, stream, p);
}
```

```cpp
#include <hip/hip_runtime.h>
#include <stdint.h>
#include <stdio.h>
#include <string.h>

#define LAS __attribute__((address_space(3)))
typedef unsigned short bf16_t;
typedef short bf16x8 __attribute__((ext_vector_type(8)));
typedef short s16x4 __attribute__((ext_vector_type(4)));
typedef float f32x4 __attribute__((ext_vector_type(4)));
typedef float f32x2 __attribute__((ext_vector_type(2)));
typedef unsigned u32x4 __attribute__((ext_vector_type(4)));
typedef unsigned u32x2 __attribute__((ext_vector_type(2)));

constexpr int D = 2048, NB = 8, SEQ = 2048, CTXL = 256;
constexpr int NLAT = NB * SEQ;
constexpr int NCTX = NB * CTXL;
constexpr int NTOK = NLAT + NCTX;
constexpr int DIN = 4112;
constexpr int NE = 32, TOPK = 4, DFF = 2048;
constexpr int NWG = 256, NTHR = 512;
constexpr int LDS_BYTES = 163840;
constexpr int MOE_ROWS = 73728;

constexpr size_t al256(size_t x) { return (x + 255) & ~(size_t)255; }
constexpr size_t WS_CTRL  = 0;
constexpr size_t CTRL_BYTES = 65536;
constexpr size_t CTRL_CNT = 16384;
constexpr size_t WS_MODP  = WS_CTRL + CTRL_BYTES;
constexpr size_t WS_MOD   = WS_MODP + (size_t)8 * 9 * 12288 * 4;
constexpr size_t WS_LB16  = WS_MOD + (size_t)9 * 12288 * 4;
constexpr size_t WS_WRT   = WS_LB16 + 65536;
constexpr size_t WS_WIN_T = WS_WRT + 262144;
constexpr size_t WS_WGLU_T = WS_WIN_T + (size_t)4096 * 2048 * 2;
constexpr size_t WS_WOUT_T = WS_WGLU_T + (size_t)1024 * 1024 * 2;
constexpr size_t WS_BTV   = WS_WOUT_T + (size_t)2048 * 2048 * 2;
constexpr size_t WS_BTY   = WS_BTV + (size_t)64 * 256 * 256 * 2;
constexpr size_t WS_U1    = WS_BTY + (size_t)64 * 256 * 512 * 2;
constexpr size_t WS_GATES = WS_U1 + (size_t)NTOK * 2048 * 2;
constexpr size_t WS_ZQK   = WS_GATES + (size_t)NTOK * 16 * 4;
constexpr size_t WS_QK    = WS_ZQK + (size_t)NTOK * 1024 * 2;
constexpr size_t WS_VBUF  = WS_QK + (size_t)NTOK * 1024 * 2;
constexpr size_t WS_OBUF  = WS_VBUF + (size_t)NTOK * 1024 * 2;
constexpr size_t WS_AS5   = WS_OBUF + (size_t)NLAT * 1024 * 2;
constexpr size_t WS_VS5   = WS_AS5 + (size_t)64 * 1280 * 512 * 2;
constexpr size_t WS_HBUF  = WS_VS5 + (size_t)64 * 1280 * 256 * 4;
constexpr size_t WS_SBUF  = WS_HBUF + (size_t)2 * NLAT * 1024 * 4;
constexpr size_t WS_CAT   = WS_SBUF + (size_t)NLAT * 1024 * 2;
constexpr size_t WS_X1    = WS_CAT + (size_t)NLAT * 2048 * 2;
constexpr size_t WS_U2    = WS_X1 + (size_t)NLAT * 2048 * 4;
constexpr size_t WS_TKE   = WS_U2 + (size_t)NLAT * 2048 * 2;
constexpr size_t WS_TKP   = WS_TKE + (size_t)NLAT * 16;
constexpr size_t WS_LIST  = WS_TKP + (size_t)NLAT * 16;
constexpr size_t WS_LPROB = WS_LIST + (size_t)32 * 16384 * 4;
constexpr size_t WS_HID   = WS_LPROB + (size_t)32 * 16384 * 4;
constexpr size_t WS_OUT2  = WS_HID + (size_t)MOE_ROWS * 2048 * 2;
constexpr size_t WS_WGU_T = WS_OUT2 + (size_t)MOE_ROWS * 2048 * 2;
constexpr size_t WS_WDN_T = WS_WGU_T + (size_t)32 * 4096 * 2048 * 2;
constexpr size_t WS_END   = WS_WDN_T + (size_t)32 * 2048 * 2048 * 2;

struct Params {
    const float *x, *c, *ctx, *c_ctx, *w_ada, *b_ada, *norm1_g, *w_in, *conv_qk, *gate_bias, *head_g,
                *lam_re, *lam_im, *log_dt, *b_re, *b_im, *c_re, *c_im, *s5_d, *w_glu, *w_out, *norm2_g,
                *w_router, *b_router, *w_gu, *b_gu, *w_down, *b_down, *final_g;
    float* out;
    unsigned char* ws;
};

__device__ __forceinline__ unsigned cvt_pk_bf16(float lo, float hi) { unsigned r; asm volatile("v_cvt_pk_bf16_f32 %0, %1, %2" : "=v"(r) : "v"(lo), "v"(hi)); return r; }
__device__ __forceinline__ unsigned cvt4_fp8(float a, float b, float c, float d) { int w = 0; w = __builtin_amdgcn_cvt_pk_fp8_f32(a, b, w, false); w = __builtin_amdgcn_cvt_pk_fp8_f32(c, d, w, true); return (unsigned)w; }
constexpr float FP8_WSCALE = 64.0f, FP8_ASCALE = 4.0f, FP8_OSCALE = 1.0f / 256.0f;
__device__ __forceinline__ bf16_t f2bf(float f) { return (bf16_t)(cvt_pk_bf16(f, 0.f) & 0xffffu); }
__device__ __forceinline__ float bf2f(bf16_t b) { return __uint_as_float(((unsigned)b) << 16); }
__device__ __forceinline__ float bflo(unsigned w) { return __uint_as_float(w << 16); }
__device__ __forceinline__ float bfhi(unsigned w) { return __uint_as_float(w & 0xffff0000u); }
__device__ __forceinline__ float bperm(float v, int srclane) { return __int_as_float(__builtin_amdgcn_ds_bpermute(srclane << 2, __float_as_int(v))); }
__device__ __forceinline__ float wave_sum(float v, int lane) {
#pragma unroll
    for (int o = 32; o >= 1; o >>= 1) v += bperm(v, lane ^ o);
    return v;
}
__device__ __forceinline__ int lane_id() { return (int)__builtin_amdgcn_mbcnt_hi(~0u, __builtin_amdgcn_mbcnt_lo(~0u, 0u)); }
__device__ __forceinline__ int make_tid(int wv) { int l; asm volatile("v_mbcnt_lo_u32_b32 %0, -1, 0\n\tv_mbcnt_hi_u32_b32 %0, -1, %0" : "=v"(l)); return wv * 64 + l; }
__device__ __forceinline__ float sigmoidf_(float x) { return 1.0f / (1.0f + __expf(-x)); }
__device__ __forceinline__ s16x4 tr_read(unsigned lds_addr) { s16x4 r; asm volatile("ds_read_b64_tr_b16 %0, %1\n\ts_waitcnt lgkmcnt(0)" : "=&v"(r) : "v"(lds_addr) : "memory"); return r; }

#define XB_TMO      128
#define XB_XCNT(j)  (256  + 64 * (j))
#define XB_XSUB(j)  (1280 + 64 * (j))
#define XB_XGEN(j)  (2304 + 64 * (j))
#define XB_TOP      3328
#define XB_TOPGEN   3392
#define XCD_BAR_WORDS 3456
#define XB_SPIN_CAP (1u << 18)

__device__ __forceinline__ unsigned xb_ld(unsigned* p)              { return __hip_atomic_load(p, __ATOMIC_RELAXED, __HIP_MEMORY_SCOPE_AGENT); }
__device__ __forceinline__ unsigned xb_add(unsigned* p, unsigned v) { return __hip_atomic_fetch_add(p, v, __ATOMIC_RELAXED, __HIP_MEMORY_SCOPE_AGENT); }
__device__ __forceinline__ unsigned xb_xcc_id() { return (unsigned)__builtin_amdgcn_s_getreg((3 << 11) | 20) & 0xFu; }
#define XB_SPIN(cond, bar) do { unsigned _sp = 0; while (cond) { __builtin_amdgcn_s_sleep(1); \
    if ((++_sp & 255u) == 0u) { if (xb_ld(&(bar)[XB_TMO])) break; if (_sp > XB_SPIN_CAP) { atomicAdd(&(bar)[XB_TMO], 1u); break; } } } } while (0)

struct XcdBarrier { unsigned* bar; unsigned x; volatile LAS unsigned* st; };

__device__ __forceinline__ XcdBarrier xcd_barrier_post(unsigned* bar, volatile LAS unsigned* st, bool t0) {
    XcdBarrier b; b.bar = bar; b.x = xb_xcc_id(); b.st = st;
    if (t0) (void)xb_add(&bar[XB_XCNT(b.x)], 1u);
    return b;
}
__device__ __forceinline__ void xcd_barrier_complete(unsigned* bar, unsigned x, unsigned& nloc, unsigned& nx) {
    const unsigned G = gridDim.x * gridDim.y * gridDim.z;
    unsigned sum, cnt, mine, sp = 0u;
    for (;;) {
        sum = 0u; cnt = 0u; mine = 0u;
#pragma unroll
        for (unsigned j = 0; j < 16; ++j) { const unsigned c = xb_ld(&bar[XB_XCNT(j)]); sum += c; cnt += (c > 0u) ? 1u : 0u; mine = (j == x) ? c : mine; }
        if (sum == G) break;
        __builtin_amdgcn_s_sleep(1);
        if ((++sp & 255u) == 0u) { if (xb_ld(&bar[XB_TMO])) break; if (sp > XB_SPIN_CAP) { atomicAdd(&bar[XB_TMO], 1u); break; } }
    }
    nloc = mine > 0u ? mine : 1u; nx = cnt > 0u ? cnt : 1u;
}
__device__ __forceinline__ void xcd_barrier(const XcdBarrier& b, int wv) {
    asm volatile("s_waitcnt vmcnt(0)" ::: "memory");
    __syncthreads();
    if (wv == 0 && lane_id() == 0) {
        unsigned* bar = b.bar;
        __builtin_amdgcn_s_waitcnt(0);
        unsigned nloc = b.st[0], nx = b.st[1];
        if (nloc == 0u) { xcd_barrier_complete(bar, b.x, nloc, nx); b.st[0] = nloc; b.st[1] = nx; }
        const unsigned old = xb_add(&bar[XB_XSUB(b.x)], 1u);
        const unsigned gen = old / nloc;
        if (old + 1u == (gen + 1u) * nloc) {
            __builtin_amdgcn_fence(__ATOMIC_RELEASE, "agent");
            asm volatile("s_waitcnt vmcnt(0)" ::: "memory");
            const unsigned og = xb_add(&bar[XB_TOP], 1u);
            const unsigned tg = og / nx;
            if (og + 1u == (tg + 1u) * nx) xb_add(&bar[XB_TOPGEN], 1u);
            else XB_SPIN(xb_ld(&bar[XB_TOPGEN]) == tg, bar);
            __builtin_amdgcn_fence(__ATOMIC_ACQUIRE, "agent");
            xb_add(&bar[XB_XGEN(b.x)], 1u);
            asm volatile("s_waitcnt vmcnt(0)" ::: "memory");
        } else {
            XB_SPIN(xb_ld(&bar[XB_XGEN(b.x)]) == gen, bar);
            __builtin_amdgcn_fence(__ATOMIC_ACQUIRE, "agent");
            asm volatile("s_waitcnt vmcnt(0)" ::: "memory");
        }
    }
    __syncthreads();
}
#define DEV_STAGE 9
__device__ __forceinline__ void conv_supertile(const float* __restrict__ src, int ld_src, int srccol, int k0, bf16_t* __restrict__ dst, int K, LAS unsigned* buf, int t) {
    const int c4 = t & 63, kq = t >> 6;
    f32x4 a[4], b[4];
#pragma unroll
    for (int i = 0; i < 4; ++i) { const int kp = kq + 8 * i; const float* r = src + (size_t)(k0 + 2 * kp) * ld_src + srccol; a[i] = *(const f32x4*)r; b[i] = *(const f32x4*)(r + ld_src); }
#pragma unroll
    for (int i = 0; i < 4; ++i) { const int kp = kq + 8 * i;
#pragma unroll
        for (int j = 0; j < 4; ++j) buf[(4 * c4 + j) * 33 + kp] = cvt_pk_bf16(a[i][j], b[i][j]); }
    __syncthreads();
    const int n = t >> 1, hf = t & 1;
    bf16_t* d = dst + (size_t)n * K + k0 + 32 * hf;
#pragma unroll
    for (int q = 0; q < 4; ++q) { u32x4 o;
#pragma unroll
        for (int e = 0; e < 4; ++e) o[e] = buf[n * 33 + 16 * hf + 4 * q + e];
        *(u32x4*)(d + 8 * q) = o; }
    __syncthreads();
}

__device__ __forceinline__ void p0_gemv_item(const Params& p, int id, LAS unsigned char* lds, int t) {
    const int cb = id % 48, ks = id / 48;
    LAS float* sv = (LAS float*)lds;
    LAS float* red = sv + 9 * 256;
    for (int i = t; i < 9 * 256; i += NTHR) { const int r = i >> 8, kk = i & 255; const float cv = (r < 8) ? p.c[r * 2048 + ks * 256 + kk] : p.c_ctx[ks * 256 + kk]; sv[i] = cv / (1.0f + __expf(-cv)); }
    __syncthreads();
    const int col4 = t & 63, w = t >> 6;
    f32x4 acc[9];
#pragma unroll
    for (int r = 0; r < 9; ++r) acc[r] = (f32x4){0.f, 0.f, 0.f, 0.f};
    const float* wp = p.w_ada + (size_t)(ks * 256 + w) * 12288 + cb * 256 + col4 * 4;
#pragma unroll 8
    for (int i = 0; i < 32; ++i) { const f32x4 wv = *(const f32x4*)(wp + (size_t)i * 8 * 12288); const int kk = w + 8 * i;
#pragma unroll
        for (int r = 0; r < 9; ++r) acc[r] += sv[r * 256 + kk] * wv; }
#pragma unroll
    for (int r = 0; r < 9; ++r) *(LAS f32x4*)(red + (w * 9 + r) * 256 + col4 * 4) = acc[r];
    __syncthreads();
    float* modp = (float*)(p.ws + WS_MODP);
    for (int i = t; i < 9 * 256; i += NTHR) { const int r = i >> 8, col = i & 255; float s = 0.f;
#pragma unroll
        for (int ww = 0; ww < 8; ++ww) s += red[(ww * 9 + r) * 256 + col];
        modp[(size_t)(ks * 9 + r) * 12288 + cb * 256 + col] = s; }
    __syncthreads();
}

__device__ __forceinline__ void p0_s5_item(const Params& p, int g, LAS unsigned char* lds, int t) {
    LAS float* LBP = (LAS float*)lds;
    LAS float* BB = LBP + 2 * 17 * 64 * 2;
    LAS float* CC = BB + 2 * 64 * 16 * 2;
    LAS float* KT = CC + 2 * 16 * 64 * 2;
    if (t < 128) {
        const int d = t >> 6, pp = t & 63, gi = (d * 64 + g) * 64 + pp;
        const float lre = fminf(p.lam_re[gi], -1e-4f), lim = p.lam_im[gi], dt = __expf(p.log_dt[d * 64 + g]);
        const float mag = expf(lre * dt), ang = lim * dt;
        float sn, cs; sincosf(ang, &sn, &cs);
        const float lbr = mag * cs, lbi = mag * sn;
        const float den = lre * lre + lim * lim, nr = lbr - 1.0f;
        const float cre = (nr * lre + lbi * lim) / den, cim = (lbi * lre - nr * lim) / den;
        float pr = 1.f, pi = 0.f;
        for (int tau = 0; tau <= 16; ++tau) { LBP[((d * 17 + tau) * 64 + pp) * 2] = pr; LBP[((d * 17 + tau) * 64 + pp) * 2 + 1] = pi; const float nr2 = pr * lbr - pi * lbi, ni2 = pr * lbi + pi * lbr; pr = nr2; pi = ni2; }
        float* lb16 = (float*)(p.ws + WS_LB16);
        lb16[gi * 2] = LBP[((d * 17 + 16) * 64 + pp) * 2]; lb16[gi * 2 + 1] = LBP[((d * 17 + 16) * 64 + pp) * 2 + 1];
        for (int h = 0; h < 16; ++h) { const float br = p.b_re[(size_t)gi * 16 + h], bi = p.b_im[(size_t)gi * 16 + h];
            BB[((d * 64 + pp) * 16 + h) * 2] = cre * br - cim * bi; BB[((d * 64 + pp) * 16 + h) * 2 + 1] = cre * bi + cim * br; }
    }
    for (int i = t; i < 2 * 16 * 64; i += NTHR) { const int d = i >> 10, h = (i >> 6) & 15, pp = i & 63; const size_t gi = ((size_t)(d * 64 + g) * 16 + h) * 64 + pp;
        CC[i * 2] = p.c_re[gi]; CC[i * 2 + 1] = p.c_im[gi]; }
    __syncthreads();
    for (int idx = t; idx < 8192; idx += NTHR) { const int d = idx >> 12, tau = (idx >> 8) & 15, h = (idx >> 4) & 15, h2 = idx & 15; float s = 0.f;
        for (int pp = 0; pp < 64; ++pp) { const float cr = CC[((d * 16 + h) * 64 + pp) * 2], ci = CC[((d * 16 + h) * 64 + pp) * 2 + 1];
            const float lr = LBP[((d * 17 + tau) * 64 + pp) * 2], li = LBP[((d * 17 + tau) * 64 + pp) * 2 + 1];
            const float br = BB[((d * 64 + pp) * 16 + h2) * 2], bi = BB[((d * 64 + pp) * 16 + h2) * 2 + 1];
            const float wr = cr * lr - ci * li, wi = cr * li + ci * lr; s += wr * br - wi * bi; }
        KT[idx] = s; }
    __syncthreads();
    unsigned* bty = (unsigned*)(p.ws + WS_BTY) + (size_t)g * 256 * 256;
    for (int idx = t; idx < 256 * 256; idx += NTHR) { const int n = idx >> 8, kp = idx & 255, tt = n >> 4, h = n & 15; float v[2];
#pragma unroll
        for (int e = 0; e < 2; ++e) { const int k = 2 * kp + e;
            if (k < 256) { const int s = k >> 4, h2 = k & 15; float a = 0.f;
                if (s <= tt) a += KT[((0 * 16 + (tt - s)) * 16 + h) * 16 + h2];
                if (s >= tt) a += KT[((1 * 16 + (s - tt)) * 16 + h) * 16 + h2];
                v[e] = a;
            } else { const int d = (k - 256) >> 7, kk = (k - 256) & 127, reim = kk >> 6, pp = kk & 63, pw = d == 0 ? tt + 1 : 16 - tt;
                const float cr = CC[((d * 16 + h) * 64 + pp) * 2], ci = CC[((d * 16 + h) * 64 + pp) * 2 + 1];
                const float lr = LBP[((d * 17 + pw) * 64 + pp) * 2], li = LBP[((d * 17 + pw) * 64 + pp) * 2 + 1];
                v[e] = reim == 0 ? (cr * lr - ci * li) : -(cr * li + ci * lr); } }
        bty[idx] = cvt_pk_bf16(v[0], v[1]); }
    unsigned* btv = (unsigned*)(p.ws + WS_BTV) + (size_t)g * 256 * 128;
    for (int idx = t; idx < 256 * 128; idx += NTHR) { const int n = idx >> 7, kp = idx & 127, d = n >> 7, reim = (n >> 6) & 1, pp = n & 63; float v[2];
#pragma unroll
        for (int e = 0; e < 2; ++e) { const int k = 2 * kp + e, s = k >> 4, h2 = k & 15, pw = d == 0 ? 15 - s : s;
            const float lr = LBP[((d * 17 + pw) * 64 + pp) * 2], li = LBP[((d * 17 + pw) * 64 + pp) * 2 + 1];
            const float br = BB[((d * 64 + pp) * 16 + h2) * 2], bi = BB[((d * 64 + pp) * 16 + h2) * 2 + 1];
            v[e] = reim == 0 ? (lr * br - li * bi) : (lr * bi + li * br); }
        btv[idx] = cvt_pk_bf16(v[0], v[1]); }
    __syncthreads();
}

struct TileF8 { const float* src; unsigned char* dst; int ld_src; };
__device__ __forceinline__ TileF8 p0_f8_tile(const Params& p, int j) {
    TileF8 T;
    if (j < 16384) { const int nb = j & 31, kb = (j >> 5) & 15, e = j >> 9, pnb = nb >> 1, hf = nb & 1;
        T.src = p.w_gu + (size_t)e * 2048 * 4096 + (size_t)(kb * 128) * 4096 + hf * 2048 + pnb * 128; T.ld_src = 4096;
        T.dst = p.ws + WS_WGU_T + ((size_t)e * 4096 + pnb * 256 + hf * 128) * 2048 + kb * 128; }
    else { const int jj = j - 16384, nb = jj & 15, kb = (jj >> 4) & 15, e = jj >> 8;
        T.src = p.w_down + (size_t)e * 2048 * 2048 + (size_t)(kb * 128) * 2048 + nb * 128; T.ld_src = 2048;
        T.dst = p.ws + WS_WDN_T + ((size_t)e * 2048 + nb * 128) * 2048 + kb * 128; }
    return T;
}
#define P0F8_LOAD(R, T) do { const float* _s = (T).src + (size_t)(kq * 8) * (T).ld_src + c4 * 4; _Pragma("unroll") for (int i = 0; i < 8; ++i) R[i] = *(const f32x4*)(_s + (size_t)i * (T).ld_src); } while (0)
__device__ __forceinline__ void p0_f8_process(const f32x4 (&r)[8], unsigned char* dst, LAS unsigned* buf, int t) {
    const int c4 = t & 31, kq = t >> 5;
#pragma unroll
    for (int j = 0; j < 4; ++j) { u32x2 w; w.x = cvt4_fp8(r[0][j] * FP8_WSCALE, r[1][j] * FP8_WSCALE, r[2][j] * FP8_WSCALE, r[3][j] * FP8_WSCALE); w.y = cvt4_fp8(r[4][j] * FP8_WSCALE, r[5][j] * FP8_WSCALE, r[6][j] * FP8_WSCALE, r[7][j] * FP8_WSCALE);
        *(LAS u32x2*)(buf + (4 * c4 + j) * 34 + 2 * kq) = w; }
    __syncthreads();
    const int n = t >> 2, q = t & 3; u32x2 o[4];
#pragma unroll
    for (int e = 0; e < 4; ++e) o[e] = *(const LAS u32x2*)(buf + n * 34 + 8 * q + 2 * e);
    unsigned char* d = dst + (size_t)n * 2048 + 32 * q;
    *(u32x4*)d = (u32x4){o[0].x, o[0].y, o[1].x, o[1].y}; *(u32x4*)(d + 16) = (u32x4){o[2].x, o[2].y, o[3].x, o[3].y};
    __syncthreads();
}
__device__ __forceinline__ void p0_f8_all(const Params& p, LAS unsigned* buf, int t) {
    const int c4 = t & 31, kq = t >> 5;
    constexpr int NT = 16384 + 8192;
    f32x4 ra[8], rb[8];
    int j = blockIdx.x;
    TileF8 Ta = p0_f8_tile(p, j), Tb;
    P0F8_LOAD(ra, Ta);
    for (; j < NT; j += 2 * NWG) {
        const bool hb = j + NWG < NT;
        if (hb) { Tb = p0_f8_tile(p, j + NWG); P0F8_LOAD(rb, Tb); }
        p0_f8_process(ra, Ta.dst, buf, t);
        if (!hb) break;
        const bool ha = j + 2 * NWG < NT;
        if (ha) { Ta = p0_f8_tile(p, j + 2 * NWG); P0F8_LOAD(ra, Ta); }
        p0_f8_process(rb, Tb.dst, buf, t);
    }
}

constexpr int P0_GEMV = 384, P0_S5 = 64, P0_RT = 1;
constexpr int P0_SPECIAL = P0_GEMV + P0_S5 + P0_RT;
constexpr int P0_WIN = 16 * 32, P0_WGLU = 4 * 16, P0_WOUT = 8 * 32, P0_WGU = 32 * 16 * 32, P0_WDN = 32 * 8 * 32;
constexpr int P0_TOTAL = P0_SPECIAL + P0_WIN + P0_WGLU + P0_WOUT;

__device__ __forceinline__ void phase0(const Params& p, LAS unsigned char* lds, int wv) {
    const int t = make_tid(wv);
    LAS unsigned* buf = (LAS unsigned*)lds;
    for (int id = blockIdx.x; id < P0_TOTAL; id += gridDim.x) {
        if (id < P0_GEMV) { p0_gemv_item(p, id, lds, t); continue; }
        if (id < P0_GEMV + P0_S5) { p0_s5_item(p, id - P0_GEMV, lds, t); continue; }
        if (id < P0_SPECIAL) {
            bf16_t* wrt = (bf16_t*)(p.ws + WS_WRT);
            for (int i = t; i < 65536; i += NTHR) { const int k = i >> 5, e = i & 31; const float w = p.w_router[i]; const bf16_t hi = f2bf(w); const bf16_t lo = f2bf(w - bf2f(hi));
                wrt[e * 2048 + k] = hi; wrt[(32 + e) * 2048 + k] = lo; }
            continue;
        }
        int j = id - P0_SPECIAL;
        const int c4 = t & 63;
        if (j < P0_WIN) { const int nb = j & 15, kb = j >> 4; const int n0 = nb * 256, sc0 = n0 < 3072 ? n0 : n0 + 16;
            conv_supertile(p.w_in, DIN, sc0 + 4 * c4, kb * 64, (bf16_t*)(p.ws + WS_WIN_T) + (size_t)n0 * 2048, 2048, buf, t); continue; }
        j -= P0_WIN;
        if (j < P0_WGLU) { const int nb = j & 3, kb = j >> 2;
            conv_supertile(p.w_glu, 1024, nb * 256 + 4 * c4, kb * 64, (bf16_t*)(p.ws + WS_WGLU_T) + (size_t)nb * 256 * 1024, 1024, buf, t); continue; }
        j -= P0_WGLU;
        if (j < P0_WOUT) { const int nb = j & 7, kb = j >> 3;
            conv_supertile(p.w_out, 2048, nb * 256 + 4 * c4, kb * 64, (bf16_t*)(p.ws + WS_WOUT_T) + (size_t)nb * 256 * 2048, 2048, buf, t); }
    }
    p0_f8_all(p, buf, t);
}

__device__ __forceinline__ void p1_load_vecs(const Params& p, int modrow, LAS float* scv, LAS float* shv, int t) {
    const float* modp = (const float*)(p.ws + WS_MODP);
    for (int d = t; d < 2048; d += NTHR) { float sh = p.b_ada[d], sc = 1.0f + p.b_ada[2048 + d];
#pragma unroll
        for (int ks = 0; ks < 8; ++ks) { sh += modp[(size_t)(ks * 9 + modrow) * 12288 + d]; sc += modp[(size_t)(ks * 9 + modrow) * 12288 + 2048 + d]; }
        scv[d] = sc; shv[d] = sh; }
}
__device__ __forceinline__ void p1_row(const Params& p, const float* __restrict__ xrow, int urow, LAS const unsigned char* wgl, LAS const float* scv, LAS const float* shv, int lane) {
    f32x4 v[8]; float ss = 0.f;
#pragma unroll
    for (int i = 0; i < 8; ++i) { v[i] = *(const f32x4*)(xrow + (i * 64 + lane) * 4); ss += v[i][0] * v[i][0] + v[i][1] * v[i][1] + v[i][2] * v[i][2] + v[i][3] * v[i][3]; }
    ss = wave_sum(ss, lane);
    const float rstd = rsqrtf(ss * (1.0f / 2048.0f) + 1e-6f);
    float acc[16];
#pragma unroll
    for (int j = 0; j < 16; ++j) acc[j] = 0.f;
    bf16_t* urow_p = (bf16_t*)(p.ws + WS_U1) + (size_t)urow * 2048;
#pragma unroll
    for (int i = 0; i < 8; ++i) { const int m = i * 64 + lane;
        const f32x4 g = *(const f32x4*)(p.norm1_g + m * 4), sc = *(LAS const f32x4*)(scv + m * 4), sh = *(LAS const f32x4*)(shv + m * 4);
        const f32x4 u = v[i] * rstd * g * sc + sh;
        u32x2 w; w.x = cvt_pk_bf16(u[0], u[1]); w.y = cvt_pk_bf16(u[2], u[3]);
        *(u32x2*)(urow_p + m * 4) = w;
#pragma unroll
        for (int j = 0; j < 4; ++j) {
#pragma unroll
            for (int q = 0; q < 4; ++q) { const f32x4 wv = *(LAS const f32x4*)(wgl + m * 272 + j * 64 + q * 16);
                acc[q * 4 + 0] += u[j] * wv[0]; acc[q * 4 + 1] += u[j] * wv[1]; acc[q * 4 + 2] += u[j] * wv[2]; acc[q * 4 + 3] += u[j] * wv[3]; } }
    }
    float r8[8], r4[4], r2[2], r1;
    { const bool up = (lane & 32) != 0;
#pragma unroll
      for (int j = 0; j < 8; ++j) { const float keep = up ? acc[j + 8] : acc[j], send = up ? acc[j] : acc[j + 8]; r8[j] = keep + bperm(send, lane ^ 32); } }
    { const bool up = (lane & 16) != 0;
#pragma unroll
      for (int j = 0; j < 4; ++j) { const float keep = up ? r8[j + 4] : r8[j], send = up ? r8[j] : r8[j + 4]; r4[j] = keep + bperm(send, lane ^ 16); } }
    { const bool up = (lane & 8) != 0;
#pragma unroll
      for (int j = 0; j < 2; ++j) { const float keep = up ? r4[j + 2] : r4[j], send = up ? r4[j] : r4[j + 2]; r2[j] = keep + bperm(send, lane ^ 8); } }
    { const bool up = (lane & 4) != 0; const float keep = up ? r2[1] : r2[0], send = up ? r2[0] : r2[1]; r1 = keep + bperm(send, lane ^ 4); }
    r1 += bperm(r1, lane ^ 2); r1 += bperm(r1, lane ^ 1);
    if ((lane & 3) == 0) { const int gi = ((lane >> 5) & 1) * 8 + ((lane >> 4) & 1) * 4 + ((lane >> 3) & 1) * 2 + ((lane >> 2) & 1);
        float gv = 15.0f * tanhf((r1 + p.gate_bias[gi]) * (1.0f / 15.0f));
        if ((gi >> 2) & 1) gv = fminf(gv, 0.f) - log1pf(__expf(-fabsf(gv)));
        ((float*)(p.ws + WS_GATES))[(size_t)urow * 16 + gi] = gv; }
}
__device__ __forceinline__ void phase1(const Params& p, LAS unsigned char* lds, int wv) {
    const int t = make_tid(wv);
    const int lane = t & 63, wid = t >> 6, wg = blockIdx.x;
    { const float* modp = (const float*)(p.ws + WS_MODP); float* mod = (float*)(p.ws + WS_MOD);
      for (int i = wg * NTHR + t; i < 9 * 12288; i += NWG * NTHR) { const int r = i / 12288, j = i - r * 12288; float s = p.b_ada[j];
#pragma unroll
          for (int ks = 0; ks < 8; ++ks) s += modp[(size_t)(ks * 9 + r) * 12288 + j];
          mod[i] = s; } }
    LAS unsigned char* wgl = lds;
    LAS float* scv = (LAS float*)(lds + 139264);
    LAS float* shv = scv + 2048;
    for (int i = t; i < 2048 * 4; i += NTHR) { const int k = i >> 2, q = i & 3; *(LAS f32x4*)(wgl + (k >> 2) * 272 + (k & 3) * 64 + q * 16) = *(const f32x4*)(p.w_in + (size_t)k * DIN + 3072 + q * 4); }
    const int b = wg >> 5;
    p1_load_vecs(p, b, scv, shv, t);
    __syncthreads();
    for (int r = wid; r < 64; r += 8) { const int row = wg * 64 + r; p1_row(p, p.x + (size_t)row * 2048, row, wgl, scv, shv, lane); }
    __syncthreads();
    p1_load_vecs(p, 8, scv, shv, t);
    __syncthreads();
    { const int row = wg * 8 + wid; p1_row(p, p.ctx + (size_t)row * 2048, NLAT + row, wgl, scv, shv, lane); }
    __syncthreads();
}
namespace pg8 {
constexpr int BM = 256, BK = 64, HALF = 128, HTB = HALF * BK * 2, STAGE_BYTES = 8 * HTB, NXCD = 8;
__host__ __device__ __forceinline__ int lds_byte(int r, int c) { const int st = (r >> 4) * 2 + (c >> 5), rr = r & 15, cc = c & 31, ob = rr * 64 + cc * 2; return st * 1024 + (ob ^ (((ob >> 9) & 1) << 5)); }
__host__ __device__ __forceinline__ void stage_rc(int b, int& R, int& C) { const int st = b / 1024, sb = b % 1024, swz = sb ^ (((sb >> 9) & 1) << 5); R = (st >> 1) * 16 + swz / 64; C = (st & 1) * 32 + (swz % 64) / 2; }
__host__ __device__ __forceinline__ int perm32(int rho) { const int n = rho >> 4, i = rho & 15; return 8 * (i >> 2) + 4 * n + (i & 3); }
struct Unit { int pm, pn, g, rb, cn; };
__device__ __forceinline__ int xcd_chunk(int L, int nwg) { const int q = nwg / NXCD, r = nwg % NXCD, xcd = L % NXCD, off = L / NXCD; return (xcd < r ? xcd * (q + 1) : r * (q + 1) + (xcd - r) * q) + off; }

__device__ __forceinline__ const char* uni_ptr(const char* p) { const unsigned lo = __builtin_amdgcn_readfirstlane((unsigned)(size_t)p), hi = __builtin_amdgcn_readfirstlane((unsigned)((size_t)p >> 32)); return (const char*)(((size_t)hi << 32) | lo); }
typedef int i32x8 __attribute__((ext_vector_type(8)));
typedef int i32x4 __attribute__((ext_vector_type(4)));
template <class Epi, class Sched, int K, int LDA, bool GATHER, bool FP8 = false>
__device__ __forceinline__ void gemm_phase(LAS unsigned char* lds, const Sched& S, const Epi& E, int wv) {
    const int tid = make_tid(wv);
    const int wid = wv, lane = tid & 63, wr = wid >> 2, wc = wid & 3, fr = lane & 15, fq = lane >> 4;
    constexpr int nt = K / BK;
    int R0, C0, R1, C1; stage_rc(tid * 16, R0, C0); stage_rc(tid * 16 + 8192, R1, C1);
    unsigned voffB[2];
    { const int Rb0 = Epi::PERM ? ((R0 & ~31) + perm32(R0 & 31)) : R0, Rb1 = Epi::PERM ? ((R1 & ~31) + perm32(R1 & 31)) : R1;
      voffB[0] = (unsigned)(Rb0 * K + C0) * 2u; voffB[1] = (unsigned)(Rb1 * K + C1) * 2u; }
    unsigned offC[2][2];
    constexpr size_t kstep = (size_t)(BK * 2);
    constexpr size_t hstepB = (size_t)HALF * K * 2;
    const unsigned ldsb = (unsigned)(size_t)lds + (unsigned)wid * 1024u;
    const int aoff = lds_byte(wr * 64 + fr, FP8 ? fq * 16 : fq * 8), boff = lds_byte(wc * 32 + fr, FP8 ? fq * 16 : fq * 8);
#define PG8_SA(b, h) (((b) * 2 + (h)) * HTB)
#define PG8_SB(b, h) ((4 + (b) * 2 + (h)) * HTB)
#define PG8_STAGE(bufoff, gbase, voff) do { _Pragma("unroll") for (int _i = 0; _i < 2; ++_i) { unsigned _keep; \
        asm volatile("s_mov_b32 %0, m0\n\ts_mov_b32 m0, %2\n\ts_nop 0\n\tglobal_load_lds_dwordx4 %1, %3\n\ts_mov_b32 m0, %0" : "=&s"(_keep) : "v"((voff)[_i]), "s"(ldsb + (unsigned)((bufoff) + _i * 8192)), "s"((const char*)(gbase)) : "memory"); } } while (0)
#define PG8_LDA(dst, b, h) do { _Pragma("unroll") for (int m = 0; m < 4; ++m) { if constexpr (FP8) { const i32x4 _l = *(const LAS i32x4*)(lds + PG8_SA(b, h) + aoff + m * 2048), _h = *(const LAS i32x4*)(lds + PG8_SA(b, h) + aoff + m * 2048 + 16); dst##8[m] = __builtin_shufflevector(_l, _h, 0, 1, 2, 3, 4, 5, 6, 7); } \
        else { _Pragma("unroll") for (int k = 0; k < 2; ++k) dst[m][k] = *(const LAS bf16x8*)(lds + PG8_SA(b, h) + aoff + m * 2048 + k * 1024); } } } while (0)
#define PG8_LDB(dst, b, h) do { _Pragma("unroll") for (int n = 0; n < 2; ++n) { if constexpr (FP8) { const i32x4 _l = *(const LAS i32x4*)(lds + PG8_SB(b, h) + boff + n * 2048), _h = *(const LAS i32x4*)(lds + PG8_SB(b, h) + boff + n * 2048 + 16); dst##8[n] = __builtin_shufflevector(_l, _h, 0, 1, 2, 3, 4, 5, 6, 7); } \
        else { _Pragma("unroll") for (int k = 0; k < 2; ++k) dst[n][k] = *(const LAS bf16x8*)(lds + PG8_SB(b, h) + boff + n * 2048 + k * 1024); } } } while (0)
#define PG8_MMA(ai, bj, At, Bt) do { __builtin_amdgcn_s_setprio(1); _Pragma("unroll") for (int m = 0; m < 4; ++m) _Pragma("unroll") for (int n = 0; n < 2; ++n) { \
        if constexpr (FP8) { acc[ai][bj][m][n] = __builtin_amdgcn_mfma_scale_f32_16x16x128_f8f6f4(Bt##8[n], At##8[m], acc[ai][bj][m][n], 0, 0, 0, 0, 0, 0); } \
        else { _Pragma("unroll") for (int k = 0; k < 2; ++k) acc[ai][bj][m][n] = __builtin_amdgcn_mfma_f32_16x16x32_bf16(Bt[n][k], At[m][k], acc[ai][bj][m][n], 0, 0, 0); } } \
        __builtin_amdgcn_s_setprio(0); } while (0)
#define PG8_WAIT_V(n) asm volatile("s_waitcnt vmcnt(" #n ")" ::: "memory")
#define PG8_WAIT_L(n) asm volatile("s_waitcnt lgkmcnt(" #n ")" ::: "memory")
#define PG8_BAR __builtin_amdgcn_s_barrier()
#define PG8_SCHED __builtin_amdgcn_sched_barrier(0)
    Unit cur, nxt; int ui = 0;
    if (!S.next(0, cur)) return;
    f32x4 acc[2][2][4][2];
#pragma unroll
    for (int a = 0; a < 2; ++a)
#pragma unroll
        for (int b = 0; b < 2; ++b)
#pragma unroll
            for (int m = 0; m < 4; ++m)
#pragma unroll
                for (int n = 0; n < 2; ++n) acc[a][b][m][n] = (f32x4){0.f, 0.f, 0.f, 0.f};
    bf16x8 At[FP8 ? 1 : 4][2], B0[FP8 ? 1 : 2][2], B1[FP8 ? 1 : 2][2]; i32x8 At8[FP8 ? 4 : 1], B08[FP8 ? 2 : 1], B18[FP8 ? 2 : 1];
    const char* cA = uni_ptr(S.a_ptr(cur)); const char* cB = uni_ptr(S.b_ptr(cur));
    if constexpr (GATHER) S.a_rows(0, wv, offC);
    else { offC[0][0] = (unsigned)(R0 * LDA + C0) * 2u; offC[0][1] = (unsigned)(R1 * LDA + C1) * 2u; offC[1][0] = (unsigned)((R0 + HALF) * LDA + C0) * 2u; offC[1][1] = (unsigned)((R1 + HALF) * LDA + C1) * 2u; }
    PG8_STAGE(PG8_SB(0, 0), cB, voffB); PG8_STAGE(PG8_SB(0, 1), cB + hstepB, voffB); PG8_STAGE(PG8_SA(0, 0), cA, offC[0]); PG8_STAGE(PG8_SA(0, 1), cA, offC[1]);
    if (wr == 1) PG8_BAR;
    PG8_WAIT_V(2); PG8_BAR;
    PG8_STAGE(PG8_SB(1, 0), cB + kstep, voffB); PG8_STAGE(PG8_SA(1, 0), cA + kstep, offC[0]); PG8_STAGE(PG8_SB(1, 1), cB + hstepB + kstep, voffB);
    PG8_WAIT_V(6); PG8_BAR;
    for (;;) {
        const bool has_next = S.next(ui + 1, nxt);
        const char* nA = has_next ? uni_ptr(S.a_ptr(nxt)) : cA; const char* nB = has_next ? uni_ptr(S.b_ptr(nxt)) : cB;
#pragma unroll 1
        for (int t = 0; t < nt; t += 2) {
            const bool last = (t == nt - 2);
            const char* a1 = cA + (size_t)(t + 1) * kstep;
            const char* a2 = last ? nA : cA + (size_t)(t + 2) * kstep; const char* b2 = last ? nB : cB + (size_t)(t + 2) * kstep;
            const char* a3 = a2 + kstep; const char* b3 = b2 + kstep;
            unsigned o2[2][2];
            if constexpr (GATHER) { if (last && has_next) S.a_rows(ui + 1, wv, o2); else { o2[0][0] = offC[0][0]; o2[0][1] = offC[0][1]; o2[1][0] = offC[1][0]; o2[1][1] = offC[1][1]; } }
            else { o2[0][0] = offC[0][0]; o2[0][1] = offC[0][1]; o2[1][0] = offC[1][0]; o2[1][1] = offC[1][1]; }
            PG8_LDB(B0, 0, 0); PG8_LDB(B1, 0, 1); PG8_SCHED; PG8_LDA(At, 0, 0); PG8_STAGE(PG8_SA(1, 1), a1, offC[1]);
            PG8_WAIT_V(8); PG8_WAIT_L(0); PG8_BAR; PG8_MMA(0, 0, At, B0); PG8_MMA(0, 1, At, B1); PG8_BAR; PG8_SCHED;
            PG8_LDA(At, 0, 1); PG8_STAGE(PG8_SB(0, 0), b2, voffB); PG8_STAGE(PG8_SB(0, 1), b2 + hstepB, voffB); PG8_STAGE(PG8_SA(0, 0), a2, o2[0]);
            PG8_WAIT_V(8); PG8_WAIT_L(0); PG8_BAR; PG8_MMA(1, 0, At, B0); PG8_MMA(1, 1, At, B1); PG8_BAR; PG8_SCHED;
            PG8_LDB(B0, 1, 0); PG8_LDB(B1, 1, 1); PG8_SCHED; PG8_LDA(At, 1, 0); PG8_STAGE(PG8_SA(0, 1), a2, o2[1]);
            PG8_WAIT_V(8); PG8_WAIT_L(0); PG8_BAR; PG8_MMA(0, 0, At, B0); PG8_MMA(0, 1, At, B1); PG8_BAR; PG8_SCHED;
            PG8_LDA(At, 1, 1); PG8_STAGE(PG8_SB(1, 0), b3, voffB); PG8_STAGE(PG8_SB(1, 1), b3 + hstepB, voffB); PG8_STAGE(PG8_SA(1, 0), a3, o2[0]);
            PG8_WAIT_V(8); PG8_WAIT_L(0); PG8_BAR; PG8_MMA(1, 0, At, B0); PG8_MMA(1, 1, At, B1); PG8_BAR; PG8_SCHED;
        }
        if (wr == 0) PG8_BAR;
        { const int l2 = make_tid(wv) & 63;
          E(acc, cur, wr, wc, l2 & 15, l2 >> 4); }
        if (!has_next) break;
#pragma unroll
        for (int a = 0; a < 2; ++a)
#pragma unroll
            for (int b = 0; b < 2; ++b)
#pragma unroll
                for (int m = 0; m < 4; ++m)
#pragma unroll
                    for (int n = 0; n < 2; ++n) acc[a][b][m][n] = (f32x4){0.f, 0.f, 0.f, 0.f};
        cur = nxt; cA = nA; cB = nB; ++ui;
        if constexpr (GATHER) S.a_rows(ui, wv, offC);
        if (wr == 1) PG8_BAR;
    }
    PG8_WAIT_V(0);
    PG8_BAR;
#undef PG8_SA
#undef PG8_SB
#undef PG8_STAGE
#undef PG8_LDA
#undef PG8_LDB
#undef PG8_MMA
#undef PG8_WAIT_V
#undef PG8_WAIT_L
#undef PG8_BAR
#undef PG8_SCHED
}
}
using pg8::Unit;
typedef f32x4 AccT[2][2][4][2];

struct SchedInProj {
    const unsigned char* ws; int c;
    __device__ __forceinline__ bool next(int i, Unit& u) const {
        const int L = i * NWG + c; if (L >= 1104) return false;
        const int w = pg8::xcd_chunk(L, 1104);
        if (w < 1024) { const int gid = w >> 7, r = w & 127; u.pm = gid * 8 + (r & 7); u.pn = r >> 3; }
        else { const int j = w - 1024, q = j >> 3; u.pm = 64 + (j & 7); u.pn = q < 6 ? 2 + q : 6 + q; }
        u.g = 0; return true;
    }
    __device__ __forceinline__ const char* a_ptr(const Unit& u) const { return (const char*)(ws + WS_U1) + (size_t)u.pm * 256 * 2048 * 2; }
    __device__ __forceinline__ const char* b_ptr(const Unit& u) const { return (const char*)(ws + WS_WIN_T) + (size_t)u.pn * 256 * 2048 * 2; }
};
struct EpiInProj {
    static constexpr bool PERM = true;
    unsigned char* ws;
    __device__ __forceinline__ void operator()(const AccT& acc, const Unit& u, int wr, int wc, int fr, int fq) const {
#pragma unroll
        for (int ai = 0; ai < 2; ++ai)
#pragma unroll
            for (int m = 0; m < 4; ++m) {
                const int row = u.pm * 256 + ai * 128 + wr * 64 + m * 16 + fr;
#pragma unroll
                for (int bj = 0; bj < 2; ++bj) {
                    const f32x4 v0 = acc[ai][bj][m][0], v1 = acc[ai][bj][m][1];
                    u32x4 w; w.x = cvt_pk_bf16(v0[0], v0[1]); w.y = cvt_pk_bf16(v0[2], v0[3]); w.z = cvt_pk_bf16(v1[0], v1[1]); w.w = cvt_pk_bf16(v1[2], v1[3]);
                    const int cc = bj * 128 + wc * 32 + 8 * fq;
                    if (u.pn < 4) *(u32x4*)((bf16_t*)(ws + WS_ZQK) + (size_t)row * 1024 + u.pn * 256 + cc) = w;
                    else if (u.pn < 8) *(u32x4*)((bf16_t*)(ws + WS_VBUF) + (size_t)row * 1024 + (u.pn - 4) * 256 + cc) = w;
                    else if (u.pn < 12) *(u32x4*)((bf16_t*)(ws + WS_OBUF) + (size_t)row * 1024 + (u.pn - 8) * 256 + cc) = w;
                    else { const int ch = (u.pn - 12) * 256 + cc, g = ch >> 4, h0 = ch & 15; int crow, tt;
                        if (row < NLAT) { const int b = row >> 11, l = row & 2047; crow = b * 128 + (l >> 4); tt = l & 15; }
                        else { const int rr = row - NLAT, b = rr >> 8, l = rr & 255; crow = 1024 + b * 16 + (l >> 4); tt = l & 15; }
                        *(u32x4*)((bf16_t*)(ws + WS_AS5) + ((size_t)g * 1280 + crow) * 512 + tt * 16 + h0) = w; }
                }
            }
    }
};

struct SchedS5V {
    const unsigned char* ws; int c;
    __device__ __forceinline__ bool next(int i, Unit& u) const { const int L = i * NWG + c; if (L >= 320) return false; const int w = pg8::xcd_chunk(L, 320); u.g = w / 5; u.pm = w % 5; u.pn = 0; return true; }
    __device__ __forceinline__ const char* a_ptr(const Unit& u) const { return (const char*)(ws + WS_AS5) + ((size_t)u.g * 1280 + u.pm * 256) * 512 * 2; }
    __device__ __forceinline__ const char* b_ptr(const Unit& u) const { return (const char*)(ws + WS_BTV) + (size_t)u.g * 256 * 256 * 2; }
};
struct EpiS5V {
    static constexpr bool PERM = false;
    unsigned char* ws;
    __device__ __forceinline__ void operator()(const AccT& acc, const Unit& u, int wr, int wc, int fr, int fq) const {
        float* base = (float*)(ws + WS_VS5) + ((size_t)u.g * 1280 + u.pm * 256) * 256;
#pragma unroll
        for (int ai = 0; ai < 2; ++ai)
#pragma unroll
            for (int m = 0; m < 4; ++m) { float* rowp = base + (size_t)(ai * 128 + wr * 64 + m * 16 + fr) * 256 + wc * 32 + 4 * fq;
#pragma unroll
                for (int bj = 0; bj < 2; ++bj)
#pragma unroll
                    for (int n = 0; n < 2; ++n) *(f32x4*)(rowp + bj * 128 + n * 16) = acc[ai][bj][m][n]; }
    }
};

struct SchedS5Y {
    const unsigned char* ws; int c;
    __device__ __forceinline__ bool next(int i, Unit& u) const { const int L = i * NWG + c; if (L >= 256) return false; const int w = pg8::xcd_chunk(L, 256); u.g = w >> 2; u.pm = w & 3; u.pn = 0; return true; }
    __device__ __forceinline__ const char* a_ptr(const Unit& u) const { return (const char*)(ws + WS_AS5) + ((size_t)u.g * 1280 + u.pm * 256) * 512 * 2; }
    __device__ __forceinline__ const char* b_ptr(const Unit& u) const { return (const char*)(ws + WS_BTY) + (size_t)u.g * 256 * 512 * 2; }
};
__device__ __forceinline__ float gelu_tanh(float x) { const float u = 0.7978845608028654f * (x + 0.044715f * x * x * x); const float e = __expf(2.0f * u); const float th = 1.0f - 2.0f / (e + 1.0f); return 0.5f * x * (1.0f + th); }
struct EpiS5Y {
    static constexpr bool PERM = true;
    unsigned char* ws; const float* s5_d;
    __device__ __forceinline__ void operator()(const AccT& acc, const Unit& u, int wr, int wc, int fr, int fq) const {
#pragma unroll
        for (int ai = 0; ai < 2; ++ai)
#pragma unroll
            for (int m = 0; m < 4; ++m) {
                const int cr = u.pm * 256 + ai * 128 + wr * 64 + m * 16 + fr, b = cr >> 7, cb = cr & 127;
#pragma unroll
                for (int bj = 0; bj < 2; ++bj) {
                    const int nn = bj * 128 + wc * 32 + 8 * fq, tt = nn >> 4, h0 = nn & 15;
                    const u32x4 uw = *(const u32x4*)((const bf16_t*)(ws + WS_AS5) + ((size_t)u.g * 1280 + cr) * 512 + nn);
                    const f32x4 d0 = *(const f32x4*)(s5_d + u.g * 16 + h0), d1 = *(const f32x4*)(s5_d + u.g * 16 + h0 + 4);
                    const f32x4 y0 = acc[ai][bj][m][0], y1 = acc[ai][bj][m][1];
                    float s[8];
                    s[0] = gelu_tanh(y0[0] + d0[0] * bflo(uw.x)); s[1] = gelu_tanh(y0[1] + d0[1] * bfhi(uw.x)); s[2] = gelu_tanh(y0[2] + d0[2] * bflo(uw.y)); s[3] = gelu_tanh(y0[3] + d0[3] * bfhi(uw.y));
                    s[4] = gelu_tanh(y1[0] + d1[0] * bflo(uw.z)); s[5] = gelu_tanh(y1[1] + d1[1] * bfhi(uw.z)); s[6] = gelu_tanh(y1[2] + d1[2] * bflo(uw.w)); s[7] = gelu_tanh(y1[3] + d1[3] * bfhi(uw.w));
                    u32x4 w; w.x = cvt_pk_bf16(s[0], s[1]); w.y = cvt_pk_bf16(s[2], s[3]); w.z = cvt_pk_bf16(s[4], s[5]); w.w = cvt_pk_bf16(s[6], s[7]);
                    *(u32x4*)((bf16_t*)(ws + WS_SBUF) + ((size_t)b * 2048 + cb * 16 + tt) * 1024 + u.g * 16 + h0) = w;
                }
            }
    }
};

template <int NN> struct SchedStatic {
    const char* A; const char* Bt; int c; size_t a_tile_bytes, b_tile_bytes;
    __device__ __forceinline__ bool next(int i, Unit& u) const { constexpr int nwg = 64 * NN; const int L = i * NWG + c; if (L >= nwg) return false;
        const int w = pg8::xcd_chunk(L, nwg); const int nig = 8 * NN, gid = w / nig, r = w % nig; u.pm = gid * 8 + (r & 7); u.pn = r >> 3; u.g = 0; return true; }
    __device__ __forceinline__ const char* a_ptr(const Unit& u) const { return A + (size_t)u.pm * a_tile_bytes; }
    __device__ __forceinline__ const char* b_ptr(const Unit& u) const { return Bt + (size_t)u.pn * b_tile_bytes; }
};
struct EpiGLU {
    static constexpr bool PERM = true;
    unsigned char* ws;
    __device__ __forceinline__ void operator()(const AccT& acc, const Unit& u, int wr, int wc, int fr, int fq) const {
#pragma unroll
        for (int ai = 0; ai < 2; ++ai)
#pragma unroll
            for (int m = 0; m < 4; ++m) {
                const int row = u.pm * 256 + ai * 128 + wr * 64 + m * 16 + fr;
#pragma unroll
                for (int bj = 0; bj < 2; ++bj) {
                    const int col = u.pn * 256 + bj * 128 + wc * 32 + 8 * fq;
                    const u32x4 sw = *(const u32x4*)((const bf16_t*)(ws + WS_SBUF) + (size_t)row * 1024 + col);
                    const f32x4 a0 = acc[ai][bj][m][0], a1 = acc[ai][bj][m][1];
                    u32x4 w;
                    w.x = cvt_pk_bf16(bflo(sw.x) * sigmoidf_(a0[0]), bfhi(sw.x) * sigmoidf_(a0[1])); w.y = cvt_pk_bf16(bflo(sw.y) * sigmoidf_(a0[2]), bfhi(sw.y) * sigmoidf_(a0[3]));
                    w.z = cvt_pk_bf16(bflo(sw.z) * sigmoidf_(a1[0]), bfhi(sw.z) * sigmoidf_(a1[1])); w.w = cvt_pk_bf16(bflo(sw.w) * sigmoidf_(a1[2]), bfhi(sw.w) * sigmoidf_(a1[3]));
                    *(u32x4*)((bf16_t*)(ws + WS_CAT) + (size_t)row * 2048 + 1024 + col) = w;
                }
            }
    }
};
struct EpiOut {
    static constexpr bool PERM = false;
    unsigned char* ws; const float* x;
    __device__ __forceinline__ void operator()(const AccT& acc, const Unit& u, int wr, int wc, int fr, int fq) const {
        const float* g1 = (const float*)(ws + WS_MOD) + (size_t)(u.pm >> 3) * 12288 + 2 * 2048;
        const int col0 = u.pn * 256 + wc * 32 + 4 * fq;
        f32x4 gv[2][2];
#pragma unroll
        for (int bj = 0; bj < 2; ++bj)
#pragma unroll
            for (int n = 0; n < 2; ++n) gv[bj][n] = *(const f32x4*)(g1 + col0 + bj * 128 + n * 16);
#pragma unroll
        for (int ai = 0; ai < 2; ++ai)
#pragma unroll
            for (int m = 0; m < 4; ++m) { const size_t ro = (size_t)(u.pm * 256 + ai * 128 + wr * 64 + m * 16 + fr) * 2048 + col0;
#pragma unroll
                for (int bj = 0; bj < 2; ++bj)
#pragma unroll
                    for (int n = 0; n < 2; ++n) { const f32x4 xv = *(const f32x4*)(x + ro + bj * 128 + n * 16);
                        *(f32x4*)((float*)(ws + WS_X1) + ro + bj * 128 + n * 16) = xv + gv[bj][n] * acc[ai][bj][m][n]; } }
    }
};

struct MoeTables { LAS const int* tp; LAS const int* cnt; LAS const int* rows; };
template <int NN  > struct SchedMoE {
    const unsigned char* ws; int c; MoeTables T; const char* A; const char* Bt; size_t b_expert_bytes; int nwg;
    __device__ __forceinline__ bool next(int i, Unit& u) const {
        const int L = i * NWG + c; if (L >= nwg) return false;
        const int w = pg8::xcd_chunk(L, nwg);
        int e = 0;
#pragma unroll 1
        for (int j = 1; j < 32; ++j) e = (w >= __builtin_amdgcn_readfirstlane(T.tp[j]) * NN) ? j : e;
        const int t0 = __builtin_amdgcn_readfirstlane(T.tp[e]), t1 = __builtin_amdgcn_readfirstlane(T.tp[e + 1]);
        const int q = w - t0 * NN, mt = t1 - t0;
        u.g = e; u.pm = q % mt; u.pn = q / mt; u.rb = t0; u.cn = __builtin_amdgcn_readfirstlane(T.cnt[e]); return true;
    }
    __device__ __forceinline__ const char* a_ptr(const Unit& u) const { return A; }
    __device__ __forceinline__ const char* b_ptr(const Unit& u) const { return Bt + (size_t)u.g * b_expert_bytes + (size_t)u.pn * 256 * 2048; }
    __device__ __forceinline__ void a_rows(int ui, int wv, unsigned (&off)[2][2]) const {
        const int tid = make_tid(wv); int R0, C0, R1, C1; pg8::stage_rc(tid * 16, R0, C0); pg8::stage_rc(tid * 16 + 8192, R1, C1);
        LAS const int* rw = T.rows + ui * 256;
        const int t00 = rw[R0], t01 = rw[R1], t10 = rw[R0 + 128], t11 = rw[R1 + 128];
        off[0][0] = (unsigned)(t00 * 1024 + C0) * 2u; off[0][1] = (unsigned)(t01 * 1024 + C1) * 2u; off[1][0] = (unsigned)(t10 * 1024 + C0) * 2u; off[1][1] = (unsigned)(t11 * 1024 + C1) * 2u;
    }
};
struct SchedMoE2 : SchedMoE<8> {
    __device__ __forceinline__ const char* a_ptr(const Unit& u) const { return A + (size_t)(u.rb + u.pm) * 256 * 2048; }
};
struct EpiMoE1 {
    static constexpr bool PERM = true;
    unsigned char* ws; const float* b_gu; MoeTables T;
    __device__ __forceinline__ void operator()(const AccT& acc, const Unit& u, int wr, int wc, int fr, int fq) const {
        const int hc = u.pn * 128 + wc * 32 + 8 * fq;
        const float* bg = b_gu + (size_t)u.g * 4096 + hc;
        const f32x4 bg0 = *(const f32x4*)bg, bg1 = *(const f32x4*)(bg + 4), bu0 = *(const f32x4*)(bg + 2048), bu1 = *(const f32x4*)(bg + 2052);
        unsigned char* hid = ws + WS_HID + (size_t)(u.rb + u.pm) * 256 * 2048 + hc;
#pragma unroll
        for (int ai = 0; ai < 2; ++ai)
#pragma unroll
            for (int m = 0; m < 4; ++m) {
                const int rr = ai * 128 + wr * 64 + m * 16 + fr;
                const f32x4 g0 = acc[ai][0][m][0] * FP8_OSCALE + bg0, g1 = acc[ai][0][m][1] * FP8_OSCALE + bg1, u0 = acc[ai][1][m][0] * FP8_OSCALE + bu0, u1 = acc[ai][1][m][1] * FP8_OSCALE + bu1;
                float h[8];
#pragma unroll
                for (int j = 0; j < 4; ++j) { const float ga = fminf(g0[j], 7.0f), ua = fminf(fmaxf(u0[j], -7.0f), 7.0f); h[j] = (ua + 1.0f) * ga * sigmoidf_(1.702f * ga);
                    const float gb = fminf(g1[j], 7.0f), ub = fminf(fmaxf(u1[j], -7.0f), 7.0f); h[4 + j] = (ub + 1.0f) * gb * sigmoidf_(1.702f * gb); }
                u32x2 w; w.x = cvt4_fp8(h[0] * FP8_ASCALE, h[1] * FP8_ASCALE, h[2] * FP8_ASCALE, h[3] * FP8_ASCALE); w.y = cvt4_fp8(h[4] * FP8_ASCALE, h[5] * FP8_ASCALE, h[6] * FP8_ASCALE, h[7] * FP8_ASCALE);
                *(u32x2*)(hid + (size_t)rr * 2048) = w;
            }
    }
};
struct EpiMoE2 {
    static constexpr bool PERM = true;
    unsigned char* ws; const float* b_down; MoeTables T;
    __device__ __forceinline__ void operator()(const AccT& acc, const Unit& u, int wr, int wc, int fr, int fq) const {
        const int n = u.cn; const float* lprob = (const float*)(ws + WS_LPROB) + u.g * 16384 + u.pm * 256;
        bf16_t* out2 = (bf16_t*)(ws + WS_OUT2) + (size_t)(u.rb + u.pm) * 256 * 2048;
#pragma unroll
        for (int bj = 0; bj < 2; ++bj) {
            const int col = u.pn * 256 + bj * 128 + wc * 32 + 8 * fq;
            const f32x4 b0 = *(const f32x4*)(b_down + (size_t)u.g * 2048 + col), b1 = *(const f32x4*)(b_down + (size_t)u.g * 2048 + col + 4);
#pragma unroll
            for (int ai = 0; ai < 2; ++ai)
#pragma unroll
                for (int m = 0; m < 4; ++m) {
                    const int rr = ai * 128 + wr * 64 + m * 16 + fr;
                    const float pr = (u.pm * 256 + rr < n) ? lprob[rr] : 0.f;
                    const f32x4 v0 = (acc[ai][bj][m][0] * FP8_OSCALE + b0) * pr, v1 = (acc[ai][bj][m][1] * FP8_OSCALE + b1) * pr;
                    u32x4 w; w.x = cvt_pk_bf16(v0[0], v0[1]); w.y = cvt_pk_bf16(v0[2], v0[3]); w.z = cvt_pk_bf16(v1[0], v1[1]); w.w = cvt_pk_bf16(v1[2], v1[3]);
                    *(u32x4*)(out2 + (size_t)rr * 2048 + col) = w;
                    asm volatile("" ::: "memory");
                }
        }
    }
};
__device__ __forceinline__ void phase_conv(const Params& p, LAS unsigned char* lds, int wv) {
    const int t = make_tid(wv);
    LAS float* cw = (LAS float*)lds;
    for (int i = t; i < 9216; i += NTHR) cw[i] = p.conv_qk[i];
    __syncthreads();
    const bf16_t* z = (const bf16_t*)(p.ws + WS_ZQK);
    bf16_t* qk = (bf16_t*)(p.ws + WS_QK);
    const int cg = t & 127, rsub = t >> 7, ch0 = cg * 8;
    for (int it = 0; it < NTOK / (NWG * 4); ++it) {
        const int row = 4 * (blockIdx.x + NWG * it) + rsub;
        float acc[8];
#pragma unroll
        for (int j = 0; j < 8; ++j) acc[j] = 0.f;
        const bool lat = row < NLAT;
        int bbase, gr, gc, ncol, nrowmax;
        if (lat) { const int l = row & 2047; bbase = row - l; gr = l >> 6; gc = l & 63; ncol = 64; nrowmax = 32; }
        else { const int rr = row - NLAT, l = rr & 255; bbase = row - l; gr = 0; gc = l; ncol = 256; nrowmax = 1; }
#pragma unroll
        for (int dy = -1; dy <= 1; ++dy)
#pragma unroll
            for (int dx = -1; dx <= 1; ++dx) {
                const int r2 = gr + dy, c2 = gc + dx;
                if (r2 >= 0 && r2 < nrowmax && c2 >= 0 && c2 < ncol) {
                    const u32x4 zv = *(const u32x4*)(z + (size_t)(bbase + r2 * ncol + c2) * 1024 + ch0);
                    LAS const float* w = cw + ((dy + 1) * 3 + (dx + 1)) * 1024 + ch0;
                    const f32x4 w0 = *(LAS const f32x4*)w, w1 = *(LAS const f32x4*)(w + 4);
                    acc[0] += w0[0] * bflo(zv.x); acc[1] += w0[1] * bfhi(zv.x); acc[2] += w0[2] * bflo(zv.y); acc[3] += w0[3] * bfhi(zv.y);
                    acc[4] += w1[0] * bflo(zv.z); acc[5] += w1[1] * bfhi(zv.z); acc[6] += w1[2] * bflo(zv.w); acc[7] += w1[3] * bfhi(zv.w);
                }
            }
        const float sc = ch0 >= 512 ? 0.08838834764831845f : 1.0f;
#pragma unroll
        for (int j = 0; j < 8; ++j) acc[j] = acc[j] * sigmoidf_(acc[j]) * sc;
        u32x4 o; o.x = cvt_pk_bf16(acc[0], acc[1]); o.y = cvt_pk_bf16(acc[2], acc[3]); o.z = cvt_pk_bf16(acc[4], acc[5]); o.w = cvt_pk_bf16(acc[6], acc[7]);
        *(u32x4*)(qk + (size_t)row * 1024 + ch0) = o;
    }
    __syncthreads();
}

__device__ __forceinline__ void phase_s5scan(const Params& p, int wv) {
    const int t = make_tid(wv); if (t >= 256) return;
    const int idx = blockIdx.x * 256 + t, pp = idx & 63, b = (idx >> 6) & 7, dir = (idx >> 9) & 1, g = idx >> 10;
    const float* lb16 = (const float*)(p.ws + WS_LB16) + (size_t)((dir * 64 + g) * 64 + pp) * 2;
    const float ar = lb16[0], ai = lb16[1];
    const float* V = (const float*)(p.ws + WS_VS5) + (size_t)g * 1280 * 256 + dir * 128 + pp;
    bf16_t* X = (bf16_t*)(p.ws + WS_AS5) + (size_t)g * 1280 * 512 + 256 + dir * 128 + pp;
    float xr = 0.f, xi = 0.f;
    {   float vr[16], vi[16];
#pragma unroll
        for (int k = 0; k < 16; ++k) { const int cix = dir ? 15 - k : k; const float* v = V + (size_t)(1024 + b * 16 + cix) * 256; vr[k] = v[0]; vi[k] = v[64]; }
#pragma unroll
        for (int k = 0; k < 16; ++k) { const float nr = ar * xr - ai * xi + vr[k], ni = ar * xi + ai * xr + vi[k]; xr = nr; xi = ni; } }
    for (int blk = 0; blk < 16; ++blk) {
        float vr[8], vi[8];
#pragma unroll
        for (int k = 0; k < 8; ++k) { const int cc = blk * 8 + k, cix = dir ? 127 - cc : cc; const float* v = V + (size_t)(b * 128 + cix) * 256; vr[k] = v[0]; vi[k] = v[64]; }
#pragma unroll
        for (int k = 0; k < 8; ++k) { const int cc = blk * 8 + k, cix = dir ? 127 - cc : cc; bf16_t* x = X + (size_t)(b * 128 + cix) * 512; x[0] = f2bf(xr); x[64] = f2bf(xi);
            const float nr = ar * xr - ai * xi + vr[k], ni = ar * xi + ai * xr + vi[k]; xr = nr; xi = ni; }
    }
}

template <int OFF1> __device__ __forceinline__ bf16x8 tr_frag(unsigned addr) {
    s16x4 a, b;
    asm volatile("ds_read_b64_tr_b16 %0, %2\n\tds_read_b64_tr_b16 %1, %2 offset:%3\n\ts_waitcnt lgkmcnt(0)" : "=&v"(a), "=&v"(b) : "v"(addr), "i"(OFF1) : "memory");
    bf16x8 r; r[0] = a[0]; r[1] = a[1]; r[2] = a[2]; r[3] = a[3]; r[4] = b[0]; r[5] = b[1]; r[6] = b[2]; r[7] = b[3]; return r;
}
constexpr int ML_QS = 0, ML_KS = 17408, ML_VS = 34816, ML_WVS = 46080, ML_SS = 57344, ML_CS = 66560, ML_VEC = 89088;
__device__ __forceinline__ void phase_mlstm(const Params& p, LAS unsigned char* lds, int wv) {
    const int t = make_tid(wv);
    const int lane = t & 63, wid = wv, c = blockIdx.x;
    const int bh = c & 31, b = bh >> 2, hd = bh & 3, dq = c >> 5, dir = dq >> 2, qt = dq & 3;
    const int l15 = lane & 15, g4 = lane >> 4, q4 = (lane & 15) >> 2, p4 = lane & 3;
    LAS float* vec = (LAS float*)(lds + ML_VEC);
    const unsigned ldsb = (unsigned)(size_t)lds;
    for (int i = t; i < 128 * 176 / 4; i += NTHR) ((LAS unsigned*)(lds + ML_CS))[i] = 0u;
    for (int i = t; i < 64 * 8; i += NTHR) { const int s = i >> 3, w = i & 7; ((LAS unsigned*)(lds + ML_VS + s * 176 + 128))[w] = (w == 0) ? 0x00003f80u : 0u; ((LAS unsigned*)(lds + ML_WVS + s * 176 + 128))[w] = 0u; }
    const bf16_t* QK = (const bf16_t*)(p.ws + WS_QK); const bf16_t* VB = (const bf16_t*)(p.ws + WS_VBUF); const float* GT = (const float*)(p.ws + WS_GATES);
    float* HB = (float*)(p.ws + WS_HBUF) + (size_t)dir * NLAT * 1024;
    f32x4 accC[5];
#pragma unroll
    for (int v = 0; v < 5; ++v) accC[v] = (f32x4){0.f, 0.f, 0.f, 0.f};
    float m0 = 0.f;
    u32x4 rq[2], rk[2], rv; float rig = 0.f, rlf = 0.f;
    auto tokbase = [&](int st) -> int { if (st < 4) { const int cc = dir ? 3 - st : st; return NLAT + b * 256 + cc * 64; } const int cc = dir ? 31 - (st - 4) : (st - 4); return b * 2048 + cc * 64; };
    auto issue = [&](int st) {
        const int base = tokbase(st);
#pragma unroll
        for (int i = 0; i < 2; ++i) { const int id = t + 512 * i, j = id >> 4, ch = id & 15; const size_t row = (size_t)(base + (dir ? 63 - j : j));
            if (st >= 4) rq[i] = *(const u32x4*)(QK + row * 1024 + hd * 128 + ch * 8);
            rk[i] = *(const u32x4*)(QK + row * 1024 + 512 + hd * 128 + ch * 8); }
        { const int j = t >> 3, ch = t & 7; const size_t row = (size_t)(base + (dir ? 63 - j : j)); rv = *(const u32x4*)(VB + row * 1024 + hd * 256 + qt * 64 + ch * 8); }
        if (t < 64) { const size_t row = (size_t)(base + (dir ? 63 - t : t)); rig = GT[row * 16 + (2 * dir) * 4 + hd]; rlf = GT[row * 16 + (2 * dir + 1) * 4 + hd]; }
    };
    issue(0);
    __syncthreads();
    for (int st = 0; st < 36; ++st) {
        const bool lat = st >= 4;
        const int base = tokbase(st);
#pragma unroll
        for (int i = 0; i < 2; ++i) { const int id = t + 512 * i, j = id >> 4, ch = id & 15;
            if (lat) *(LAS u32x4*)(lds + ML_QS + j * 272 + ch * 16) = rq[i];
            *(LAS u32x4*)(lds + ML_KS + j * 272 + ch * 16) = rk[i]; }
        { const int j = t >> 3, ch = t & 7; *(LAS u32x4*)(lds + ML_VS + j * 176 + ch * 16) = rv; }
        if (wid == 0) {
            float bc = rlf;
#pragma unroll
            for (int o = 1; o < 64; o <<= 1) { const float n = bperm(bc, lane - o); if (lane >= o) bc += n; }
            const float gtot = bperm(bc, 63);
            const float beta = rig - bc;
            float pm = beta;
#pragma unroll
            for (int o = 1; o < 64; o <<= 1) { const float n = bperm(pm, lane - o); if (lane >= o) pm = fmaxf(pm, n); }
            const float mm = fmaxf(m0, pm);
            const float mloc = gtot + bperm(pm, 63);
            const float mnew = fmaxf(gtot + m0, mloc);
            vec[lane] = -mm; vec[64 + lane] = beta; vec[128 + lane] = __expf(m0 - mm); vec[192 + lane] = __expf(-(bc + mm)); vec[256 + lane] = __expf(gtot + beta - mnew);
            if (lane == 0) vec[320] = __expf(gtot + m0 - mnew);
            m0 = mnew;
        }
        if (st + 1 < 36) issue(st + 1);
        __syncthreads();
        if (lat) {
#pragma unroll
            for (int ii = 0; ii < 2; ++ii) { const int idx = 2 * wid + ii, jt = idx >> 2, stl = idx & 3;
                f32x4 a4 = (f32x4){0.f, 0.f, 0.f, 0.f};
                if (stl <= jt) {
#pragma unroll
                    for (int ks = 0; ks < 4; ++ks) { const bf16x8 A = *(const LAS bf16x8*)(lds + ML_QS + (jt * 16 + l15) * 272 + (ks * 32 + 8 * g4) * 2);
                        const bf16x8 B = *(const LAS bf16x8*)(lds + ML_KS + (stl * 16 + l15) * 272 + (ks * 32 + 8 * g4) * 2);
                        a4 = __builtin_amdgcn_mfma_f32_16x16x32_bf16(A, B, a4, 0, 0, 0); }
                }
                const int sp = stl * 16 + l15; const float be = vec[64 + sp];
#pragma unroll
                for (int r = 0; r < 4; ++r) { const int jp = jt * 16 + 4 * g4 + r; const float v = (sp <= jp) ? a4[r] * __expf(vec[jp] + be) : 0.f;
                    *(LAS bf16_t*)(lds + ML_SS + jp * 144 + sp * 2) = f2bf(v); }
            }
        }
        { const int s = t >> 3, ch = t & 7; const float w = vec[256 + s]; const u32x4 vv = *(const LAS u32x4*)(lds + ML_VS + s * 176 + ch * 16); u32x4 o;
          o.x = cvt_pk_bf16(w * bflo(vv.x), w * bfhi(vv.x)); o.y = cvt_pk_bf16(w * bflo(vv.y), w * bfhi(vv.y)); o.z = cvt_pk_bf16(w * bflo(vv.z), w * bfhi(vv.z)); o.w = cvt_pk_bf16(w * bflo(vv.w), w * bfhi(vv.w));
          *(LAS u32x4*)(lds + ML_WVS + s * 176 + ch * 16) = o;
          if (t < 64) *(LAS bf16_t*)(lds + ML_WVS + t * 176 + 128) = f2bf(vec[256 + t]); }
        __syncthreads();
        if (lat) {
            const int jt = wid >> 1; f32x4 o3[3];
#pragma unroll
            for (int ti = 0; ti < 3; ++ti) { const int vt = (ti == 2) ? 4 : ((wid & 1) * 2 + ti);
                f32x4 a4 = (f32x4){0.f, 0.f, 0.f, 0.f};
#pragma unroll
                for (int ks = 0; ks < 4; ++ks) { const bf16x8 A = *(const LAS bf16x8*)(lds + ML_QS + (jt * 16 + l15) * 272 + (ks * 32 + 8 * g4) * 2);
                    const bf16x8 B = tr_frag<4 * 176>(ldsb + ML_CS + (ks * 32 + 8 * g4 + q4) * 176 + (vt * 16 + 4 * p4) * 2);
                    a4 = __builtin_amdgcn_mfma_f32_16x16x32_bf16(A, B, a4, 0, 0, 0); }
#pragma unroll
                for (int r = 0; r < 4; ++r) a4[r] *= vec[128 + jt * 16 + 4 * g4 + r];
#pragma unroll
                for (int ks = 0; ks < 2; ++ks) { const bf16x8 A = *(const LAS bf16x8*)(lds + ML_SS + (jt * 16 + l15) * 144 + (ks * 32 + 8 * g4) * 2);
                    const bf16x8 B = tr_frag<4 * 176>(ldsb + ML_VS + (ks * 32 + 8 * g4 + q4) * 176 + (vt * 16 + 4 * p4) * 2);
                    a4 = __builtin_amdgcn_mfma_f32_16x16x32_bf16(A, B, a4, 0, 0, 0); }
                o3[ti] = a4; }
            float inv[4];
#pragma unroll
            for (int r = 0; r < 4; ++r) { const float dn = bperm(o3[2][r], lane & 48); inv[r] = 1.0f / fmaxf(fabsf(dn), vec[192 + jt * 16 + 4 * g4 + r]); }
#pragma unroll
            for (int ti = 0; ti < 2; ++ti) { const int vt = (wid & 1) * 2 + ti;
#pragma unroll
                for (int r = 0; r < 4; ++r) { const int jp = jt * 16 + 4 * g4 + r; const size_t row = (size_t)(base + (dir ? 63 - jp : jp));
                    HB[row * 1024 + hd * 256 + qt * 64 + vt * 16 + l15] = o3[ti][r] * inv[r]; } }
        }
        { const float sprev = vec[320];
          bf16x8 Bk[2];
#pragma unroll
          for (int ks = 0; ks < 2; ++ks) Bk[ks] = tr_frag<4 * 272>(ldsb + ML_KS + (ks * 32 + 8 * g4 + q4) * 272 + (wid * 16 + 4 * p4) * 2);
#pragma unroll
          for (int vt = 0; vt < 5; ++vt) { accC[vt] *= sprev;
#pragma unroll
              for (int ks = 0; ks < 2; ++ks) { const bf16x8 A = tr_frag<4 * 176>(ldsb + ML_WVS + (ks * 32 + 8 * g4 + q4) * 176 + (vt * 16 + 4 * p4) * 2);
                  accC[vt] = __builtin_amdgcn_mfma_f32_16x16x32_bf16(A, Bk[ks], accC[vt], 0, 0, 0); } } }
        __syncthreads();
#pragma unroll
        for (int vt = 0; vt < 5; ++vt) { u32x2 w; w.x = cvt_pk_bf16(accC[vt][0], accC[vt][1]); w.y = cvt_pk_bf16(accC[vt][2], accC[vt][3]);
            *(LAS u32x2*)(lds + ML_CS + (wid * 16 + l15) * 176 + (vt * 16 + 4 * g4) * 2) = w; }
    }
    __syncthreads();
}

__device__ __forceinline__ void phase_hmerge(const Params& p, int wv) {
    const int t = make_tid(wv);
    const int lane = t & 63, wid = t >> 6;
    const float* H0 = (const float*)(p.ws + WS_HBUF); const float* H1 = H0 + (size_t)NLAT * 1024;
    const bf16_t* O = (const bf16_t*)(p.ws + WS_OBUF); bf16_t* CAT = (bf16_t*)(p.ws + WS_CAT);
    for (int i = 0; i < 8; ++i) { const size_t row = (size_t)blockIdx.x * 64 + wid * 8 + i;
#pragma unroll
        for (int hd = 0; hd < 4; ++hd) { const int col = hd * 256 + lane * 4;
            const f32x4 a = *(const f32x4*)(H0 + row * 1024 + col), bb = *(const f32x4*)(H1 + row * 1024 + col); const f32x4 h = a + bb;
            const float ss = wave_sum(h[0] * h[0] + h[1] * h[1] + h[2] * h[2] + h[3] * h[3], lane);
            const float rstd = rsqrtf(ss * (1.0f / 256.0f) + 1e-6f);
            const f32x4 gg = *(const f32x4*)(p.head_g + col); const u32x2 ow = *(const u32x2*)(O + row * 1024 + col);
            const float o0 = h[0] * rstd * gg[0] * sigmoidf_(bflo(ow.x)), o1 = h[1] * rstd * gg[1] * sigmoidf_(bfhi(ow.x)), o2 = h[2] * rstd * gg[2] * sigmoidf_(bflo(ow.y)), o3 = h[3] * rstd * gg[3] * sigmoidf_(bfhi(ow.y));
            u32x2 w; w.x = cvt_pk_bf16(o0, o1); w.y = cvt_pk_bf16(o2, o3);
            *(u32x2*)(CAT + row * 2048 + col) = w; } }
}
constexpr int RT_XR = 0, RT_XSTRIDE = 8208, RT_RED = 16 * RT_XSTRIDE  , RT_LG = RT_RED + 8 * 16 * 32 * 4  , RT_RSTD = RT_LG + 2048, RT_SEL = RT_RSTD + 64;
__device__ __forceinline__ void phase_router(const Params& p, LAS unsigned char* lds, int wv) {
    const int t = make_tid(wv);
    const int lane = t & 63, wid = wv, l15 = lane & 15, g4 = lane >> 4;
    const float* X1 = (const float*)(p.ws + WS_X1); unsigned char* U2 = p.ws + WS_U2; const bf16_t* WRT = (const bf16_t*)(p.ws + WS_WRT);
    LAS float* red = (LAS float*)(lds + RT_RED); LAS float* lg = (LAS float*)(lds + RT_LG); LAS float* rstd = (LAS float*)(lds + RT_RSTD);
    LAS int* se = (LAS int*)(lds + RT_SEL); LAS float* sp = (LAS float*)(lds + RT_SEL + 1024); LAS int* sr = (LAS int*)(lds + RT_SEL + 2048); LAS int* lc = (LAS int*)(lds + RT_SEL + 3072); LAS int* lbase = lc + 32;
    const int bidx = blockIdx.x >> 5;
    const float* mod = (const float*)(p.ws + WS_MOD) + (size_t)bidx * 12288; const float* sh2 = mod + 3 * 2048; const float* sc2 = mod + 4 * 2048;
    if (t < 32) lc[t] = 0;
    for (int it = 0; it < 4; ++it) {
        const int row0 = blockIdx.x * 64 + it * 16;
        for (int i = 0; i < 16; ++i) { const int id = t + NTHR * i, r = id >> 9, c4 = id & 511; *(LAS f32x4*)(lds + RT_XR + r * RT_XSTRIDE + c4 * 16) = *(const f32x4*)(X1 + (size_t)(row0 + r) * 2048 + c4 * 4); }
        __syncthreads();
#pragma unroll
        for (int rr = 0; rr < 2; ++rr) { const int r = wid * 2 + rr; float ss = 0.f;
#pragma unroll
            for (int i = 0; i < 8; ++i) { const f32x4 v = *(const LAS f32x4*)(lds + RT_XR + r * RT_XSTRIDE + (i * 64 + lane) * 16); ss += v[0] * v[0] + v[1] * v[1] + v[2] * v[2] + v[3] * v[3]; }
            ss = wave_sum(ss, lane); if (lane == 0) rstd[r] = rsqrtf(ss * (1.0f / 2048.0f) + 1e-6f); }
        __syncthreads();
        f32x4 acc[2]; acc[0] = (f32x4){0.f, 0.f, 0.f, 0.f}; acc[1] = acc[0];
        const float rs = rstd[l15];
#pragma unroll 2
        for (int s = 0; s < 8; ++s) { const int k0 = wid * 256 + s * 32 + 8 * g4;
            const f32x4 x0 = *(const LAS f32x4*)(lds + RT_XR + l15 * RT_XSTRIDE + k0 * 4), x1 = *(const LAS f32x4*)(lds + RT_XR + l15 * RT_XSTRIDE + k0 * 4 + 16);
            const f32x4 ga = *(const f32x4*)(p.norm2_g + k0), gb = *(const f32x4*)(p.norm2_g + k0 + 4), sa = *(const f32x4*)(sc2 + k0), sb = *(const f32x4*)(sc2 + k0 + 4), ha = *(const f32x4*)(sh2 + k0), hb = *(const f32x4*)(sh2 + k0 + 4);
            const f32x4 u0 = x0 * rs * ga * (sa + 1.0f) + ha, u1 = x1 * rs * gb * (sb + 1.0f) + hb;
            u32x4 hi; hi.x = cvt_pk_bf16(u0[0], u0[1]); hi.y = cvt_pk_bf16(u0[2], u0[3]); hi.z = cvt_pk_bf16(u1[0], u1[1]); hi.w = cvt_pk_bf16(u1[2], u1[3]);
            { u32x2 f8; f8.x = cvt4_fp8(u0[0] * FP8_ASCALE, u0[1] * FP8_ASCALE, u0[2] * FP8_ASCALE, u0[3] * FP8_ASCALE); f8.y = cvt4_fp8(u1[0] * FP8_ASCALE, u1[1] * FP8_ASCALE, u1[2] * FP8_ASCALE, u1[3] * FP8_ASCALE);
              *(u32x2*)(U2 + (size_t)(row0 + l15) * 2048 + k0) = f8; }
            u32x4 lo; lo.x = cvt_pk_bf16(u0[0] - bflo(hi.x), u0[1] - bfhi(hi.x)); lo.y = cvt_pk_bf16(u0[2] - bflo(hi.y), u0[3] - bfhi(hi.y));
            lo.z = cvt_pk_bf16(u1[0] - bflo(hi.z), u1[1] - bfhi(hi.z)); lo.w = cvt_pk_bf16(u1[2] - bflo(hi.w), u1[3] - bfhi(hi.w));
            bf16x8 Ah, Al; __builtin_memcpy(&Ah, &hi, 16); __builtin_memcpy(&Al, &lo, 16);
#pragma unroll
            for (int nt = 0; nt < 2; ++nt) { const bf16x8 Bh = *(const bf16x8*)(WRT + (size_t)(nt * 16 + l15) * 2048 + k0), Bl = *(const bf16x8*)(WRT + (size_t)(32 + nt * 16 + l15) * 2048 + k0);
                acc[nt] = __builtin_amdgcn_mfma_f32_16x16x32_bf16(Ah, Bh, acc[nt], 0, 0, 0); acc[nt] = __builtin_amdgcn_mfma_f32_16x16x32_bf16(Ah, Bl, acc[nt], 0, 0, 0); acc[nt] = __builtin_amdgcn_mfma_f32_16x16x32_bf16(Al, Bh, acc[nt], 0, 0, 0); } }
#pragma unroll
        for (int nt = 0; nt < 2; ++nt)
#pragma unroll
            for (int r = 0; r < 4; ++r) red[(wid * 16 + 4 * g4 + r) * 32 + nt * 16 + l15] = acc[nt][r];
        __syncthreads();
        { const int tok = t >> 5, e = t & 31; float s = p.b_router[e];
#pragma unroll
          for (int w = 0; w < 8; ++w) s += red[(w * 16 + tok) * 32 + e];
          lg[tok * 32 + e] = s; }
        __syncthreads();
        if (t < 16) { float v[4]; int ix[4];
#pragma unroll
            for (int k = 0; k < 4; ++k) { float best = -3.0e38f; int bi = 0;
                for (int e = 0; e < 32; ++e) { const float x = lg[t * 32 + e]; bool taken = false;
#pragma unroll
                    for (int k2 = 0; k2 < 4; ++k2) taken = taken || (k2 < k && ix[k2] == e);
                    if (!taken && x > best) { best = x; bi = e; } }
                v[k] = best; ix[k] = bi; }
            const float e1 = __expf(v[1] - v[0]), e2 = __expf(v[2] - v[0]), e3 = __expf(v[3] - v[0]), inv = 1.0f / (1.0f + e1 + e2 + e3);
            const int tl = it * 16 + t;
            se[tl * 4 + 0] = ix[0]; se[tl * 4 + 1] = ix[1]; se[tl * 4 + 2] = ix[2]; se[tl * 4 + 3] = ix[3];
            sp[tl * 4 + 0] = inv; sp[tl * 4 + 1] = e1 * inv; sp[tl * 4 + 2] = e2 * inv; sp[tl * 4 + 3] = e3 * inv; }
        __syncthreads();
    }
    if (t < 256) sr[t] = atomicAdd((int*)&lc[se[t]], 1);
    __syncthreads();
    if (t < 32) lbase[t] = (int)atomicAdd((unsigned*)(p.ws + WS_CTRL + CTRL_CNT) + t, (unsigned)lc[t]);
    __syncthreads();
    if (t < 256) { const int e = se[t], pos = lbase[e] + sr[t], tok = blockIdx.x * 64 + (t >> 2);
        ((int*)(p.ws + WS_LIST))[e * 16384 + pos] = tok; ((float*)(p.ws + WS_LPROB))[e * 16384 + pos] = sp[t];
        ((int*)(p.ws + WS_TKE))[tok * 4 + (t & 3)] = e; ((int*)(p.ws + WS_TKP))[tok * 4 + (t & 3)] = pos; }
    __syncthreads();
}

__device__ __forceinline__ MoeTables moe_tables(const Params& p, LAS unsigned char* lds_tab, int wv) {
    const int t = make_tid(wv);
    LAS int* tp = (LAS int*)lds_tab; LAS int* cnt = tp + 64;
    const unsigned* gc = (const unsigned*)(p.ws + WS_CTRL + CTRL_CNT);
    if (t < 32) cnt[t] = (int)__hip_atomic_load(gc + t, __ATOMIC_RELAXED, __HIP_MEMORY_SCOPE_AGENT);
    __syncthreads();
    if (t == 0) { int s = 0; for (int e = 0; e < 32; ++e) { tp[e] = s; s += (cnt[e] + 255) >> 8; } tp[32] = s; }
    __syncthreads();
    MoeTables T; T.tp = tp; T.cnt = cnt; T.rows = tp + 128; return T;
}
template <class Sched> __device__ __forceinline__ void moe_rows_preload(const Params& p, const Sched& S, const MoeTables& T, int wv) {
    const int t = make_tid(wv); LAS int* rows = (LAS int*)T.rows; pg8::Unit u;
    for (int ui = 0; ui < 18 && S.next(ui, u); ++ui) if (t < 256) { const int q = u.pm * 256 + t; rows[ui * 256 + t] = q < u.cn ? ((const int*)(p.ws + WS_LIST))[u.g * 16384 + q] : 0; }
    __syncthreads();
}

__device__ __forceinline__ void phase_final(const Params& p, const MoeTables& T, int wv) {
    const int t = make_tid(wv);
    const int lane = t & 63, wid = t >> 6;
    const float* X1 = (const float*)(p.ws + WS_X1); const bf16_t* O2 = (const bf16_t*)(p.ws + WS_OUT2);
    const int* tke = (const int*)(p.ws + WS_TKE); const int* tkp = (const int*)(p.ws + WS_TKP);
    for (int i = 0; i < 8; ++i) { const int row = blockIdx.x * 64 + wid * 8 + i;
        const float* g2 = (const float*)(p.ws + WS_MOD) + (size_t)(row >> 11) * 12288 + 5 * 2048;
        size_t srow[4];
#pragma unroll
        for (int k = 0; k < 4; ++k) { const int e = tke[row * 4 + k], pos = tkp[row * 4 + k]; srow[k] = (size_t)(T.tp[e] * 256 + pos) * 2048; }
        f32x4 v[8]; float ss = 0.f;
#pragma unroll
        for (int j = 0; j < 8; ++j) { const int col = (j * 64 + lane) * 4; f32x4 m = (f32x4){0.f, 0.f, 0.f, 0.f};
#pragma unroll
            for (int k = 0; k < 4; ++k) { const u32x2 w = *(const u32x2*)(O2 + srow[k] + col); m[0] += bflo(w.x); m[1] += bfhi(w.x); m[2] += bflo(w.y); m[3] += bfhi(w.y); }
            const f32x4 x = *(const f32x4*)(X1 + (size_t)row * 2048 + col), gg = *(const f32x4*)(g2 + col);
            v[j] = x + gg * m; ss += v[j][0] * v[j][0] + v[j][1] * v[j][1] + v[j][2] * v[j][2] + v[j][3] * v[j][3]; }
        ss = wave_sum(ss, lane); const float rstd = rsqrtf(ss * (1.0f / 2048.0f) + 1e-6f);
#pragma unroll
        for (int j = 0; j < 8; ++j) { const int col = (j * 64 + lane) * 4; const f32x4 fg = *(const f32x4*)(p.final_g + col); *(f32x4*)(p.out + (size_t)row * 2048 + col) = v[j] * rstd * fg; }
    }
}
#ifndef DEV_STAGE
#define DEV_STAGE 9
#endif
__device__ __forceinline__ void phase_final_simple(const Params& p, const float* src, int wv) {
    const int t = make_tid(wv), lane = t & 63, wid = t >> 6;
    for (int i = 0; i < 8; ++i) { const int row = blockIdx.x * 64 + wid * 8 + i; f32x4 v[8]; float ss = 0.f;
#pragma unroll
        for (int j = 0; j < 8; ++j) { v[j] = *(const f32x4*)(src + (size_t)row * 2048 + (j * 64 + lane) * 4); ss += v[j][0] * v[j][0] + v[j][1] * v[j][1] + v[j][2] * v[j][2] + v[j][3] * v[j][3]; }
        ss = wave_sum(ss, lane); const float rstd = rsqrtf(ss * (1.0f / 2048.0f) + 1e-6f);
#pragma unroll
        for (int j = 0; j < 8; ++j) { const int col = (j * 64 + lane) * 4; *(f32x4*)(p.out + (size_t)row * 2048 + col) = v[j] * rstd * *(const f32x4*)(p.final_g + col); } }
}

__global__ void __launch_bounds__(512, 2) fwd_kernel(Params p) {
    extern __shared__ __attribute__((aligned(16))) unsigned char smem[];
    LAS unsigned char* lds = (LAS unsigned char*)smem;
    volatile LAS unsigned* xbw = (volatile LAS unsigned*)(lds + LDS_BYTES - 16);
    const int wv = __builtin_amdgcn_readfirstlane(threadIdx.x >> 6);
    const bool t0 = (wv == 0 && lane_id() == 0);
    if (t0) { xbw[0] = 0u; xbw[1] = 0u; xbw[2] = 0u; xbw[3] = 0u; }
    __syncthreads();
    XcdBarrier bar = xcd_barrier_post((unsigned*)(p.ws + WS_CTRL), xbw, t0);
    const int c = blockIdx.x;

    phase0(p, lds, wv);
    xcd_barrier(bar, wv);
    phase1(p, lds, wv);
    xcd_barrier(bar, wv);
#if DEV_STAGE == 1
    phase_final_simple(p, p.x, wv);
#else
    { SchedInProj S; S.ws = p.ws; S.c = c; EpiInProj E; E.ws = p.ws; pg8::gemm_phase<EpiInProj, SchedInProj, 2048, 2048, false>(lds, S, E, wv); }
    xcd_barrier(bar, wv);
    { SchedS5V S; S.ws = p.ws; S.c = c; EpiS5V E; E.ws = p.ws; pg8::gemm_phase<EpiS5V, SchedS5V, 256, 512, false>(lds, S, E, wv); }
    phase_conv(p, lds, wv);
    xcd_barrier(bar, wv);
    phase_s5scan(p, wv);
#if DEV_STAGE >= 3
    phase_mlstm(p, lds, wv);
#endif
    xcd_barrier(bar, wv);
    { SchedS5Y S; S.ws = p.ws; S.c = c; EpiS5Y E; E.ws = p.ws; E.s5_d = p.s5_d; pg8::gemm_phase<EpiS5Y, SchedS5Y, 512, 512, false>(lds, S, E, wv); }
#if DEV_STAGE >= 3
    phase_hmerge(p, wv);
#else
    { bf16_t* CAT = (bf16_t*)(p.ws + WS_CAT); for (int i = make_tid(wv); i < 64 * 128; i += NTHR) { const int r = i >> 7, q = i & 127; *(u32x4*)(CAT + ((size_t)blockIdx.x * 64 + r) * 2048 + q * 8) = (u32x4){0u, 0u, 0u, 0u}; } }
#endif
    xcd_barrier(bar, wv);
    { SchedStatic<4> S; S.A = (const char*)(p.ws + WS_SBUF); S.Bt = (const char*)(p.ws + WS_WGLU_T); S.c = c; S.a_tile_bytes = (size_t)256 * 1024 * 2; S.b_tile_bytes = (size_t)256 * 1024 * 2;
      EpiGLU E; E.ws = p.ws; pg8::gemm_phase<EpiGLU, SchedStatic<4>, 1024, 1024, false>(lds, S, E, wv); }
    xcd_barrier(bar, wv);
    { SchedStatic<8> S; S.A = (const char*)(p.ws + WS_CAT); S.Bt = (const char*)(p.ws + WS_WOUT_T); S.c = c; S.a_tile_bytes = (size_t)256 * 2048 * 2; S.b_tile_bytes = (size_t)256 * 2048 * 2;
      EpiOut E; E.ws = p.ws; E.x = p.x; pg8::gemm_phase<EpiOut, SchedStatic<8>, 2048, 2048, false>(lds, S, E, wv); }
    xcd_barrier(bar, wv);
#if DEV_STAGE < 9
    phase_final_simple(p, (const float*)(p.ws + WS_X1), wv);
#else
    phase_router(p, lds, wv);
    xcd_barrier(bar, wv);
    const MoeTables T = moe_tables(p, lds + 139264, wv);
    { SchedMoE<16> S; S.ws = p.ws; S.c = c; S.T = T; S.A = (const char*)(p.ws + WS_U2); S.Bt = (const char*)(p.ws + WS_WGU_T); S.b_expert_bytes = (size_t)4096 * 2048; S.nwg = __builtin_amdgcn_readfirstlane(T.tp[32]) * 16; moe_rows_preload(p, S, T, wv);
      EpiMoE1 E; E.ws = p.ws; E.b_gu = p.b_gu; E.T = T; pg8::gemm_phase<EpiMoE1, SchedMoE<16>, 1024, 1024, true, true>(lds, S, E, wv); }
    xcd_barrier(bar, wv);
    { SchedMoE2 S; S.ws = p.ws; S.c = c; S.T = T; S.A = (const char*)(p.ws + WS_HID); S.Bt = (const char*)(p.ws + WS_WDN_T); S.b_expert_bytes = (size_t)2048 * 2048; S.nwg = __builtin_amdgcn_readfirstlane(T.tp[32]) * 8;
      EpiMoE2 E; E.ws = p.ws; E.b_down = p.b_down; E.T = T; pg8::gemm_phase<EpiMoE2, SchedMoE2, 1024, 1024, false, true>(lds, S, E, wv); }
    xcd_barrier(bar, wv);
    phase_final(p, T, wv);
#endif
#endif
}

extern "C" void kernel_launch(void* const* d_in, const int* in_sizes, int n_in, void* d_out, int out_size, void* d_ws, size_t ws_size, hipStream_t stream) {
    static int ready = 0;
    if (ready == 0) {
        if (n_in != 29 || out_size != NLAT * D || ws_size < WS_END) { fprintf(stderr, "kernel_launch: unexpected shapes (n_in %d out %d ws %zu need %zu)\n", n_in, out_size, ws_size, (size_t)WS_END); ready = -1; return; }
        if (hipFuncSetAttribute((const void*)fwd_kernel, hipFuncAttributeMaxDynamicSharedMemorySize, LDS_BYTES) != hipSuccess) { fprintf(stderr, "kernel_launch: hipFuncSetAttribute failed\n"); ready = -1; return; }
        ready = 1;
    }
    if (ready < 0) return;
    (void)hipMemsetAsync((char*)d_ws + WS_CTRL, 0, CTRL_BYTES, stream);
    Params p;
    memset(&p, 0, sizeof(p));
    const float** f = (const float**)&p;
    for (int i = 0; i < 29; ++i) f[i] = (const float*)d_in[i];
    p.out = (float*)d_out; p.ws = (unsigned char*)d_ws;
    hipLaunchKernelGGL(fwd_kernel, dim3(NWG), dim3(NTHR), LDS_BYTES, stream, p);
}
```

```cpp
#include <hip/hip_runtime.h>
#include <stdint.h>
#include <stdio.h>
#include <string.h>

#define LAS __attribute__((address_space(3)))
typedef unsigned short bf16_t;
typedef short bf16x8 __attribute__((ext_vector_type(8)));
typedef short s16x4 __attribute__((ext_vector_type(4)));
typedef float f32x4 __attribute__((ext_vector_type(4)));
typedef float f32x2 __attribute__((ext_vector_type(2)));
typedef unsigned u32x4 __attribute__((ext_vector_type(4)));
typedef unsigned u32x2 __attribute__((ext_vector_type(2)));

constexpr int D = 2048, NB = 8, SEQ = 2048, CTXL = 256;
constexpr int NLAT = NB * SEQ;
constexpr int NCTX = NB * CTXL;
constexpr int NTOK = NLAT + NCTX;
constexpr int DIN = 4112;
constexpr int NE = 32, TOPK = 4, DFF = 2048;
constexpr int NWG = 256, NTHR = 512;
constexpr int LDS_BYTES = 163840;
constexpr int MOE_ROWS = 73728;

constexpr size_t al256(size_t x) { return (x + 255) & ~(size_t)255; }
constexpr size_t WS_CTRL  = 0;
constexpr size_t CTRL_BYTES = 65536;
constexpr size_t CTRL_CNT = 16384;
constexpr int MODKS = 16;
constexpr size_t WS_MODP  = WS_CTRL + CTRL_BYTES;
constexpr size_t WS_MOD   = WS_MODP + (size_t)MODKS * 9 * 12288 * 4;
constexpr size_t WS_LB16  = WS_MOD + (size_t)9 * 12288 * 4;
constexpr size_t WS_WRT   = WS_LB16 + 65536;
constexpr size_t WS_WIN_T = WS_WRT + 262144;
constexpr size_t WS_WGLU_T = WS_WIN_T + (size_t)4096 * 2048 * 2;
constexpr size_t WS_WOUT_T = WS_WGLU_T + (size_t)1024 * 1024 * 2;
constexpr size_t WS_BTV   = WS_WOUT_T + (size_t)2048 * 2048 * 2;
constexpr size_t WS_BTY   = WS_BTV + (size_t)64 * 256 * 256 * 2;
constexpr size_t WS_U1    = WS_BTY + (size_t)64 * 256 * 512 * 2;
constexpr size_t WS_GATES = WS_U1 + (size_t)NTOK * 2048 * 2;
constexpr size_t WS_ZQK   = WS_GATES + (size_t)NTOK * 16 * 4;
constexpr size_t WS_QK    = WS_ZQK + (size_t)NTOK * 1024 * 2;
constexpr size_t WS_VBUF  = WS_QK + (size_t)NTOK * 1024 * 2;
constexpr size_t WS_OBUF  = WS_VBUF + (size_t)NTOK * 1024 * 2;
constexpr size_t WS_AS5   = WS_OBUF + (size_t)NLAT * 1024 * 2;
constexpr size_t WS_VS5   = WS_AS5 + (size_t)64 * 1280 * 512 * 2;
constexpr size_t WS_HBUF  = WS_VS5 + (size_t)64 * 1280 * 256 * 4;
constexpr size_t WS_SBUF  = WS_HBUF + (size_t)2 * NLAT * 1024 * 4;
constexpr size_t WS_CAT   = WS_SBUF + (size_t)NLAT * 1024 * 2;
constexpr size_t WS_X1    = WS_CAT + (size_t)NLAT * 2048 * 2;
constexpr size_t WS_U2    = WS_X1 + (size_t)NLAT * 2048 * 4;
constexpr size_t WS_TKE   = WS_U2 + (size_t)NLAT * 2048 * 2;
constexpr size_t WS_TKP   = WS_TKE + (size_t)NLAT * 16;
constexpr size_t WS_LIST  = WS_TKP + (size_t)NLAT * 16;
constexpr size_t WS_LPROB = WS_LIST + (size_t)32 * 16384 * 4;
constexpr size_t WS_HID   = WS_LPROB + (size_t)32 * 16384 * 4;
constexpr size_t WS_OUT2  = WS_HID + (size_t)MOE_ROWS * 2048 * 2;
constexpr size_t WS_WGU_T = WS_OUT2 + (size_t)MOE_ROWS * 2048 * 2;
constexpr size_t WS_WDN_T = WS_WGU_T + (size_t)32 * 4096 * 2048 * 2;
constexpr size_t WS_END   = WS_WDN_T + (size_t)32 * 2048 * 2048 * 2;

struct Params {
    const float *x, *c, *ctx, *c_ctx, *w_ada, *b_ada, *norm1_g, *w_in, *conv_qk, *gate_bias, *head_g,
                *lam_re, *lam_im, *log_dt, *b_re, *b_im, *c_re, *c_im, *s5_d, *w_glu, *w_out, *norm2_g,
                *w_router, *b_router, *w_gu, *b_gu, *w_down, *b_down, *final_g;
    float* out;
    unsigned char* ws;
};

__device__ __forceinline__ unsigned cvt_pk_bf16(float lo, float hi) { unsigned r; asm volatile("v_cvt_pk_bf16_f32 %0, %1, %2" : "=v"(r) : "v"(lo), "v"(hi)); return r; }
__device__ __forceinline__ unsigned cvt4_fp8_raw(float a, float b, float c, float d) { int w = 0; w = __builtin_amdgcn_cvt_pk_fp8_f32(a, b, w, false); w = __builtin_amdgcn_cvt_pk_fp8_f32(c, d, w, true); return (unsigned)w; }
__device__ __forceinline__ float sat_fp8(float x) { return __builtin_amdgcn_fmed3f(x, -448.0f, 448.0f); }
__device__ __forceinline__ unsigned cvt4_fp8(float a, float b, float c, float d) { return cvt4_fp8_raw(a, b, c, d); }
__device__ __forceinline__ unsigned cvt4_fp8_sat(float a, float b, float c, float d) { return cvt4_fp8_raw(sat_fp8(a), sat_fp8(b), sat_fp8(c), sat_fp8(d)); }
constexpr float FP8_WSCALE = 64.0f, FP8_ASCALE = 4.0f, FP8_OSCALE = 1.0f / 256.0f, FP8_YSCALE = 8.0f;
__device__ __forceinline__ bf16_t f2bf(float f) { return (bf16_t)(cvt_pk_bf16(f, 0.f) & 0xffffu); }
__device__ __forceinline__ float bf2f(bf16_t b) { return __uint_as_float(((unsigned)b) << 16); }
__device__ __forceinline__ float bflo(unsigned w) { return __uint_as_float(w << 16); }
__device__ __forceinline__ float bfhi(unsigned w) { return __uint_as_float(w & 0xffff0000u); }
__device__ __forceinline__ float bperm(float v, int srclane) { return __int_as_float(__builtin_amdgcn_ds_bpermute(srclane << 2, __float_as_int(v))); }
__device__ __forceinline__ float wave_sum(float v, int lane) {
#pragma unroll
    for (int o = 32; o >= 1; o >>= 1) v += bperm(v, lane ^ o);
    return v;
}
__device__ __forceinline__ int lane_id() { return (int)__builtin_amdgcn_mbcnt_hi(~0u, __builtin_amdgcn_mbcnt_lo(~0u, 0u)); }
__device__ __forceinline__ int make_tid(int wv) { int l; asm volatile("v_mbcnt_lo_u32_b32 %0, -1, 0\n\tv_mbcnt_hi_u32_b32 %0, -1, %0" : "=v"(l)); return wv * 64 + l; }
__device__ __forceinline__ float sigmoidf_(float x) { return __builtin_amdgcn_rcpf(1.0f + __builtin_amdgcn_exp2f(x * -1.4426950408889634f)); }
__device__ __forceinline__ s16x4 tr_read(unsigned lds_addr) { s16x4 r; asm volatile("ds_read_b64_tr_b16 %0, %1\n\ts_waitcnt lgkmcnt(0)" : "=&v"(r) : "v"(lds_addr) : "memory"); return r; }

#define XB_TMO      128
#define XB_XCNT(j)  (256  + 64 * (j))
#define XB_XSUB(j)  (1280 + 64 * (j))
#define XB_XGEN(j)  (2304 + 64 * (j))
#define XB_TOP      3328
#define XB_TOPGEN   3392
#define XCD_BAR_WORDS 3456
#define XB_SPIN_CAP (1u << 18)

__device__ __forceinline__ unsigned xb_ld(unsigned* p)              { return __hip_atomic_load(p, __ATOMIC_RELAXED, __HIP_MEMORY_SCOPE_AGENT); }
__device__ __forceinline__ unsigned xb_add(unsigned* p, unsigned v) { return __hip_atomic_fetch_add(p, v, __ATOMIC_RELAXED, __HIP_MEMORY_SCOPE_AGENT); }
__device__ __forceinline__ unsigned xb_xcc_id() { return (unsigned)__builtin_amdgcn_s_getreg((3 << 11) | 20) & 0xFu; }
#define XB_SPIN(cond, bar) do { unsigned _sp = 0; while (cond) { __builtin_amdgcn_s_sleep(1); \
    if ((++_sp & 255u) == 0u) { if (xb_ld(&(bar)[XB_TMO])) break; if (_sp > XB_SPIN_CAP) { atomicAdd(&(bar)[XB_TMO], 1u); break; } } } } while (0)

struct XcdBarrier { unsigned* bar; unsigned x; volatile LAS unsigned* st; };

__device__ __forceinline__ XcdBarrier xcd_barrier_post(unsigned* bar, volatile LAS unsigned* st, bool t0) {
    XcdBarrier b; b.bar = bar; b.x = xb_xcc_id(); b.st = st;
    if (t0) (void)xb_add(&bar[XB_XCNT(b.x)], 1u);
    return b;
}
__device__ __forceinline__ void xcd_barrier_complete(unsigned* bar, unsigned x, unsigned& nloc, unsigned& nx) {
    const unsigned G = gridDim.x * gridDim.y * gridDim.z;
    unsigned sum, cnt, mine, sp = 0u;
    for (;;) {
        sum = 0u; cnt = 0u; mine = 0u;
#pragma unroll
        for (unsigned j = 0; j < 16; ++j) { const unsigned c = xb_ld(&bar[XB_XCNT(j)]); sum += c; cnt += (c > 0u) ? 1u : 0u; mine = (j == x) ? c : mine; }
        if (sum == G) break;
        __builtin_amdgcn_s_sleep(1);
        if ((++sp & 255u) == 0u) { if (xb_ld(&bar[XB_TMO])) break; if (sp > XB_SPIN_CAP) { atomicAdd(&bar[XB_TMO], 1u); break; } }
    }
    nloc = mine > 0u ? mine : 1u; nx = cnt > 0u ? cnt : 1u;
}
__device__ __forceinline__ void xcd_barrier(const XcdBarrier& b, int wv) {
    asm volatile("s_waitcnt vmcnt(0)" ::: "memory");
    __syncthreads();
    if (wv == 0 && lane_id() == 0) {
        unsigned* bar = b.bar;
        __builtin_amdgcn_s_waitcnt(0);
        unsigned nloc = b.st[0], nx = b.st[1];
        if (nloc == 0u) { xcd_barrier_complete(bar, b.x, nloc, nx); b.st[0] = nloc; b.st[1] = nx; }
        const unsigned old = xb_add(&bar[XB_XSUB(b.x)], 1u);
        const unsigned gen = old / nloc;
        if (old + 1u == (gen + 1u) * nloc) {
            __builtin_amdgcn_fence(__ATOMIC_RELEASE, "agent");
            asm volatile("s_waitcnt vmcnt(0)" ::: "memory");
            const unsigned og = xb_add(&bar[XB_TOP], 1u);
            const unsigned tg = og / nx;
            if (og + 1u == (tg + 1u) * nx) xb_add(&bar[XB_TOPGEN], 1u);
            else XB_SPIN(xb_ld(&bar[XB_TOPGEN]) == tg, bar);
            __builtin_amdgcn_fence(__ATOMIC_ACQUIRE, "agent");
            xb_add(&bar[XB_XGEN(b.x)], 1u);
            asm volatile("s_waitcnt vmcnt(0)" ::: "memory");
        } else {
            XB_SPIN(xb_ld(&bar[XB_XGEN(b.x)]) == gen, bar);
            __builtin_amdgcn_fence(__ATOMIC_ACQUIRE, "agent");
            asm volatile("s_waitcnt vmcnt(0)" ::: "memory");
        }
    }
    __syncthreads();
}
#define DEV_STAGE 9
#define DBL -1
#define PROBE_GEMM 0
#define PROBE_A 0
#define PROBE_B 1
#define F8SWZ_OFF 0
#define INPROJ_FP8 1
#define STEAL 1
__device__ __forceinline__ void conv_supertile(const float* __restrict__ src, int ld_src, int srccol, int k0, bf16_t* __restrict__ dst, int K, LAS unsigned* buf, int t) {
    const int c4 = t & 63, kq = t >> 6;
    f32x4 a[4], b[4];
#pragma unroll
    for (int i = 0; i < 4; ++i) { const int kp = kq + 8 * i; const float* r = src + (size_t)(k0 + 2 * kp) * ld_src + srccol; a[i] = *(const f32x4*)r; b[i] = *(const f32x4*)(r + ld_src); }
#pragma unroll
    for (int i = 0; i < 4; ++i) { const int kp = kq + 8 * i;
#pragma unroll
        for (int j = 0; j < 4; ++j) buf[(4 * c4 + j) * 33 + kp] = cvt_pk_bf16(a[i][j], b[i][j]); }
    __syncthreads();
    const int n = t >> 1, hf = t & 1;
    bf16_t* d = dst + (size_t)n * K + k0 + 32 * hf;
#pragma unroll
    for (int q = 0; q < 4; ++q) { u32x4 o;
#pragma unroll
        for (int e = 0; e < 4; ++e) o[e] = buf[n * 33 + 16 * hf + 4 * q + e];
        *(u32x4*)(d + 8 * q) = o; }
    __syncthreads();
}

__device__ __forceinline__ void p0_gemv_item(const Params& p, int id, LAS unsigned char* lds, int t) {
    const int cb = id % 48, ks = id / 48;
    LAS float* sv = (LAS float*)lds;
    LAS float* red = sv + 9 * 256;
    for (int i = t; i < 9 * 256; i += NTHR) { const int r = i >> 8, kk = i & 255; if (kk < 128) { const float cv = (r < 8) ? p.c[r * 2048 + ks * 128 + kk] : p.c_ctx[ks * 128 + kk]; sv[i] = cv / (1.0f + __expf(-cv)); } }
    __syncthreads();
    const int col4 = t & 63, w = t >> 6;
    f32x4 acc[9];
#pragma unroll
    for (int r = 0; r < 9; ++r) acc[r] = (f32x4){0.f, 0.f, 0.f, 0.f};
    const float* wp = p.w_ada + (size_t)(ks * 128 + w) * 12288 + cb * 256 + col4 * 4;
#pragma unroll 8
    for (int i = 0; i < 16; ++i) { const f32x4 wv = *(const f32x4*)(wp + (size_t)i * 8 * 12288); const int kk = w + 8 * i;
#pragma unroll
        for (int r = 0; r < 9; ++r) acc[r] += sv[r * 256 + kk] * wv; }
#pragma unroll
    for (int r = 0; r < 9; ++r) *(LAS f32x4*)(red + (w * 9 + r) * 256 + col4 * 4) = acc[r];
    __syncthreads();
    float* modp = (float*)(p.ws + WS_MODP);
    for (int i = t; i < 9 * 256; i += NTHR) { const int r = i >> 8, col = i & 255; float s = 0.f;
#pragma unroll
        for (int ww = 0; ww < 8; ++ww) s += red[(ww * 9 + r) * 256 + col];
        modp[(size_t)(ks * 9 + r) * 12288 + cb * 256 + col] = s; }
    __syncthreads();
}

template <int CUT = 0> __device__ __forceinline__ void p0_s5_item(const Params& p, int g, LAS unsigned char* lds, int t) {
    constexpr int CCS = 34, KTS = 272;
    LAS float* LBP = (LAS float*)lds;
    LAS float* BBr = LBP + 2 * 17 * 64 * 2;
    LAS float* BBi = BBr + 2 * 64 * 16;
    LAS float* CC = BBi + 2 * 64 * 16;
    LAS float* KT = CC + 2 * 64 * CCS;
    if (t < 128) {
        const int d = t >> 6, pp = t & 63, gi = (d * 64 + g) * 64 + pp;
        const float lre = fminf(p.lam_re[gi], -1e-4f), lim = p.lam_im[gi], dt = __expf(p.log_dt[d * 64 + g]);
        const float mag = expf(lre * dt), ang = lim * dt;
        float sn, cs; sincosf(ang, &sn, &cs);
        const float lbr = mag * cs, lbi = mag * sn;
        const float den = lre * lre + lim * lim, nr = lbr - 1.0f;
        const float cre = (nr * lre + lbi * lim) / den, cim = (lbi * lre - nr * lim) / den;
        float pr = 1.f, pi = 0.f;
        for (int tau = 0; tau <= 16; ++tau) { LBP[((d * 17 + tau) * 64 + pp) * 2] = pr; LBP[((d * 17 + tau) * 64 + pp) * 2 + 1] = pi; const float nr2 = pr * lbr - pi * lbi, ni2 = pr * lbi + pi * lbr; pr = nr2; pi = ni2; }
        float* lb16 = (float*)(p.ws + WS_LB16);
        lb16[gi * 2] = LBP[((d * 17 + 16) * 64 + pp) * 2]; lb16[gi * 2 + 1] = LBP[((d * 17 + 16) * 64 + pp) * 2 + 1];
        for (int h = 0; h < 16; ++h) { const float br = p.b_re[(size_t)gi * 16 + h], bi = p.b_im[(size_t)gi * 16 + h];
            BBr[(d * 64 + pp) * 16 + h] = cre * br - cim * bi; BBi[(d * 64 + pp) * 16 + h] = cre * bi + cim * br; }
    }
    for (int i = t; i < 2 * 16 * 64; i += NTHR) { const int d = i >> 10, h = (i >> 6) & 15, pp = i & 63; const size_t gi = ((size_t)(d * 64 + g) * 16 + h) * 64 + pp;
        CC[(d * 64 + pp) * CCS + h * 2] = p.c_re[gi]; CC[(d * 64 + pp) * CCS + h * 2 + 1] = p.c_im[gi]; }
    __syncthreads();
    if (CUT == 1) return;
    { const int d = t >> 8, tau = (t >> 4) & 15, h = t & 15; f32x4 a4[4];
#pragma unroll
      for (int q = 0; q < 4; ++q) a4[q] = (f32x4){0.f, 0.f, 0.f, 0.f};
#pragma unroll 2
      for (int pp = 0; pp < 64; ++pp) { const float cr = CC[(d * 64 + pp) * CCS + h * 2], ci = CC[(d * 64 + pp) * CCS + h * 2 + 1];
          const float lr = LBP[((d * 17 + tau) * 64 + pp) * 2], li = LBP[((d * 17 + tau) * 64 + pp) * 2 + 1];
          const float wr = cr * lr - ci * li, nwi = -(cr * li + ci * lr);
          LAS const f32x4* br = (LAS const f32x4*)(BBr + (d * 64 + pp) * 16); LAS const f32x4* bi = (LAS const f32x4*)(BBi + (d * 64 + pp) * 16);
#pragma unroll
          for (int q = 0; q < 4; ++q) { a4[q] += br[q] * wr; a4[q] += bi[q] * nwi; } }
#pragma unroll
      for (int q = 0; q < 4; ++q) *(LAS f32x4*)(KT + (d * 16 + tau) * KTS + h * 16 + q * 4) = a4[q]; }
    __syncthreads();
    if (CUT == 2) return;
    unsigned* bty = (unsigned*)(p.ws + WS_BTY) + (size_t)g * 256 * 256;
    for (int i = t; i < 256 * 64; i += NTHR) { const int n = i >> 6, k8 = (i & 63) * 8, tt = n >> 4, h = n & 15; float v[8];
        if (k8 < 256) { const int s = k8 >> 4, h2 = k8 & 15; f32x4 a0 = (f32x4){0.f, 0.f, 0.f, 0.f}, a1 = a0;
            if (s <= tt) { LAS const float* kt = KT + (0 * 16 + (tt - s)) * KTS + h * 16 + h2; a0 += *(LAS const f32x4*)kt; a1 += *(LAS const f32x4*)(kt + 4); }
            if (s >= tt) { LAS const float* kt = KT + (1 * 16 + (s - tt)) * KTS + h * 16 + h2; a0 += *(LAS const f32x4*)kt; a1 += *(LAS const f32x4*)(kt + 4); }
            v[0] = a0[0]; v[1] = a0[1]; v[2] = a0[2]; v[3] = a0[3]; v[4] = a1[0]; v[5] = a1[1]; v[6] = a1[2]; v[7] = a1[3];
        } else { const int kk = k8 - 256, d = kk >> 7, reim = (kk >> 6) & 1, pp0 = kk & 63, pw = d == 0 ? tt + 1 : 16 - tt;
#pragma unroll
            for (int e = 0; e < 8; ++e) { const int pp = pp0 + e;
                const float cr = CC[(d * 64 + pp) * CCS + h * 2], ci = CC[(d * 64 + pp) * CCS + h * 2 + 1];
                const float lr = LBP[((d * 17 + pw) * 64 + pp) * 2], li = LBP[((d * 17 + pw) * 64 + pp) * 2 + 1];
                v[e] = reim == 0 ? (cr * lr - ci * li) : -(cr * li + ci * lr); } }
        u32x4 o; o.x = cvt_pk_bf16(v[0], v[1]); o.y = cvt_pk_bf16(v[2], v[3]); o.z = cvt_pk_bf16(v[4], v[5]); o.w = cvt_pk_bf16(v[6], v[7]);
        *(u32x4*)(bty + n * 256 + (k8 >> 1)) = o; }
    if (CUT == 3) { __syncthreads(); return; }
    unsigned* btv = (unsigned*)(p.ws + WS_BTV) + (size_t)g * 256 * 128;
    for (int i = t; i < 256 * 32; i += NTHR) { const int n = i >> 5, k8 = (i & 31) * 8, d = n >> 7, reim = (n >> 6) & 1, pp = n & 63, s = k8 >> 4, h2 = k8 & 15, pw = d == 0 ? 15 - s : s;
        const float lr = LBP[((d * 17 + pw) * 64 + pp) * 2], li = LBP[((d * 17 + pw) * 64 + pp) * 2 + 1];
        LAS const float* br = BBr + (d * 64 + pp) * 16 + h2; LAS const float* bi = BBi + (d * 64 + pp) * 16 + h2; float v[8];
#pragma unroll
        for (int e = 0; e < 8; ++e) v[e] = reim == 0 ? (lr * br[e] - li * bi[e]) : (lr * bi[e] + li * br[e]);
        u32x4 o; o.x = cvt_pk_bf16(v[0], v[1]); o.y = cvt_pk_bf16(v[2], v[3]); o.z = cvt_pk_bf16(v[4], v[5]); o.w = cvt_pk_bf16(v[6], v[7]);
        *(u32x4*)(btv + n * 128 + (k8 >> 1)) = o; }
    __syncthreads();
}

#ifndef INPROJ_FP8
#define INPROJ_FP8 1
#endif
constexpr int F8_TILES = 16384 + 8192, F8_PER_WG = F8_TILES / NWG  , F8_MLSTM = 36  , F8_P0 = F8_PER_WG - F8_MLSTM;
constexpr int G_INPROJ = 144;
struct TileF8 { const float* src; unsigned char* dst; int ld_src; };
__device__ __forceinline__ TileF8 p0_f8_tile(const Params& p, int j) {
    TileF8 T;
    if (j < 16384) { const int nb = j & 31, kb = (j >> 5) & 15, e = j >> 9, pnb = nb >> 1, hf = nb & 1;
        T.src = p.w_gu + (size_t)e * 2048 * 4096 + (size_t)(kb * 128) * 4096 + hf * 2048 + pnb * 128; T.ld_src = 4096;
        T.dst = p.ws + WS_WGU_T + ((size_t)e * 4096 + pnb * 256 + hf * 128) * 2048 + kb * 128; }
    else if (j >= F8_TILES + 256) { const int jj = j - F8_TILES - 256, nb = jj & 31, kb = jj >> 5, n0 = nb * 128;
        T.src = p.w_in + (size_t)(kb * 128) * DIN + (n0 < 3072 ? n0 : n0 + 16); T.ld_src = DIN;
        T.dst = p.ws + WS_WIN_T + (size_t)n0 * 2048 + kb * 128; }
    else if (j >= F8_TILES) { const int jj = j - F8_TILES, nb = jj & 15, kb = jj >> 4;
        T.src = p.w_out + (size_t)(kb * 128) * 2048 + nb * 128; T.ld_src = 2048;
        T.dst = p.ws + WS_WOUT_T + (size_t)(nb * 128) * 2048 + kb * 128; }
    else { const int jj = j - 16384, nb = jj & 15, kb = (jj >> 4) & 15, e = jj >> 8;
        T.src = p.w_down + (size_t)e * 2048 * 2048 + (size_t)(kb * 128) * 2048 + nb * 128; T.ld_src = 2048;
        T.dst = p.ws + WS_WDN_T + ((size_t)e * 2048 + nb * 128) * 2048 + kb * 128; }
    return T;
}
#define P0F8_LOAD(R, T) do { const float* _s = (T).src + (size_t)(kq * 8) * (T).ld_src + c4 * 4; _Pragma("unroll") for (int i = 0; i < 8; ++i) R[i] = *(const f32x4*)(_s + (size_t)i * (T).ld_src); } while (0)
__device__ __forceinline__ void p0_f8_to_lds(const f32x4 (&r)[8], LAS unsigned* buf, int t) {
    const int c4 = t & 31, kq = t >> 5;
#pragma unroll
    for (int j = 0; j < 4; ++j) { u32x2 w; w.x = cvt4_fp8(r[0][j] * FP8_WSCALE, r[1][j] * FP8_WSCALE, r[2][j] * FP8_WSCALE, r[3][j] * FP8_WSCALE); w.y = cvt4_fp8(r[4][j] * FP8_WSCALE, r[5][j] * FP8_WSCALE, r[6][j] * FP8_WSCALE, r[7][j] * FP8_WSCALE);
        *(LAS u32x2*)(buf + (4 * c4 + j) * 34 + 2 * kq) = w; }
}
__device__ __forceinline__ void p0_f8_store(unsigned char* dst, LAS const unsigned* buf, int t) {
    const int n = t >> 2, q = t & 3; u32x2 o[4];
#pragma unroll
    for (int e = 0; e < 4; ++e) o[e] = *(const LAS u32x2*)(buf + n * 34 + 8 * q + 2 * e);
    unsigned char* d = dst + (size_t)n * 2048 + 32 * q;
    *(u32x4*)d = (u32x4){o[0].x, o[0].y, o[1].x, o[1].y}; *(u32x4*)(d + 16) = (u32x4){o[2].x, o[2].y, o[3].x, o[3].y};
}
__device__ __forceinline__ void p0_f8_process(const f32x4 (&r)[8], unsigned char* dst, LAS unsigned* buf, int t) { p0_f8_to_lds(r, buf, t); __syncthreads(); p0_f8_store(dst, buf, t); __syncthreads(); }
__device__ __forceinline__ void p0_f8_range(const Params& p, LAS unsigned* buf, int t, int first, int stride, int count) {
    const int c4 = t & 31, kq = t >> 5;
    f32x4 ra[8], rb[8], rc[8];
    TileF8 Ta = p0_f8_tile(p, first), Tb = p0_f8_tile(p, first + stride), Tc = Ta;
    P0F8_LOAD(ra, Ta); if (count > 1) P0F8_LOAD(rb, Tb);
    for (int i = 0; i < count; i += 3) {
        if (i + 2 < count) { Tc = p0_f8_tile(p, first + stride * (i + 2)); P0F8_LOAD(rc, Tc); }
        p0_f8_process(ra, Ta.dst, buf, t);
        if (i + 3 < count) { Ta = p0_f8_tile(p, first + stride * (i + 3)); P0F8_LOAD(ra, Ta); }
        if (i + 1 < count) p0_f8_process(rb, Tb.dst, buf, t);
        if (i + 4 < count) { Tb = p0_f8_tile(p, first + stride * (i + 4)); P0F8_LOAD(rb, Tb); }
        if (i + 2 < count) p0_f8_process(rc, Tc.dst, buf, t);
    }
}

constexpr size_t CTRL_STEAL = 49152;
__device__ __forceinline__ void p0_f8_steal(const Params& p, LAS unsigned* buf, LAS unsigned* slot, int t, int total) {
    const int c4 = t & 31, kq = t >> 5;
    unsigned* counter = (unsigned*)(p.ws + WS_CTRL + CTRL_STEAL);
    unsigned pend = 0;
    if (t == 0) { const unsigned b0 = atomicAdd(counter, 3u); const unsigned b1 = atomicAdd(counter, 3u); slot[0] = b0; slot[1] = b1; }
    __syncthreads();
    int base = __builtin_amdgcn_readfirstlane((int)slot[0]);
    if (base >= total) return;
    f32x4 ra[8], rb[8], rc[8];
    TileF8 Ta = p0_f8_tile(p, base), Tb = p0_f8_tile(p, base + 1), Tc = Ta;
    P0F8_LOAD(ra, Ta); P0F8_LOAD(rb, Tb);
    for (int i = 0;; ++i) {
        if (t == 0) pend = atomicAdd(counter, 3u);
        Tc = p0_f8_tile(p, base + 2); P0F8_LOAD(rc, Tc);
        p0_f8_process(ra, Ta.dst, buf, t);
        const int nb = __builtin_amdgcn_readfirstlane((int)slot[(i + 1) & 1]);
        if (nb < total) { Ta = p0_f8_tile(p, nb); P0F8_LOAD(ra, Ta); }
        p0_f8_process(rb, Tb.dst, buf, t);
        if (nb < total) { Tb = p0_f8_tile(p, nb + 1); P0F8_LOAD(rb, Tb); }
        if (t == 0) slot[i & 1] = pend;
        p0_f8_process(rc, Tc.dst, buf, t);
        if (nb >= total) break;
        base = nb;
    }
}

constexpr int P0_GEMV = 48 * MODKS, P0_S5 = 64, P0_RT = 1;
constexpr int P0_SPECIAL = P0_GEMV + P0_S5 + P0_RT;
constexpr int P0_WIN = 16 * 32, P0_WGLU = 4 * 16, P0_WOUT = 8 * 32, P0_WGU = 32 * 16 * 32, P0_WDN = 32 * 8 * 32;
constexpr int P0_TOTAL = P0_SPECIAL + P0_WGLU + (INPROJ_FP8 ? 0 : P0_WIN);

static_assert(INPROJ_FP8 == 1 && P0_GEMV == 4 * (NWG - P0_S5), "phase0 assignment");
template <int MASK = 7> __device__ __forceinline__ void phase0(const Params& p, LAS unsigned char* lds, int wv) {
    const int t = make_tid(wv), c = blockIdx.x;
    LAS unsigned* buf = (LAS unsigned*)lds;
    if (c < P0_S5) { if (MASK & 2) p0_s5_item<(MASK >> 4)>(p, c, lds, t); }
    else {
        if (MASK & 1) for (int i = 0; i < 4; ++i) p0_gemv_item(p, (c - P0_S5) + (NWG - P0_S5) * i, lds, t);
        if ((MASK & 2) && c >= NWG - P0_WGLU) { const int j = c - (NWG - P0_WGLU), nb = j & 3, kb = j >> 2, c4 = t & 63;
            conv_supertile(p.w_glu, 1024, nb * 256 + 4 * c4, kb * 64, (bf16_t*)(p.ws + WS_WGLU_T) + (size_t)nb * 256 * 1024, 1024, buf, t); }
    }
    if ((MASK & 2) && t < 256) {
        bf16_t* wrt = (bf16_t*)(p.ws + WS_WRT);
        const int i = c * 256 + t, k = i >> 5, e = i & 31; const float w = p.w_router[i]; const bf16_t hi = f2bf(w); const bf16_t lo = f2bf(w - bf2f(hi));
        wrt[e * 2048 + k] = hi; wrt[(32 + e) * 2048 + k] = lo; }
    if (!(MASK & 4)) return;
    p0_f8_range(p, buf, t, F8_TILES + blockIdx.x, NWG, 1);
    if (INPROJ_FP8) p0_f8_range(p, buf, t, F8_TILES + 256 + blockIdx.x, NWG, 2);
}

__device__ __forceinline__ void p1_load_vecs(const Params& p, int modrow, LAS float* scv, LAS float* shv, int t) {
    const float* modp = (const float*)(p.ws + WS_MODP) + (size_t)modrow * 12288 + t * 4;
    f32x4 sh = *(const f32x4*)(p.b_ada + t * 4), sc = *(const f32x4*)(p.b_ada + 2048 + t * 4) + 1.0f;
#pragma unroll
    for (int ks = 0; ks < MODKS; ++ks) { sh += *(const f32x4*)(modp + (size_t)ks * 9 * 12288); sc += *(const f32x4*)(modp + (size_t)ks * 9 * 12288 + 2048); }
    *(LAS f32x4*)(scv + t * 4) = sc * *(const f32x4*)(p.norm1_g + t * 4); *(LAS f32x4*)(shv + t * 4) = sh;
}
__device__ __forceinline__ void p1_load(const float* __restrict__ xrow, int lane, f32x4 (&v)[8]) {
#pragma unroll
    for (int i = 0; i < 8; ++i) v[i] = *(const f32x4*)(xrow + (i * 64 + lane) * 4);
}
__device__ __forceinline__ void p1_row(const Params& p, const f32x4 (&v)[8], int urow, LAS const unsigned char* wgl, LAS const float* scv, LAS const float* shv, int lane) {
    float ss = 0.f;
#pragma unroll
    for (int i = 0; i < 8; ++i) ss += v[i][0] * v[i][0] + v[i][1] * v[i][1] + v[i][2] * v[i][2] + v[i][3] * v[i][3];
    ss = wave_sum(ss, lane);
    const float rstd = rsqrtf(ss * (1.0f / 2048.0f) + 1e-6f);
    float acc[16];
#pragma unroll
    for (int j = 0; j < 16; ++j) acc[j] = 0.f;
#if INPROJ_FP8
    unsigned char* urow_p = p.ws + WS_U1 + (size_t)urow * 2048;
#else
    bf16_t* urow_p = (bf16_t*)(p.ws + WS_U1) + (size_t)urow * 2048;
#endif
#pragma unroll
    for (int i = 0; i < 8; ++i) { const int m = i * 64 + lane;
        const f32x4 sc = *(LAS const f32x4*)(scv + m * 4), sh = *(LAS const f32x4*)(shv + m * 4);
        const f32x4 u = v[i] * rstd * sc + sh;
#if INPROJ_FP8
        *(unsigned*)(urow_p + m * 4) = cvt4_fp8_sat(u[0] * FP8_ASCALE, u[1] * FP8_ASCALE, u[2] * FP8_ASCALE, u[3] * FP8_ASCALE);
#else
        { u32x2 w; w.x = cvt_pk_bf16(u[0], u[1]); w.y = cvt_pk_bf16(u[2], u[3]); *(u32x2*)(urow_p + m * 4) = w; }
#endif
        asm volatile("" ::: "memory");
#pragma unroll
        for (int j = 0; j < 4; ++j) {
#pragma unroll
            for (int q = 0; q < 4; ++q) { const f32x4 wv = *(LAS const f32x4*)(wgl + m * 272 + j * 64 + q * 16);
                acc[q * 4 + 0] += u[j] * wv[0]; acc[q * 4 + 1] += u[j] * wv[1]; acc[q * 4 + 2] += u[j] * wv[2]; acc[q * 4 + 3] += u[j] * wv[3]; } }
    }
    float r8[8], r4[4], r2[2], r1;
    { const bool up = (lane & 32) != 0;
#pragma unroll
      for (int j = 0; j < 8; ++j) { const float keep = up ? acc[j + 8] : acc[j], send = up ? acc[j] : acc[j + 8]; r8[j] = keep + bperm(send, lane ^ 32); } }
    { const bool up = (lane & 16) != 0;
#pragma unroll
      for (int j = 0; j < 4; ++j) { const float keep = up ? r8[j + 4] : r8[j], send = up ? r8[j] : r8[j + 4]; r4[j] = keep + bperm(send, lane ^ 16); } }
    { const bool up = (lane & 8) != 0;
#pragma unroll
      for (int j = 0; j < 2; ++j) { const float keep = up ? r4[j + 2] : r4[j], send = up ? r4[j] : r4[j + 2]; r2[j] = keep + bperm(send, lane ^ 8); } }
    { const bool up = (lane & 4) != 0; const float keep = up ? r2[1] : r2[0], send = up ? r2[0] : r2[1]; r1 = keep + bperm(send, lane ^ 4); }
    r1 += bperm(r1, lane ^ 2); r1 += bperm(r1, lane ^ 1);
    if ((lane & 3) == 0) { const int gi = ((lane >> 5) & 1) * 8 + ((lane >> 4) & 1) * 4 + ((lane >> 3) & 1) * 2 + ((lane >> 2) & 1);
        float gv = 15.0f * tanhf((r1 + p.gate_bias[gi]) * (1.0f / 15.0f));
        if ((gi >> 2) & 1) gv = fminf(gv, 0.f) - log1pf(__expf(-fabsf(gv)));
        ((float*)(p.ws + WS_GATES))[(size_t)urow * 16 + gi] = gv; }
}
__device__ __forceinline__ void phase1(const Params& p, LAS unsigned char* lds, int wv) {
    const int t = make_tid(wv);
    const int lane = t & 63, wid = t >> 6, wg = blockIdx.x;
    { const float* modp = (const float*)(p.ws + WS_MODP); float* mod = (float*)(p.ws + WS_MOD);
      for (int i = wg * NTHR + t; i < 9 * 12288; i += NWG * NTHR) { const int r = i / 12288, j = i - r * 12288; float s = p.b_ada[j];
#pragma unroll
          for (int ks = 0; ks < MODKS; ++ks) s += modp[(size_t)(ks * 9 + r) * 12288 + j];
          mod[i] = s; } }
    LAS unsigned char* wgl = lds;
    LAS float* scv = (LAS float*)(lds + 139264);
    LAS float* shv = scv + 2048;
    { f32x4 wl[16];
#pragma unroll
      for (int j = 0; j < 16; ++j) { const int i = t + NTHR * j, k = i >> 2, q = i & 3; wl[j] = *(const f32x4*)(p.w_in + (size_t)k * DIN + 3072 + q * 4); }
#pragma unroll
      for (int j = 0; j < 16; ++j) { const int i = t + NTHR * j, k = i >> 2, q = i & 3; *(LAS f32x4*)(wgl + (k >> 2) * 272 + (k & 3) * 64 + q * 16) = wl[j]; } }
    const int b = wg >> 5;
    p1_load_vecs(p, b, scv, shv, t);
    __syncthreads();
    { f32x4 va[8], vb[8]; p1_load(p.x + (size_t)(wg * 64 + wid) * 2048, lane, va);
#pragma unroll 1
      for (int r = wid; r < 64; r += 16) { const int row = wg * 64 + r;
          p1_load(p.x + (size_t)(row + 8) * 2048, lane, vb);
          p1_row(p, va, row, wgl, scv, shv, lane);
          if (r + 16 < 64) p1_load(p.x + (size_t)(row + 16) * 2048, lane, va);
          p1_row(p, vb, row + 8, wgl, scv, shv, lane); } }
    __syncthreads();
    p1_load_vecs(p, 8, scv, shv, t);
    __syncthreads();
    { const int row = wg * 8 + wid; f32x4 va[8]; p1_load(p.ctx + (size_t)row * 2048, lane, va); p1_row(p, va, NLAT + row, wgl, scv, shv, lane); }
    __syncthreads();
}
namespace pg8 {
constexpr int BM = 256, BK = 64, HALF = 128, HTB = HALF * BK * 2, STAGE_BYTES = 8 * HTB, NXCD = 8;
__host__ __device__ __forceinline__ int lds_byte(int r, int c) { const int st = (r >> 4) * 2 + (c >> 5), rr = r & 15, cc = c & 31, ob = rr * 64 + cc * 2; return st * 1024 + (ob ^ (((ob >> 9) & 1) << 5)); }
__host__ __device__ __forceinline__ void stage_rc(int b, int& R, int& C) { const int st = b / 1024, sb = b % 1024, swz = sb ^ (((sb >> 9) & 1) << 5); R = (st >> 1) * 16 + swz / 64; C = (st & 1) * 32 + (swz % 64) / 2; }
__host__ __device__ __forceinline__ int perm32(int rho) { const int n = rho >> 4, i = rho & 15; return 8 * (i >> 2) + 4 * n + (i & 3); }
#ifndef F8SWZ_OFF
#define F8SWZ_OFF 0
#endif
__host__ __device__ __forceinline__ int f8swz(int r) { if (F8SWZ_OFF) return 0; const int q = (r >> 1) & 7; return q ^ ((((q + 2) >> 2) & 1) << 1); }
__host__ __device__ __forceinline__ int lds_byte8(int r, int s) { return (r >> 4) * 2048 + (r & 15) * 128 + 16 * (s ^ f8swz(r & 15)); }
__host__ __device__ __forceinline__ void stage_rc8(int b, int& R, int& C) { const int blk = b >> 11, p = b & 2047, rr = p >> 7; R = blk * 16 + rr; C = 8 * (((p >> 4) & 7) ^ f8swz(rr)); }
struct Unit { int pm, pn, g, rb, cn, ui; };
__device__ __forceinline__ int xcd_chunk(int L, int nwg) { const int q = nwg / NXCD, r = nwg % NXCD, xcd = L % NXCD, off = L / NXCD; return (xcd < r ? xcd * (q + 1) : r * (q + 1) + (xcd - r) * q) + off; }

__device__ __forceinline__ const char* uni_ptr(const char* p) { const unsigned lo = __builtin_amdgcn_readfirstlane((unsigned)(size_t)p), hi = __builtin_amdgcn_readfirstlane((unsigned)((size_t)p >> 32)); return (const char*)(((size_t)hi << 32) | lo); }
typedef int i32x8 __attribute__((ext_vector_type(8)));
typedef int i32x4 __attribute__((ext_vector_type(4)));
#ifndef PROBE_GEMM
#define PROBE_GEMM 0
#endif
template <class Epi, class Sched, int K, int LDA, bool GATHER, bool FP8 = false, int PRB = 0, bool ALIGN_EPI = true, bool ABLK = false>
__device__ __forceinline__ void gemm_phase(LAS unsigned char* lds, const Sched& S, const Epi& E, int wv, float* diag = nullptr) {
    unsigned long long pk = 0, pe = 0, pt = 0;
    const int tid = make_tid(wv);
    const int wid = wv, lane = tid & 63, wr = wid >> 2, wc = wid & 3, fr = lane & 15, fq = lane >> 4;
    constexpr int nt = K / BK;
    int R0, C0, R1, C1;
    if constexpr (FP8) { stage_rc8(tid * 16, R0, C0); stage_rc8(tid * 16 + 8192, R1, C1); } else { stage_rc(tid * 16, R0, C0); stage_rc(tid * 16 + 8192, R1, C1); }
    unsigned voffB[2];
    { const int Rb0 = Epi::PERM ? ((R0 & ~31) + perm32(R0 & 31)) : R0, Rb1 = Epi::PERM ? ((R1 & ~31) + perm32(R1 & 31)) : R1;
      voffB[0] = (unsigned)(Rb0 * K + C0) * 2u; voffB[1] = (unsigned)(Rb1 * K + C1) * 2u; }
    unsigned offC[2][2];
    constexpr size_t kstep = (size_t)(BK * 2);
    constexpr size_t ABLK_GSTR = (size_t)16384 * 32;
    constexpr size_t kstepA = ABLK ? 4 * ABLK_GSTR : kstep;
    constexpr size_t hstepB = (size_t)HALF * K * 2;
    constexpr size_t hstepA = GATHER ? 0 : (ABLK ? (size_t)HALF * 32 : (size_t)HALF * LDA * 2);
    const unsigned ldsb = (unsigned)(size_t)lds + (unsigned)wid * 1024u;
    const int aoff = FP8 ? lds_byte8(wr * 64 + fr, 2 * fq) : lds_byte(wr * 64 + fr, fq * 8), boff = FP8 ? lds_byte8(wc * 32 + fr, 2 * fq) : lds_byte(wc * 32 + fr, fq * 8);
    const int aoffx = aoff ^ 16, boffx = boff ^ 16;
#define PG8_SA(b, h) (((b) * 2 + (h)) * HTB)
#define PG8_SB(b, h) ((4 + (b) * 2 + (h)) * HTB)
#define PG8_STAGE(bufoff, gbase, voff) do { _Pragma("unroll") for (int _i = 0; _i < 2; ++_i) { unsigned _keep; \
        asm volatile("s_mov_b32 %0, m0\n\ts_mov_b32 m0, %2\n\ts_nop 0\n\tglobal_load_lds_dwordx4 %1, %3\n\ts_mov_b32 m0, %0" : "=&s"(_keep) : "v"((voff)[_i]), "s"(ldsb + (unsigned)((bufoff) + _i * 8192)), "s"((const char*)(gbase)) : "memory"); } } while (0)
#define PG8_LDA(dst, b, h) do { _Pragma("unroll") for (int m = 0; m < 4; ++m) { if constexpr (FP8) { const i32x4 _l = *(const LAS i32x4*)(lds + PG8_SA(b, h) + aoff + m * 2048), _h = *(const LAS i32x4*)(lds + PG8_SA(b, h) + aoffx + m * 2048); dst##8[m] = __builtin_shufflevector(_l, _h, 0, 1, 2, 3, 4, 5, 6, 7); } \
        else { _Pragma("unroll") for (int k = 0; k < 2; ++k) dst[m][k] = *(const LAS bf16x8*)(lds + PG8_SA(b, h) + aoff + m * 2048 + k * 1024); } } } while (0)
#define PG8_LDB(dst, b, h) do { _Pragma("unroll") for (int n = 0; n < 2; ++n) { if constexpr (FP8) { const i32x4 _l = *(const LAS i32x4*)(lds + PG8_SB(b, h) + boff + n * 2048), _h = *(const LAS i32x4*)(lds + PG8_SB(b, h) + boffx + n * 2048); dst##8[n] = __builtin_shufflevector(_l, _h, 0, 1, 2, 3, 4, 5, 6, 7); } \
        else { _Pragma("unroll") for (int k = 0; k < 2; ++k) dst[n][k] = *(const LAS bf16x8*)(lds + PG8_SB(b, h) + boff + n * 2048 + k * 1024); } } } while (0)
#define PG8_MMA(ai, bj, At, Bt) do { __builtin_amdgcn_s_setprio(1); _Pragma("unroll") for (int m = 0; m < 4; ++m) _Pragma("unroll") for (int n = 0; n < 2; ++n) { \
        if constexpr (FP8) { acc[ai][bj][m][n] = __builtin_amdgcn_mfma_scale_f32_16x16x128_f8f6f4(Bt##8[n], At##8[m], acc[ai][bj][m][n], 0, 0, 0, 0, 0, 0); } \
        else { _Pragma("unroll") for (int k = 0; k < 2; ++k) acc[ai][bj][m][n] = __builtin_amdgcn_mfma_f32_16x16x32_bf16(Bt[n][k], At[m][k], acc[ai][bj][m][n], 0, 0, 0); } } \
        __builtin_amdgcn_s_setprio(0); } while (0)
#define PG8_WAIT_V(n) asm volatile("s_waitcnt vmcnt(" #n ")" ::: "memory")
#define PG8_WAIT_L(n) asm volatile("s_waitcnt lgkmcnt(" #n ")" ::: "memory")
#define PG8_BAR __builtin_amdgcn_s_barrier()
#define PG8_SCHED __builtin_amdgcn_sched_barrier(0)
    Unit cur, nxt; int ui = 0;
    if (!S.next(0, cur)) return;
    f32x4 acc[2][2][4][2];
#pragma unroll
    for (int a = 0; a < 2; ++a)
#pragma unroll
        for (int b = 0; b < 2; ++b)
#pragma unroll
            for (int m = 0; m < 4; ++m)
#pragma unroll
                for (int n = 0; n < 2; ++n) acc[a][b][m][n] = (f32x4){0.f, 0.f, 0.f, 0.f};
    bf16x8 At[FP8 ? 1 : 4][2], B0[FP8 ? 1 : 2][2], B1[FP8 ? 1 : 2][2]; i32x8 At8[FP8 ? 4 : 1], B08[FP8 ? 2 : 1], B18[FP8 ? 2 : 1];
    const char* cA = uni_ptr(S.a_ptr(cur)); const char* cB = uni_ptr(S.b_ptr(cur));
    if constexpr (GATHER) S.a_rows(0, wv, offC);
    else if constexpr (ABLK) { offC[0][0] = (unsigned)((C0 >> 4) * ABLK_GSTR + R0 * 32 + (C0 & 15) * 2); offC[0][1] = (unsigned)((C1 >> 4) * ABLK_GSTR + R1 * 32 + (C1 & 15) * 2); offC[1][0] = offC[0][0]; offC[1][1] = offC[0][1]; }
    else { offC[0][0] = (unsigned)(R0 * LDA + C0) * 2u; offC[0][1] = (unsigned)(R1 * LDA + C1) * 2u; offC[1][0] = offC[0][0]; offC[1][1] = offC[0][1]; }
    PG8_STAGE(PG8_SB(0, 0), cB, voffB); PG8_STAGE(PG8_SB(0, 1), cB + hstepB, voffB); PG8_STAGE(PG8_SA(0, 0), cA, offC[0]); PG8_STAGE(PG8_SA(0, 1), cA + hstepA, offC[1]);
    if (wr == 1) PG8_BAR;
    PG8_WAIT_V(2); PG8_BAR;
    PG8_STAGE(PG8_SB(1, 0), cB + kstep, voffB); PG8_STAGE(PG8_SA(1, 0), cA + kstepA, offC[0]); PG8_STAGE(PG8_SB(1, 1), cB + hstepB + kstep, voffB);
    PG8_WAIT_V(6); PG8_BAR;
    for (;;) {
        if (PRB && PROBE_GEMM == 3) { Unit dummy; (void)S.next(ui + 1 + (int)(pt & 1), dummy); asm volatile("" :: "s"(dummy.pm), "s"(dummy.pn), "s"(dummy.g)); }
        const bool has_next = S.next(ui + 1, nxt);
        const char* nA = has_next ? uni_ptr(S.a_ptr(nxt)) : cA; const char* nB = has_next ? uni_ptr(S.b_ptr(nxt)) : cB;
        if (PRB && PROBE_GEMM) { const unsigned long long now = wall_clock64(); if (pt) pe += now - pt; pt = now; }
#pragma unroll 1
        for (int t = 0; t < nt; t += 2) {
            const bool last = (t == nt - 2);
            const char* a1 = cA + (size_t)(t + 1) * kstepA;
            const char* a2 = last ? nA : cA + (size_t)(t + 2) * kstepA; const char* b2 = last ? nB : cB + (size_t)(t + 2) * kstep;
            const char* a3 = a2 + kstepA; const char* b3 = b2 + kstep;
            unsigned o2[2][2];
            if constexpr (GATHER) { if (last && has_next) S.a_rows(ui + 1, wv, o2); else { o2[0][0] = offC[0][0]; o2[0][1] = offC[0][1]; o2[1][0] = offC[1][0]; o2[1][1] = offC[1][1]; } }
            else { o2[0][0] = offC[0][0]; o2[0][1] = offC[0][1]; o2[1][0] = offC[1][0]; o2[1][1] = offC[1][1]; }
            PG8_LDB(B0, 0, 0); PG8_LDB(B1, 0, 1); PG8_SCHED; PG8_LDA(At, 0, 0); PG8_STAGE(PG8_SA(1, 1), a1 + hstepA, offC[1]);
            PG8_WAIT_V(8); PG8_WAIT_L(0); PG8_BAR; PG8_MMA(0, 0, At, B0); PG8_MMA(0, 1, At, B1); PG8_BAR; PG8_SCHED;
            PG8_LDA(At, 0, 1); PG8_STAGE(PG8_SB(0, 0), b2, voffB); PG8_STAGE(PG8_SB(0, 1), b2 + hstepB, voffB); PG8_STAGE(PG8_SA(0, 0), a2, o2[0]);
            PG8_WAIT_V(8); PG8_WAIT_L(0); PG8_BAR; PG8_MMA(1, 0, At, B0); PG8_MMA(1, 1, At, B1); PG8_BAR; PG8_SCHED;
            PG8_LDB(B0, 1, 0); PG8_LDB(B1, 1, 1); PG8_SCHED; PG8_LDA(At, 1, 0); PG8_STAGE(PG8_SA(0, 1), a2 + hstepA, o2[1]);
            PG8_WAIT_V(8); PG8_WAIT_L(0); PG8_BAR; PG8_MMA(0, 0, At, B0); PG8_MMA(0, 1, At, B1); PG8_BAR; PG8_SCHED;
            PG8_LDA(At, 1, 1); PG8_STAGE(PG8_SB(1, 0), b3, voffB); PG8_STAGE(PG8_SB(1, 1), b3 + hstepB, voffB); PG8_STAGE(PG8_SA(1, 0), a3, o2[0]);
            PG8_WAIT_V(8); PG8_WAIT_L(0); PG8_BAR; PG8_MMA(1, 0, At, B0); PG8_MMA(1, 1, At, B1); PG8_BAR; PG8_SCHED;
        }
        if (PRB && PROBE_GEMM) { const unsigned long long now = wall_clock64(); pk += now - pt; pt = now; }
        if constexpr (ALIGN_EPI) { if (wr == 0) PG8_BAR; }
        { const int l2 = make_tid(wv) & 63;
          E(acc, cur, wr, wc, l2 & 15, l2 >> 4);
          if (PRB && PROBE_GEMM == 2) { const int l3 = make_tid(wv) & 63; E(acc, cur, wr, wc, l3 & 15, l3 >> 4); } }
        if (!has_next) break;
#pragma unroll
        for (int a = 0; a < 2; ++a)
#pragma unroll
            for (int b = 0; b < 2; ++b)
#pragma unroll
                for (int m = 0; m < 4; ++m)
#pragma unroll
                    for (int n = 0; n < 2; ++n) acc[a][b][m][n] = (f32x4){0.f, 0.f, 0.f, 0.f};
        cur = nxt; cA = nA; cB = nB; ++ui;
        if constexpr (GATHER) S.a_rows(ui, wv, offC);
        if constexpr (ALIGN_EPI) { if (wr == 1) PG8_BAR; }
    }
    PG8_WAIT_V(0);
    if constexpr (!ALIGN_EPI) { if (wr == 0) PG8_BAR; }
    PG8_BAR;
    if (PRB && PROBE_GEMM) { const unsigned long long now = wall_clock64(); pe += now - pt; if (blockIdx.x == PRB - 1 && tid == 0) { diag[0] = (float)pk * 0.01f; diag[1] = (float)pe * 0.01f; } }
#undef PG8_SA
#undef PG8_SB
#undef PG8_STAGE
#undef PG8_LDA
#undef PG8_LDB
#undef PG8_MMA
#undef PG8_WAIT_V
#undef PG8_WAIT_L
#undef PG8_BAR
#undef PG8_SCHED
}
}
using pg8::Unit;
typedef f32x4 AccT[2][2][4][2];

struct SchedInProj {
    const unsigned char* ws; int c;
    __device__ __forceinline__ bool next(int i, Unit& u) const {
        const int L = i * G_INPROJ + c; if (L >= 1104) return false;
        const int w = pg8::xcd_chunk(L, 1104);
        if (w < 1024) { const int gid = w >> 7, r = w & 127; u.pm = gid * 8 + (r & 7); u.pn = r >> 3; }
        else { const int j = w - 1024, q = j >> 3; u.pm = 64 + (j & 7); u.pn = q < 6 ? 2 + q : 6 + q; }
        u.g = 0; return true;
    }
    __device__ __forceinline__ const char* a_ptr(const Unit& u) const { return (const char*)(ws + WS_U1) + (size_t)u.pm * 256 * 2048 * (INPROJ_FP8 ? 1 : 2); }
    __device__ __forceinline__ const char* b_ptr(const Unit& u) const { return (const char*)(ws + WS_WIN_T) + (size_t)u.pn * 256 * 2048 * (INPROJ_FP8 ? 1 : 2); }
};
constexpr float IP_SCALE = INPROJ_FP8 ? FP8_OSCALE : 1.0f;
struct EpiInProj {
    static constexpr bool PERM = true;
    unsigned char* ws;
    __device__ __forceinline__ void operator()(const AccT& acc, const Unit& u, int wr, int wc, int fr, int fq) const {
        if (u.pn < 12) {
            const size_t wsb = u.pn < 4 ? WS_ZQK : (u.pn < 8 ? WS_VBUF : WS_OBUF);
            char* base = (char*)pg8::uni_ptr((const char*)(ws + wsb + (size_t)u.pm * 256 * 2048 + (u.pn & 3) * 512));
            const unsigned vo = (unsigned)((wr * 64 + fr) * 2048 + wc * 64 + 16 * fq);
#pragma unroll
            for (int ai = 0; ai < 2; ++ai)
#pragma unroll
                for (int m = 0; m < 4; ++m)
#pragma unroll
                    for (int bj = 0; bj < 2; ++bj) {
                        const f32x4 v0 = acc[ai][bj][m][0] * IP_SCALE, v1 = acc[ai][bj][m][1] * IP_SCALE;
                        u32x4 w; w.x = cvt_pk_bf16(v0[0], v0[1]); w.y = cvt_pk_bf16(v0[2], v0[3]); w.z = cvt_pk_bf16(v1[0], v1[1]); w.w = cvt_pk_bf16(v1[2], v1[3]);
                        *(u32x4*)(base + (vo + (unsigned)((ai * 128 + m * 16) * 2048 + bj * 256))) = w; }
        } else {
            const unsigned vo = (unsigned)(((fq >> 1) * (1280 * 512) + fr * 16 + 8 * (fq & 1)) * 2);
#pragma unroll
            for (int ai = 0; ai < 2; ++ai)
#pragma unroll
                for (int m = 0; m < 4; ++m) {
                    const int rowb = u.pm * 256 + ai * 128 + wr * 64 + m * 16; int crow;
                    if (rowb < NLAT) crow = (rowb >> 11) * 128 + ((rowb & 2047) >> 4); else { const int rr = rowb - NLAT; crow = 1024 + (rr >> 8) * 16 + ((rr & 255) >> 4); }
#pragma unroll
                    for (int bj = 0; bj < 2; ++bj) {
                        const f32x4 v0 = acc[ai][bj][m][0] * IP_SCALE, v1 = acc[ai][bj][m][1] * IP_SCALE;
                        u32x4 w; w.x = cvt_pk_bf16(v0[0], v0[1]); w.y = cvt_pk_bf16(v0[2], v0[3]); w.z = cvt_pk_bf16(v1[0], v1[1]); w.w = cvt_pk_bf16(v1[2], v1[3]);
                        char* base = (char*)pg8::uni_ptr((const char*)(ws + WS_AS5 + (size_t)((((u.pn - 12) * 16 + bj * 8 + wc * 2) * 1280 + crow) * 512) * 2));
                        *(u32x4*)(base + vo) = w; }
                }
        }
    }
};

struct SchedS5V {
    const unsigned char* ws; int c;
    __device__ __forceinline__ bool next(int i, Unit& u) const { const int L = i * NWG + c; if (L >= 320) return false; const int w = pg8::xcd_chunk(L, 320); u.g = w / 5; u.pm = w % 5; u.pn = 0; return true; }
    __device__ __forceinline__ const char* a_ptr(const Unit& u) const { return (const char*)(ws + WS_AS5) + ((size_t)u.g * 1280 + u.pm * 256) * 512 * 2; }
    __device__ __forceinline__ const char* b_ptr(const Unit& u) const { return (const char*)(ws + WS_BTV) + (size_t)u.g * 256 * 256 * 2; }
};
struct EpiS5V {
    static constexpr bool PERM = false;
    unsigned char* ws;
    __device__ __forceinline__ void operator()(const AccT& acc, const Unit& u, int wr, int wc, int fr, int fq) const {
        float* base = (float*)(ws + WS_VS5) + ((size_t)u.g * 1280 + u.pm * 256) * 256;
#pragma unroll
        for (int ai = 0; ai < 2; ++ai)
#pragma unroll
            for (int m = 0; m < 4; ++m) { float* rowp = base + (size_t)(ai * 128 + wr * 64 + m * 16 + fr) * 256 + wc * 32 + 4 * fq;
#pragma unroll
                for (int bj = 0; bj < 2; ++bj)
#pragma unroll
                    for (int n = 0; n < 2; ++n) *(f32x4*)(rowp + bj * 128 + n * 16) = acc[ai][bj][m][n]; }
    }
};

struct SchedS5Y {
    const unsigned char* ws; int c;
    __device__ __forceinline__ bool next(int i, Unit& u) const { const int L = i * NWG + c; if (L >= 256) return false; const int w = pg8::xcd_chunk(L, 256); u.g = w >> 2; u.pm = w & 3; u.pn = 0; return true; }
    __device__ __forceinline__ const char* a_ptr(const Unit& u) const { return (const char*)(ws + WS_AS5) + ((size_t)u.g * 1280 + u.pm * 256) * 512 * 2; }
    __device__ __forceinline__ const char* b_ptr(const Unit& u) const { return (const char*)(ws + WS_BTY) + (size_t)u.g * 256 * 512 * 2; }
};
__device__ __forceinline__ float gelu_tanh(float x) { const float u = 0.7978845608028654f * (x + 0.044715f * x * x * x); const float e = __builtin_amdgcn_exp2f(u * 2.8853900817779268f); const float th = 1.0f - 2.0f * __builtin_amdgcn_rcpf(e + 1.0f); return 0.5f * x * (1.0f + th); }
struct EpiS5Y {
    static constexpr bool PERM = true;
    unsigned char* ws; const float* s5_d;
    __device__ __forceinline__ void operator()(const AccT& acc, const Unit& u, int wr, int wc, int fr, int fq) const {
        f32x4 dd[2][2];
#pragma unroll
        for (int bj = 0; bj < 2; ++bj) { const int h0 = (bj * 128 + wc * 32 + 8 * fq) & 15; dd[bj][0] = *(const f32x4*)(s5_d + u.g * 16 + h0); dd[bj][1] = *(const f32x4*)(s5_d + u.g * 16 + h0 + 4); }
        u32x4 ub[2][4];
#define S5Y_LOAD(q, B) do { _Pragma("unroll") for (int mm = 0; mm < 2; ++mm) _Pragma("unroll") for (int bj = 0; bj < 2; ++bj) { const int ai = (q) >> 1, m = ((q) & 1) * 2 + mm; \
            const int cr = u.pm * 256 + ai * 128 + wr * 64 + m * 16 + fr, nn = bj * 128 + wc * 32 + 8 * fq; \
            B[mm * 2 + bj] = *(const u32x4*)((const bf16_t*)(ws + WS_AS5) + ((size_t)u.g * 1280 + cr) * 512 + nn); } } while (0)
        S5Y_LOAD(0, ub[0]);
#pragma unroll
        for (int q = 0; q < 4; ++q) {
            if (q + 1 < 4) S5Y_LOAD(q + 1, ub[(q + 1) & 1]);
#pragma unroll
            for (int mm = 0; mm < 2; ++mm)
#pragma unroll
                for (int bj = 0; bj < 2; ++bj) { const int ai = q >> 1, m = (q & 1) * 2 + mm;
                    const int cr = u.pm * 256 + ai * 128 + wr * 64 + m * 16 + fr, b = cr >> 7, cb = cr & 127;
                    const int nn = bj * 128 + wc * 32 + 8 * fq, tt = nn >> 4, h0 = nn & 15;
                    const u32x4 uw = ub[q & 1][mm * 2 + bj]; const f32x4 d0 = dd[bj][0], d1 = dd[bj][1];
                    const f32x4 y0 = acc[ai][bj][m][0], y1 = acc[ai][bj][m][1];
                    float s[8];
                    s[0] = gelu_tanh(y0[0] + d0[0] * bflo(uw.x)); s[1] = gelu_tanh(y0[1] + d0[1] * bfhi(uw.x)); s[2] = gelu_tanh(y0[2] + d0[2] * bflo(uw.y)); s[3] = gelu_tanh(y0[3] + d0[3] * bfhi(uw.y));
                    s[4] = gelu_tanh(y1[0] + d1[0] * bflo(uw.z)); s[5] = gelu_tanh(y1[1] + d1[1] * bfhi(uw.z)); s[6] = gelu_tanh(y1[2] + d1[2] * bflo(uw.w)); s[7] = gelu_tanh(y1[3] + d1[3] * bfhi(uw.w));
                    u32x4 w; w.x = cvt_pk_bf16(s[0], s[1]); w.y = cvt_pk_bf16(s[2], s[3]); w.z = cvt_pk_bf16(s[4], s[5]); w.w = cvt_pk_bf16(s[6], s[7]);
                    *(u32x4*)((bf16_t*)(ws + WS_SBUF) + ((size_t)u.g * 16384 + b * 2048 + cb * 16 + tt) * 16 + h0) = w; }
        }
#undef S5Y_LOAD
    }
};

template <int NN> struct SchedStatic {
    const char* A; const char* Bt; int c; size_t a_tile_bytes, b_tile_bytes;
    __device__ __forceinline__ bool next(int i, Unit& u) const { constexpr int nwg = 64 * NN; const int L = i * NWG + c; if (L >= nwg) return false;
        const int w = pg8::xcd_chunk(L, nwg); const int nig = 8 * NN, gid = w / nig, r = w % nig; u.pm = gid * 8 + (r & 7); u.pn = r >> 3; u.g = 0; return true; }
    __device__ __forceinline__ const char* a_ptr(const Unit& u) const { return A + (size_t)u.pm * a_tile_bytes; }
    __device__ __forceinline__ const char* b_ptr(const Unit& u) const { return Bt + (size_t)u.pn * b_tile_bytes; }
};
struct EpiGLU {
    static constexpr bool PERM = true;
    unsigned char* ws;
    __device__ __forceinline__ void operator()(const AccT& acc, const Unit& u, int wr, int wc, int fr, int fq) const {
        u32x4 sb[2][4];
#define GLU_LOAD(q, B) do { _Pragma("unroll") for (int mm = 0; mm < 2; ++mm) _Pragma("unroll") for (int bj = 0; bj < 2; ++bj) { const int ai = (q) >> 1, m = ((q) & 1) * 2 + mm; \
            const int row = u.pm * 256 + ai * 128 + wr * 64 + m * 16 + fr, col = u.pn * 256 + bj * 128 + wc * 32 + 8 * fq; \
            B[mm * 2 + bj] = *(const u32x4*)((const bf16_t*)(ws + WS_SBUF) + ((size_t)(col >> 4) * 16384 + row) * 16 + (col & 15)); } } while (0)
        GLU_LOAD(0, sb[0]);
#pragma unroll
        for (int q = 0; q < 4; ++q) {
            if (q + 1 < 4) GLU_LOAD(q + 1, sb[(q + 1) & 1]);
#pragma unroll
            for (int mm = 0; mm < 2; ++mm)
#pragma unroll
                for (int bj = 0; bj < 2; ++bj) { const int ai = q >> 1, m = (q & 1) * 2 + mm;
                    const int row = u.pm * 256 + ai * 128 + wr * 64 + m * 16 + fr, col = u.pn * 256 + bj * 128 + wc * 32 + 8 * fq;
                    const u32x4 sw = sb[q & 1][mm * 2 + bj];
                    const f32x4 a0 = acc[ai][bj][m][0], a1 = acc[ai][bj][m][1];
                    u32x2 w;
                    w.x = cvt4_fp8_sat(bflo(sw.x) * sigmoidf_(a0[0]) * FP8_ASCALE, bfhi(sw.x) * sigmoidf_(a0[1]) * FP8_ASCALE, bflo(sw.y) * sigmoidf_(a0[2]) * FP8_ASCALE, bfhi(sw.y) * sigmoidf_(a0[3]) * FP8_ASCALE);
                    w.y = cvt4_fp8_sat(bflo(sw.z) * sigmoidf_(a1[0]) * FP8_ASCALE, bfhi(sw.z) * sigmoidf_(a1[1]) * FP8_ASCALE, bflo(sw.w) * sigmoidf_(a1[2]) * FP8_ASCALE, bfhi(sw.w) * sigmoidf_(a1[3]) * FP8_ASCALE);
                    *(u32x2*)(ws + WS_CAT + (size_t)row * 2048 + 1024 + col) = w; }
        }
#undef GLU_LOAD
    }
};
struct EpiOut {
    static constexpr bool PERM = true;
    unsigned char* ws; const float* x;
    __device__ __forceinline__ void operator()(const AccT& acc, const Unit& u, int wr, int wc, int fr, int fq) const {
        const float* g1 = (const float*)(ws + WS_MOD) + (size_t)(u.pm >> 3) * 12288 + 2 * 2048;
        const int col0 = u.pn * 256 + wc * 32 + 8 * fq;
        f32x4 gv[2][2];
#pragma unroll
        for (int bj = 0; bj < 2; ++bj)
#pragma unroll
            for (int n = 0; n < 2; ++n) gv[bj][n] = *(const f32x4*)(g1 + col0 + bj * 128 + n * 4);
        f32x4 xb[2][8];
#define OUT_LOAD(q, B) do { _Pragma("unroll") for (int mm = 0; mm < 2; ++mm) _Pragma("unroll") for (int bj = 0; bj < 2; ++bj) { const int ai = (q) >> 1, m = ((q) & 1) * 2 + mm; \
            const size_t ro = (size_t)(u.pm * 256 + ai * 128 + wr * 64 + m * 16 + fr) * 2048 + col0; \
            B[(mm * 2 + bj) * 2] = *(const f32x4*)(x + ro + bj * 128); B[(mm * 2 + bj) * 2 + 1] = *(const f32x4*)(x + ro + bj * 128 + 4); } } while (0)
        OUT_LOAD(0, xb[0]);
#pragma unroll
        for (int q = 0; q < 4; ++q) {
            if (q + 1 < 4) OUT_LOAD(q + 1, xb[(q + 1) & 1]);
#pragma unroll
            for (int mm = 0; mm < 2; ++mm)
#pragma unroll
                for (int bj = 0; bj < 2; ++bj) { const int ai = q >> 1, m = (q & 1) * 2 + mm;
                    const size_t ro = (size_t)(u.pm * 256 + ai * 128 + wr * 64 + m * 16 + fr) * 2048 + col0;
                    const f32x4 xv0 = xb[q & 1][(mm * 2 + bj) * 2], xv1 = xb[q & 1][(mm * 2 + bj) * 2 + 1];
                    const f32x4 r0 = xv0 + gv[bj][0] * (acc[ai][bj][m][0] * FP8_OSCALE), r1 = xv1 + gv[bj][1] * (acc[ai][bj][m][1] * FP8_OSCALE);
                    u32x4 w; w.x = cvt_pk_bf16(r0[0], r0[1]); w.y = cvt_pk_bf16(r0[2], r0[3]); w.z = cvt_pk_bf16(r1[0], r1[1]); w.w = cvt_pk_bf16(r1[2], r1[3]);
                    *(u32x4*)((bf16_t*)(ws + WS_X1) + ro + bj * 128) = w; }
        }
#undef OUT_LOAD
    }
};

struct EpiOutDummy {
    static constexpr bool PERM = false;
    unsigned char* ws; const float* x;
    __device__ __forceinline__ void operator()(const AccT& acc, const Unit& u, int wr, int wc, int fr, int fq) const {
        const float* g1 = (const float*)(ws + WS_MOD) + (size_t)(u.pm >> 3) * 12288 + 2 * 2048;
        const int col0 = u.pn * 256 + wc * 32 + 4 * fq;
#pragma unroll
        for (int ai = 0; ai < 2; ++ai)
#pragma unroll
            for (int m = 0; m < 4; ++m) { const size_t ro = (size_t)(u.pm * 256 + ai * 128 + wr * 64 + m * 16 + fr) * 2048 + col0;
#pragma unroll
                for (int bj = 0; bj < 2; ++bj)
#pragma unroll
                    for (int n = 0; n < 2; ++n) { const f32x4 xv = *(const f32x4*)(x + ro + bj * 128 + n * 16); const f32x4 gv = *(const f32x4*)(g1 + col0 + bj * 128 + n * 16);
                        *(f32x4*)((float*)(ws + WS_HID) + ro + bj * 128 + n * 16) = xv + gv * (acc[ai][bj][m][n] * FP8_OSCALE); } }
    }
};
template <int NN, bool HOT> struct SchedProbe : SchedStatic<NN> {
    __device__ __forceinline__ const char* a_ptr(const Unit& u) const { return HOT ? this->A : this->A + (size_t)u.pm * this->a_tile_bytes; }
    __device__ __forceinline__ const char* b_ptr(const Unit& u) const { return HOT ? this->Bt : this->Bt + (size_t)u.pn * this->b_tile_bytes; }
};
struct MoeTables { LAS const int* tp; LAS const int* cnt; LAS const unsigned short* rows; LAS const int* utab; LAS const unsigned char* bias; };
template <int NN  > struct SchedMoE {
    const unsigned char* ws; int c; MoeTables T; const char* A; const char* Bt; size_t b_expert_bytes; int nwg;
    __device__ __forceinline__ bool decode(int i, int (&o)[5]) const {
        const int L = i * NWG + c; if (L >= nwg) return false;
        const int w = pg8::xcd_chunk(L, nwg);
        int e = 0;
#pragma unroll
        for (int j = 1; j < 32; ++j) e = (w >= T.tp[j] * NN) ? j : e;
        const int t0 = T.tp[e], t1 = T.tp[e + 1], q = w - t0 * NN, mt = t1 - t0;
        o[0] = e; o[1] = q % mt; o[2] = q / mt; o[3] = t0; o[4] = T.cnt[e]; return true;
    }
    __device__ __forceinline__ bool next(int i, Unit& u) const {
        if (i * NWG + c >= nwg) return false;
        LAS const int* r = T.utab + i * 8;
        u.g = __builtin_amdgcn_readfirstlane(r[0]); u.pm = __builtin_amdgcn_readfirstlane(r[1]); u.pn = __builtin_amdgcn_readfirstlane(r[2]); u.rb = __builtin_amdgcn_readfirstlane(r[3]); u.cn = __builtin_amdgcn_readfirstlane(r[4]); u.ui = i; return true;
    }
    __device__ __forceinline__ const char* a_ptr(const Unit& u) const { return A; }
    __device__ __forceinline__ const char* b_ptr(const Unit& u) const { return Bt + (size_t)u.g * b_expert_bytes + (size_t)u.pn * 256 * 2048; }
    __device__ __forceinline__ void a_rows(int ui, int wv, unsigned (&off)[2][2]) const {
        const int tid = make_tid(wv); int R0, C0, R1, C1; pg8::stage_rc8(tid * 16, R0, C0); pg8::stage_rc8(tid * 16 + 8192, R1, C1);
        LAS const unsigned short* rw = T.rows + ui * 256;
        const int t00 = rw[R0], t01 = rw[R1], t10 = rw[R0 + 128], t11 = rw[R1 + 128];
        off[0][0] = (unsigned)(t00 * 1024 + C0) * 2u; off[0][1] = (unsigned)(t01 * 1024 + C1) * 2u; off[1][0] = (unsigned)(t10 * 1024 + C0) * 2u; off[1][1] = (unsigned)(t11 * 1024 + C1) * 2u;
    }
};
struct SchedMoE2 : SchedMoE<8> {
    __device__ __forceinline__ const char* a_ptr(const Unit& u) const { return A + (size_t)(u.rb + u.pm) * 256 * 2048; }
};
struct EpiMoE1 {
    static constexpr bool PERM = true;
    unsigned char* ws; const float* b_gu; MoeTables T;
    __device__ __forceinline__ void operator()(const AccT& acc, const Unit& u, int wr, int wc, int fr, int fq) const {
        const int hc = u.pn * 128 + wc * 32 + 8 * fq;
        const __amdgpu_buffer_rsrc_t hrs = __builtin_amdgcn_make_buffer_rsrc((void*)pg8::uni_ptr((const char*)(ws + WS_HID + (size_t)(u.rb + u.pm) * 256 * 2048)), 0, 256 * 2048, 0x00020000);
        const int hvo = (wr * 64 + fr) * 2048 + hc;
        f32x4 bgv[2], buv[2];
#pragma unroll
        for (int n = 0; n < 2; ++n) {
            LAS const unsigned char* bl = T.bias + u.ui * 512 + (wc * 32 + 8 * fq + 4 * n) * 2;
            const u32x2 bgw = *(LAS const u32x2*)bl, buw = *(LAS const u32x2*)(bl + 256);
            bgv[n] = (f32x4){bflo(bgw.x), bfhi(bgw.x), bflo(bgw.y), bfhi(bgw.y)}; buv[n] = (f32x4){bflo(buw.x), bfhi(buw.x), bflo(buw.y), bfhi(buw.y)}; }
#pragma unroll
        for (int ai = 0; ai < 2; ++ai)
#pragma unroll
            for (int m = 0; m < 4; ++m) { u32x2 w8;
#pragma unroll
                for (int n = 0; n < 2; ++n) {
                    const f32x4 g0 = acc[ai][0][m][n] * FP8_OSCALE + bgv[n], u0 = acc[ai][1][m][n] * FP8_OSCALE + buv[n];
                    f32x4 ga, ua;
#pragma unroll
                    for (int j = 0; j < 4; ++j) { ga[j] = fminf(g0[j], 7.0f); ua[j] = __builtin_amdgcn_fmed3f(u0[j], -7.0f, 7.0f); }
                    f32x4 ex = ga * (-1.702f * 1.4426950408889634f);
#pragma unroll
                    for (int j = 0; j < 4; ++j) ex[j] = __builtin_amdgcn_exp2f(ex[j]);
                    f32x4 den = ex + 1.0f;
#pragma unroll
                    for (int j = 0; j < 4; ++j) den[j] = __builtin_amdgcn_rcpf(den[j]);
                    const f32x4 h = (ua * FP8_ASCALE + FP8_ASCALE) * ga * den;
                    w8[n] = cvt4_fp8(h[0], h[1], h[2], h[3]); }
                __builtin_amdgcn_raw_buffer_store_b64(w8, hrs, hvo, (ai * 128 + m * 16) * 2048, 0); }
    }
};
struct EpiMoE2 {
    static constexpr bool PERM = true;
    unsigned char* ws; const float* b_down; MoeTables T;
    __device__ __forceinline__ void operator()(const AccT& acc, const Unit& u, int wr, int wc, int fr, int fq) const {
        const __amdgpu_buffer_rsrc_t ors = __builtin_amdgcn_make_buffer_rsrc((void*)pg8::uni_ptr((const char*)(ws + WS_OUT2 + (size_t)(u.rb + u.pm) * 256 * 2048 + (size_t)u.pn * 256)), 0, 256 * 2048, 0x00020000);
        const int ovo = (wr * 64 + fr) * 2048 + (wc * 32 + 8 * fq);
#pragma unroll
        for (int bj = 0; bj < 2; ++bj) {
            LAS const float* bl = (LAS const float*)T.bias + u.ui * 256 + bj * 128 + wc * 32 + 8 * fq;
            const f32x4 b0 = *(LAS const f32x4*)bl, b1 = *(LAS const f32x4*)(bl + 4);
#pragma unroll
            for (int ai = 0; ai < 2; ++ai)
#pragma unroll
                for (int m = 0; m < 4; ++m) {
                    const f32x4 v0 = (acc[ai][bj][m][0] * FP8_OSCALE + b0) * FP8_YSCALE, v1 = (acc[ai][bj][m][1] * FP8_OSCALE + b1) * FP8_YSCALE;
                    u32x2 w; w.x = cvt4_fp8(v0[0], v0[1], v0[2], v0[3]); w.y = cvt4_fp8(v1[0], v1[1], v1[2], v1[3]);
                    __builtin_amdgcn_raw_buffer_store_b64(w, ors, ovo, (ai * 128 + m * 16) * 2048 + bj * 128, 0);
                    asm volatile("" ::: "memory");
                }
        }
    }
};
#define CV_GEO(row) const bool lat = (row) < NLAT; int bbase, gr, gc, ncol, nrowmax; \
    if (lat) { const int l = (row) & 2047; bbase = (row) - l; gr = l >> 6; gc = l & 63; ncol = 64; nrowmax = 32; } \
    else { const int rr = (row) - NLAT, l = rr & 255; bbase = (row) - l; gr = 0; gc = l; ncol = 256; nrowmax = 1; }
#define CV_LOAD(Z, row) do { CV_GEO(row) \
    _Pragma("unroll") for (int dy = -1; dy <= 1; ++dy) _Pragma("unroll") for (int dx = -1; dx <= 1; ++dx) { const int r2 = gr + dy, c2 = gc + dx; \
        if (r2 >= 0 && r2 < nrowmax && c2 >= 0 && c2 < ncol) Z[(dy + 1) * 3 + dx + 1] = *(const u32x4*)(z + (size_t)(bbase + r2 * ncol + c2) * 1024 + ch0); } } while (0)
#define CV_COMPUTE(Z, row) do { CV_GEO(row) float acc[8]; \
    _Pragma("unroll") for (int j = 0; j < 8; ++j) acc[j] = 0.f; \
    _Pragma("unroll") for (int dy = -1; dy <= 1; ++dy) _Pragma("unroll") for (int dx = -1; dx <= 1; ++dx) { const int r2 = gr + dy, c2 = gc + dx; \
        if (r2 >= 0 && r2 < nrowmax && c2 >= 0 && c2 < ncol) { const u32x4 zv = Z[(dy + 1) * 3 + dx + 1]; \
            LAS const float* w = cw + ((dy + 1) * 3 + (dx + 1)) * 1024 + ch0; const f32x4 w0 = *(LAS const f32x4*)w, w1 = *(LAS const f32x4*)(w + 4); \
            acc[0] += w0[0] * bflo(zv.x); acc[1] += w0[1] * bfhi(zv.x); acc[2] += w0[2] * bflo(zv.y); acc[3] += w0[3] * bfhi(zv.y); \
            acc[4] += w1[0] * bflo(zv.z); acc[5] += w1[1] * bfhi(zv.z); acc[6] += w1[2] * bflo(zv.w); acc[7] += w1[3] * bfhi(zv.w); } } \
    _Pragma("unroll") for (int j = 0; j < 8; ++j) acc[j] = acc[j] * sigmoidf_(acc[j]) * sc; \
    u32x4 o; o.x = cvt_pk_bf16(acc[0], acc[1]); o.y = cvt_pk_bf16(acc[2], acc[3]); o.z = cvt_pk_bf16(acc[4], acc[5]); o.w = cvt_pk_bf16(acc[6], acc[7]); \
    *(u32x4*)(qk + (size_t)(row) * 1024 + ch0) = o; } while (0)
__device__ __forceinline__ void phase_conv(const Params& p, LAS unsigned char* lds, int wv) {
    const int t = make_tid(wv);
    LAS float* cw = (LAS float*)lds;
    { float wl[18];
#pragma unroll
      for (int j = 0; j < 18; ++j) wl[j] = p.conv_qk[t + NTHR * j];
#pragma unroll
      for (int j = 0; j < 18; ++j) cw[t + NTHR * j] = wl[j]; }
    __syncthreads();
    const bf16_t* z = (const bf16_t*)(p.ws + WS_ZQK);
    bf16_t* qk = (bf16_t*)(p.ws + WS_QK);
    const int cg = t & 127, rsub = t >> 7, ch0 = cg * 8;
    const float sc = ch0 >= 512 ? 0.08838834764831845f : 1.0f;
    constexpr int NIT = NTOK / (NWG * 4);
    u32x4 za[9], zb[9];
    CV_LOAD(za, 4 * (int)blockIdx.x + rsub);
#pragma unroll 1
    for (int it = 0; it < NIT; it += 2) {
        const int row = 4 * ((int)blockIdx.x + NWG * it) + rsub, row1 = row + 4 * NWG;
        CV_LOAD(zb, row1);
        CV_COMPUTE(za, row);
        if (it + 2 < NIT) CV_LOAD(za, row1 + 4 * NWG);
        CV_COMPUTE(zb, row1);
    }
    __syncthreads();
}

__device__ __forceinline__ void phase_s5scan(const Params& p, int wv) {
    const int t = make_tid(wv); if (t >= 256) return;
    const int idx = blockIdx.x * 256 + t, pp = idx & 63, b = (idx >> 6) & 7, dir = (idx >> 9) & 1, g = idx >> 10;
    const float* lb16 = (const float*)(p.ws + WS_LB16) + (size_t)((dir * 64 + g) * 64 + pp) * 2;
    const float ar = lb16[0], ai = lb16[1];
    const float* V = (const float*)(p.ws + WS_VS5) + (size_t)g * 1280 * 256 + dir * 128 + pp;
    bf16_t* X = (bf16_t*)(p.ws + WS_AS5) + (size_t)g * 1280 * 512 + 256 + dir * 128 + pp;
    float xr = 0.f, xi = 0.f;
    {   float vr[16], vi[16];
#pragma unroll
        for (int k = 0; k < 16; ++k) { const int cix = dir ? 15 - k : k; const float* v = V + (size_t)(1024 + b * 16 + cix) * 256; vr[k] = v[0]; vi[k] = v[64]; }
#pragma unroll
        for (int k = 0; k < 16; ++k) { const float nr = ar * xr - ai * xi + vr[k], ni = ar * xi + ai * xr + vi[k]; xr = nr; xi = ni; } }
    for (int blk = 0; blk < 8; ++blk) {
        float vr[16], vi[16];
#pragma unroll
        for (int k = 0; k < 16; ++k) { const int cc = blk * 16 + k, cix = dir ? 127 - cc : cc; const float* v = V + (size_t)(b * 128 + cix) * 256; vr[k] = v[0]; vi[k] = v[64]; }
#pragma unroll
        for (int k = 0; k < 16; ++k) { const int cc = blk * 16 + k, cix = dir ? 127 - cc : cc; bf16_t* x = X + (size_t)(b * 128 + cix) * 512; x[0] = f2bf(xr); x[64] = f2bf(xi);
            const float nr = ar * xr - ai * xi + vr[k], ni = ar * xi + ai * xr + vi[k]; xr = nr; xi = ni; }
    }
}

template <int OFF1> __device__ __forceinline__ bf16x8 tr_frag(unsigned addr) {
    s16x4 a, b;
    asm volatile("ds_read_b64_tr_b16 %0, %2\n\tds_read_b64_tr_b16 %1, %2 offset:%3\n\ts_waitcnt lgkmcnt(0)" : "=&v"(a), "=&v"(b) : "v"(addr), "i"(OFF1) : "memory");
    bf16x8 r; r[0] = a[0]; r[1] = a[1]; r[2] = a[2]; r[3] = a[3]; r[4] = b[0]; r[5] = b[1]; r[6] = b[2]; r[7] = b[3]; return r;
}
struct TrF { s16x4 a, b; };
template <int OFF1> __device__ __forceinline__ void tr_issue(unsigned addr, TrF& f) {
    asm volatile("ds_read_b64_tr_b16 %0, %2\n\tds_read_b64_tr_b16 %1, %2 offset:%3" : "=&v"(f.a), "=&v"(f.b) : "v"(addr), "i"(OFF1) : "memory");
}
__device__ __forceinline__ bf16x8 tr_val(const TrF& f) { return __builtin_shufflevector(f.a, f.b, 0, 1, 2, 3, 4, 5, 6, 7); }
#define TR_W2(x) "+v"(x.a), "+v"(x.b)
#define TR_WAIT4(f0, f1, f2, f3) asm volatile("s_waitcnt lgkmcnt(0)" : TR_W2(f0), TR_W2(f1), TR_W2(f2), TR_W2(f3) :: "memory")
#define TR_WAIT2(f0, f1) asm volatile("s_waitcnt lgkmcnt(0)" : TR_W2(f0), TR_W2(f1) :: "memory")
#define TR_WAIT12(f0, f1, f2, f3, f4, f5, f6, f7, f8, f9, f10, f11) asm volatile("s_waitcnt lgkmcnt(0)" : TR_W2(f0), TR_W2(f1), TR_W2(f2), TR_W2(f3), TR_W2(f4), TR_W2(f5), TR_W2(f6), TR_W2(f7), TR_W2(f8), TR_W2(f9), TR_W2(f10), TR_W2(f11) :: "memory")
constexpr int ML_QS = 0, ML_KS = 17408, ML_VS = 34816, ML_WVS = 46080, ML_SS = 57344, ML_CS = 66560, ML_VEC = 89088, ML_F8 = 90624, ML_HS = 108032;
__device__ __forceinline__ void phase_mlstm(const Params& p, LAS unsigned char* lds, int wv) {
    const int t = make_tid(wv);
    const int lane = t & 63, wid = wv, c = blockIdx.x;
    const int bh = c & 31, b = bh >> 2, hd = bh & 3, dq = c >> 5, dir = dq >> 2, qt = dq & 3;
    const int l15 = lane & 15, g4 = lane >> 4, q4 = (lane & 15) >> 2, p4 = lane & 3;
    LAS float* vec = (LAS float*)(lds + ML_VEC);
    const unsigned ldsb = (unsigned)(size_t)lds;
    for (int i = t; i < 128 * 176 / 4; i += NTHR) ((LAS unsigned*)(lds + ML_CS))[i] = 0u;
    for (int i = t; i < 64 * 8; i += NTHR) { const int s = i >> 3, w = i & 7; ((LAS unsigned*)(lds + ML_VS + s * 176 + 128))[w] = (w == 0) ? 0x00003f80u : 0u; ((LAS unsigned*)(lds + ML_WVS + s * 176 + 128))[w] = 0u; }
    const bf16_t* QK = (const bf16_t*)(p.ws + WS_QK); const bf16_t* VB = (const bf16_t*)(p.ws + WS_VBUF); const float* GT = (const float*)(p.ws + WS_GATES);
    bf16_t* HB = (bf16_t*)(p.ws + WS_HBUF) + (size_t)dir * NLAT * 1024;
    f32x4 accC[5];
#pragma unroll
    for (int v = 0; v < 5; ++v) accC[v] = (f32x4){0.f, 0.f, 0.f, 0.f};
    float m0 = 0.f;
    u32x4 rq[2], rk[2], rv; float rig = 0.f, rlf = 0.f;
    auto tokbase = [&](int st) -> int { if (st < 4) { const int cc = dir ? 3 - st : st; return NLAT + b * 256 + cc * 64; } const int cc = dir ? 31 - (st - 4) : (st - 4); return b * 2048 + cc * 64; };
    auto issue = [&](int st) {
        const int base = tokbase(st);
#pragma unroll
        for (int i = 0; i < 2; ++i) { const int id = t + 512 * i, j = id >> 4, ch = id & 15; const size_t row = (size_t)(base + (dir ? 63 - j : j));
            if (st >= 4) rq[i] = *(const u32x4*)(QK + row * 1024 + hd * 128 + ch * 8);
            rk[i] = *(const u32x4*)(QK + row * 1024 + 512 + hd * 128 + ch * 8); }
        { const int j = t >> 3, ch = t & 7; const size_t row = (size_t)(base + (dir ? 63 - j : j)); rv = *(const u32x4*)(VB + row * 1024 + hd * 256 + qt * 64 + ch * 8); }
        if (t < 64) { const size_t row = (size_t)(base + (dir ? 63 - t : t)); rig = GT[row * 16 + (2 * dir) * 4 + hd]; rlf = GT[row * 16 + (2 * dir + 1) * 4 + hd]; }
    };
    issue(0);
    const int sidx = blockIdx.x * 256 + (t & 255), spp = sidx & 63, sb = (sidx >> 6) & 7, sdir = (sidx >> 9) & 1, sg = sidx >> 10;
    const float* SV = (const float*)(p.ws + WS_VS5) + (size_t)sg * 1280 * 256 + sdir * 128 + spp;
    bf16_t* SX = (bf16_t*)(p.ws + WS_AS5) + (size_t)sg * 1280 * 512 + 256 + sdir * 128 + spp;
    float sar = 0.f, sai = 0.f, sxr = 0.f, sxi = 0.f, svr[4], svi[4];
    auto srow = [&](int q) -> int { if (q < 16) return 1024 + sb * 16 + (sdir ? 15 - q : q); const int cc = q - 16; return sb * 128 + (sdir ? 127 - cc : cc); };
    if (wid >= 4) { const float* lb16 = (const float*)(p.ws + WS_LB16) + (size_t)((sdir * 64 + sg) * 64 + spp) * 2; sar = lb16[0]; sai = lb16[1];
#pragma unroll
        for (int k = 0; k < 4; ++k) { const float* v = SV + (size_t)srow(k) * 256; svr[k] = v[0]; svi[k] = v[64]; } }
    LAS unsigned* f8buf = (LAS unsigned*)(lds + ML_F8); f32x4 cvr[8];
    { const int c4 = t & 31, kq = t >> 5; const TileF8 T0 = p0_f8_tile(p, blockIdx.x + NWG * F8_P0); P0F8_LOAD(cvr, T0); }
    __syncthreads();
    for (int st = 0; st < 36; ++st) {
        const bool lat = st >= 4;
        const int base = tokbase(st);
#pragma unroll
        for (int i = 0; i < 2; ++i) { const int id = t + 512 * i, j = id >> 4, ch = id & 15;
            if (lat) *(LAS u32x4*)(lds + ML_QS + j * 272 + ch * 16) = rq[i];
            *(LAS u32x4*)(lds + ML_KS + j * 272 + ch * 16) = rk[i]; }
        { const int j = t >> 3, ch = t & 7; *(LAS u32x4*)(lds + ML_VS + j * 176 + ch * 16) = rv; }
        if (wid == 0) {
            float bc = rlf;
#pragma unroll
            for (int o = 1; o < 64; o <<= 1) { const float n = bperm(bc, lane - o); if (lane >= o) bc += n; }
            const float gtot = bperm(bc, 63);
            const float beta = rig - bc;
            float pm = beta;
#pragma unroll
            for (int o = 1; o < 64; o <<= 1) { const float n = bperm(pm, lane - o); if (lane >= o) pm = fmaxf(pm, n); }
            const float mm = fmaxf(m0, pm);
            const float mloc = gtot + bperm(pm, 63);
            const float mnew = fmaxf(gtot + m0, mloc);
            vec[lane] = -mm; vec[64 + lane] = beta; vec[128 + lane] = __expf(m0 - mm); vec[192 + lane] = __expf(-(bc + mm)); vec[256 + lane] = __expf(gtot + beta - mnew);
            if (lane == 0) vec[320] = __expf(gtot + m0 - mnew);
            m0 = mnew;
        }
        if (st + 1 < 36) issue(st + 1);
        if (wid >= 4) {
#pragma unroll
            for (int k = 0; k < 4; ++k) { const int q = st * 4 + k;
                if (q >= 16) { bf16_t* x = SX + (size_t)srow(q) * 512; x[0] = f2bf(sxr); x[64] = f2bf(sxi); }
                const float nr = sar * sxr - sai * sxi + svr[k], ni = sar * sxi + sai * sxr + svi[k]; sxr = nr; sxi = ni; }
            if (st + 1 < 36) {
#pragma unroll
                for (int k = 0; k < 4; ++k) { const float* v = SV + (size_t)srow(st * 4 + 4 + k) * 256; svr[k] = v[0]; svi[k] = v[64]; } }
        }
        p0_f8_to_lds(cvr, f8buf, t);
        if (st + 1 < F8_MLSTM) { const int c4 = t & 31, kq = t >> 5; const TileF8 Tn = p0_f8_tile(p, blockIdx.x + NWG * (F8_P0 + st + 1)); P0F8_LOAD(cvr, Tn); }
        __syncthreads();
        { const TileF8 Tc = p0_f8_tile(p, blockIdx.x + NWG * (F8_P0 + st)); p0_f8_store(Tc.dst, f8buf, t); }
        if (lat) {
#pragma unroll
            for (int ii = 0; ii < 2; ++ii) { const int idx = 2 * wid + ii, jt = idx >> 2, stl = idx & 3;
                f32x4 a4 = (f32x4){0.f, 0.f, 0.f, 0.f};
                if (stl <= jt) {
#pragma unroll
                    for (int ks = 0; ks < 4; ++ks) { const bf16x8 A = *(const LAS bf16x8*)(lds + ML_QS + (jt * 16 + l15) * 272 + (ks * 32 + 8 * g4) * 2);
                        const bf16x8 B = *(const LAS bf16x8*)(lds + ML_KS + (stl * 16 + l15) * 272 + (ks * 32 + 8 * g4) * 2);
                        a4 = __builtin_amdgcn_mfma_f32_16x16x32_bf16(A, B, a4, 0, 0, 0); }
                }
                const int sp = stl * 16 + l15; const float be = vec[64 + sp];
#pragma unroll
                for (int r = 0; r < 4; ++r) { const int jp = jt * 16 + 4 * g4 + r; const float v = (sp <= jp) ? a4[r] * __expf(vec[jp] + be) : 0.f;
                    *(LAS bf16_t*)(lds + ML_SS + jp * 144 + sp * 2) = f2bf(v); }
            }
        }
        { const int s = t >> 3, ch = t & 7; const float w = vec[256 + s]; const u32x4 vv = *(const LAS u32x4*)(lds + ML_VS + s * 176 + ch * 16); u32x4 o;
          o.x = cvt_pk_bf16(w * bflo(vv.x), w * bfhi(vv.x)); o.y = cvt_pk_bf16(w * bflo(vv.y), w * bfhi(vv.y)); o.z = cvt_pk_bf16(w * bflo(vv.z), w * bfhi(vv.z)); o.w = cvt_pk_bf16(w * bflo(vv.w), w * bfhi(vv.w));
          *(LAS u32x4*)(lds + ML_WVS + s * 176 + ch * 16) = o;
          if (t < 64) *(LAS bf16_t*)(lds + ML_WVS + t * 176 + 128) = f2bf(vec[256 + t]); }
        __syncthreads();
        if (lat) {
            const int jt = wid >> 1; f32x4 o3[3];
#pragma unroll
            for (int ti = 0; ti < 3; ++ti) { const int vt = (ti == 2) ? 4 : ((wid & 1) * 2 + ti);
                f32x4 a4 = (f32x4){0.f, 0.f, 0.f, 0.f};
                TrF c0, c1, c2, c3, v0, v1;
                tr_issue<4 * 176>(ldsb + ML_CS + (0 * 32 + 8 * g4 + q4) * 176 + (vt * 16 + 4 * p4) * 2, c0); tr_issue<4 * 176>(ldsb + ML_CS + (1 * 32 + 8 * g4 + q4) * 176 + (vt * 16 + 4 * p4) * 2, c1);
                tr_issue<4 * 176>(ldsb + ML_CS + (2 * 32 + 8 * g4 + q4) * 176 + (vt * 16 + 4 * p4) * 2, c2); tr_issue<4 * 176>(ldsb + ML_CS + (3 * 32 + 8 * g4 + q4) * 176 + (vt * 16 + 4 * p4) * 2, c3);
                tr_issue<4 * 176>(ldsb + ML_VS + (0 * 32 + 8 * g4 + q4) * 176 + (vt * 16 + 4 * p4) * 2, v0); tr_issue<4 * 176>(ldsb + ML_VS + (1 * 32 + 8 * g4 + q4) * 176 + (vt * 16 + 4 * p4) * 2, v1);
                bf16x8 Aq[4], As[2];
#pragma unroll
                for (int ks = 0; ks < 4; ++ks) Aq[ks] = *(const LAS bf16x8*)(lds + ML_QS + (jt * 16 + l15) * 272 + (ks * 32 + 8 * g4) * 2);
#pragma unroll
                for (int ks = 0; ks < 2; ++ks) As[ks] = *(const LAS bf16x8*)(lds + ML_SS + (jt * 16 + l15) * 144 + (ks * 32 + 8 * g4) * 2);
                TR_WAIT4(c0, c1, c2, c3); TR_WAIT2(v0, v1);
                a4 = __builtin_amdgcn_mfma_f32_16x16x32_bf16(Aq[0], tr_val(c0), a4, 0, 0, 0); a4 = __builtin_amdgcn_mfma_f32_16x16x32_bf16(Aq[1], tr_val(c1), a4, 0, 0, 0);
                a4 = __builtin_amdgcn_mfma_f32_16x16x32_bf16(Aq[2], tr_val(c2), a4, 0, 0, 0); a4 = __builtin_amdgcn_mfma_f32_16x16x32_bf16(Aq[3], tr_val(c3), a4, 0, 0, 0);
#pragma unroll
                for (int r = 0; r < 4; ++r) a4[r] *= vec[128 + jt * 16 + 4 * g4 + r];
                a4 = __builtin_amdgcn_mfma_f32_16x16x32_bf16(As[0], tr_val(v0), a4, 0, 0, 0); a4 = __builtin_amdgcn_mfma_f32_16x16x32_bf16(As[1], tr_val(v1), a4, 0, 0, 0);
                o3[ti] = a4; }
            float inv[4];
#pragma unroll
            for (int r = 0; r < 4; ++r) { const float dn = bperm(o3[2][r], lane & 48); inv[r] = 1.0f / fmaxf(fabsf(dn), vec[192 + jt * 16 + 4 * g4 + r]); }
#pragma unroll
            for (int ti = 0; ti < 2; ++ti) { const int vt = (wid & 1) * 2 + ti;
#pragma unroll
                for (int r = 0; r < 4; ++r) { const int jp = jt * 16 + 4 * g4 + r; *(LAS bf16_t*)(lds + ML_HS + jp * 144 + (vt * 16 + l15) * 2) = f2bf(o3[ti][r] * inv[r]); } }
        }
        { const float sprev = vec[320];
          TrF k0, k1, w00, w01, w10, w11, w20, w21, w30, w31, w40, w41;
          tr_issue<4 * 272>(ldsb + ML_KS + (0 * 32 + 8 * g4 + q4) * 272 + (wid * 16 + 4 * p4) * 2, k0); tr_issue<4 * 272>(ldsb + ML_KS + (1 * 32 + 8 * g4 + q4) * 272 + (wid * 16 + 4 * p4) * 2, k1);
#define ML_WV(vt, ks, f) tr_issue<4 * 176>(ldsb + ML_WVS + ((ks) * 32 + 8 * g4 + q4) * 176 + ((vt) * 16 + 4 * p4) * 2, f)
          ML_WV(0, 0, w00); ML_WV(0, 1, w01); ML_WV(1, 0, w10); ML_WV(1, 1, w11); ML_WV(2, 0, w20); ML_WV(2, 1, w21); ML_WV(3, 0, w30); ML_WV(3, 1, w31); ML_WV(4, 0, w40); ML_WV(4, 1, w41);
#undef ML_WV
#pragma unroll
          for (int vt = 0; vt < 5; ++vt) accC[vt] *= sprev;
          TR_WAIT12(k0, k1, w00, w01, w10, w11, w20, w21, w30, w31, w40, w41);
          const bf16x8 K0 = tr_val(k0), K1 = tr_val(k1);
          accC[0] = __builtin_amdgcn_mfma_f32_16x16x32_bf16(tr_val(w00), K0, accC[0], 0, 0, 0); accC[0] = __builtin_amdgcn_mfma_f32_16x16x32_bf16(tr_val(w01), K1, accC[0], 0, 0, 0);
          accC[1] = __builtin_amdgcn_mfma_f32_16x16x32_bf16(tr_val(w10), K0, accC[1], 0, 0, 0); accC[1] = __builtin_amdgcn_mfma_f32_16x16x32_bf16(tr_val(w11), K1, accC[1], 0, 0, 0);
          accC[2] = __builtin_amdgcn_mfma_f32_16x16x32_bf16(tr_val(w20), K0, accC[2], 0, 0, 0); accC[2] = __builtin_amdgcn_mfma_f32_16x16x32_bf16(tr_val(w21), K1, accC[2], 0, 0, 0);
          accC[3] = __builtin_amdgcn_mfma_f32_16x16x32_bf16(tr_val(w30), K0, accC[3], 0, 0, 0); accC[3] = __builtin_amdgcn_mfma_f32_16x16x32_bf16(tr_val(w31), K1, accC[3], 0, 0, 0);
          accC[4] = __builtin_amdgcn_mfma_f32_16x16x32_bf16(tr_val(w40), K0, accC[4], 0, 0, 0); accC[4] = __builtin_amdgcn_mfma_f32_16x16x32_bf16(tr_val(w41), K1, accC[4], 0, 0, 0); }
        __syncthreads();
        if (lat) { const int j = t >> 3, ch = t & 7; const size_t row = (size_t)(base + (dir ? 63 - j : j)); *(u32x4*)(HB + row * 1024 + hd * 256 + qt * 64 + ch * 8) = *(const LAS u32x4*)(lds + ML_HS + j * 144 + ch * 16); }
#pragma unroll
        for (int vt = 0; vt < 5; ++vt) { u32x2 w; w.x = cvt_pk_bf16(accC[vt][0], accC[vt][1]); w.y = cvt_pk_bf16(accC[vt][2], accC[vt][3]);
            *(LAS u32x2*)(lds + ML_CS + (wid * 16 + l15) * 176 + (vt * 16 + 4 * g4) * 2) = w; }
    }
    __syncthreads();
}

#define HM_LOAD(HA, HB, OW, row) do { _Pragma("unroll") for (int hd = 0; hd < 4; ++hd) { const int col = hd * 256 + lane * 4; \
        HA[hd] = *(const u32x2*)(H0 + (size_t)(row) * 1024 + col); HB[hd] = *(const u32x2*)(H1 + (size_t)(row) * 1024 + col); OW[hd] = *(const u32x2*)(O + (size_t)(row) * 1024 + col); } } while (0)
#define HM_COMPUTE(HA, HB, OW, row) do { _Pragma("unroll") for (int hd = 0; hd < 4; ++hd) { const int col = hd * 256 + lane * 4; const u32x2 ha = HA[hd], hb = HB[hd], ow = OW[hd]; \
        const f32x4 h = (f32x4){bflo(ha.x) + bflo(hb.x), bfhi(ha.x) + bfhi(hb.x), bflo(ha.y) + bflo(hb.y), bfhi(ha.y) + bfhi(hb.y)}; \
        const float ss = wave_sum(h[0] * h[0] + h[1] * h[1] + h[2] * h[2] + h[3] * h[3], lane); \
        const float rstd = rsqrtf(ss * (1.0f / 256.0f) + 1e-6f); \
        const float o0 = h[0] * rstd * gg[hd][0] * sigmoidf_(bflo(ow.x)), o1 = h[1] * rstd * gg[hd][1] * sigmoidf_(bfhi(ow.x)), o2 = h[2] * rstd * gg[hd][2] * sigmoidf_(bflo(ow.y)), o3 = h[3] * rstd * gg[hd][3] * sigmoidf_(bfhi(ow.y)); \
        *(unsigned*)(CAT + (size_t)(row) * 2048 + col) = cvt4_fp8_sat(o0 * FP8_ASCALE, o1 * FP8_ASCALE, o2 * FP8_ASCALE, o3 * FP8_ASCALE); } } while (0)
__device__ __forceinline__ void phase_hmerge(const Params& p, int wv) {
    const int t = make_tid(wv);
    const int lane = t & 63, row0 = blockIdx.x * 64 + wv * 8;
    const bf16_t* H0 = (const bf16_t*)(p.ws + WS_HBUF); const bf16_t* H1 = H0 + (size_t)NLAT * 1024;
    const bf16_t* O = (const bf16_t*)(p.ws + WS_OBUF); unsigned char* CAT = p.ws + WS_CAT;
    f32x4 gg[4];
#pragma unroll
    for (int hd = 0; hd < 4; ++hd) gg[hd] = *(const f32x4*)(p.head_g + hd * 256 + lane * 4);
    u32x2 a0[4], b0[4], o0v[4], a1[4], b1[4], o1v[4];
    HM_LOAD(a0, b0, o0v, row0);
#pragma unroll 1
    for (int i = 0; i < 8; i += 2) {
        HM_LOAD(a1, b1, o1v, row0 + i + 1);
        HM_COMPUTE(a0, b0, o0v, row0 + i);
        if (i + 2 < 8) HM_LOAD(a0, b0, o0v, row0 + i + 2);
        HM_COMPUTE(a1, b1, o1v, row0 + i + 1);
    }
}
constexpr int RT_XR = 0, RT_XSTRIDE = 4112, RT_RED = 16 * RT_XSTRIDE  , RT_LG = RT_RED + 8 * 16 * 32 * 4  , RT_RSTD = RT_LG + 64 * 33 * 4  , RT_SEL = RT_RSTD + 64, RT_CG = RT_SEL + 4096  , RT_SH = RT_CG + 8192;
__device__ __forceinline__ void phase_router(const Params& p, LAS unsigned char* lds, int wv) {
    const int t = make_tid(wv);
    const int lane = t & 63, wid = wv, l15 = lane & 15, g4 = lane >> 4;
    const bf16_t* X1 = (const bf16_t*)(p.ws + WS_X1); unsigned char* U2 = p.ws + WS_U2; const bf16_t* WRT = (const bf16_t*)(p.ws + WS_WRT);
    LAS float* red = (LAS float*)(lds + RT_RED); LAS float* lg = (LAS float*)(lds + RT_LG); LAS float* rstd = (LAS float*)(lds + RT_RSTD);
    LAS int* se = (LAS int*)(lds + RT_SEL); LAS float* sp = (LAS float*)(lds + RT_SEL + 1024); LAS int* sr = (LAS int*)(lds + RT_SEL + 2048); LAS int* lc = (LAS int*)(lds + RT_SEL + 3072); LAS int* lbase = lc + 32;
    LAS float* cg = (LAS float*)(lds + RT_CG); LAS float* shl = (LAS float*)(lds + RT_SH);
    const int bidx = blockIdx.x >> 5;
    const float* mod = (const float*)(p.ws + WS_MOD) + (size_t)bidx * 12288; const float* sh2 = mod + 3 * 2048; const float* sc2 = mod + 4 * 2048;
    if (t < 32) lc[t] = 0;
    { const int c = t * 4; const f32x4 g = *(const f32x4*)(p.norm2_g + c), sv = *(const f32x4*)(sc2 + c), hv = *(const f32x4*)(sh2 + c); *(LAS f32x4*)(cg + c) = g * (sv + 1.0f); *(LAS f32x4*)(shl + c) = hv; }
    const int pr = t >> 8, pc = t & 255;
    u32x4 pre[8];
#pragma unroll
    for (int i = 0; i < 8; ++i) pre[i] = *(const u32x4*)(X1 + (size_t)(blockIdx.x * 64 + pr + 2 * i) * 2048 + pc * 8);
#pragma unroll 1
    for (int it = 0; it < 4; ++it) {
        const int row0 = blockIdx.x * 64 + it * 16;
#pragma unroll
        for (int i = 0; i < 8; ++i) *(LAS u32x4*)(lds + RT_XR + (pr + 2 * i) * RT_XSTRIDE + pc * 16) = pre[i];
        __syncthreads();
        if (it < 3) {
#pragma unroll
            for (int i = 0; i < 8; ++i) pre[i] = *(const u32x4*)(X1 + (size_t)(row0 + 16 + pr + 2 * i) * 2048 + pc * 8); }
#pragma unroll
        for (int rr = 0; rr < 2; ++rr) { const int r = wid * 2 + rr; float ss = 0.f;
#pragma unroll
            for (int i = 0; i < 4; ++i) { const u32x4 v = *(const LAS u32x4*)(lds + RT_XR + r * RT_XSTRIDE + (i * 64 + lane) * 16);
                ss += bflo(v.x) * bflo(v.x) + bfhi(v.x) * bfhi(v.x) + bflo(v.y) * bflo(v.y) + bfhi(v.y) * bfhi(v.y) + bflo(v.z) * bflo(v.z) + bfhi(v.z) * bfhi(v.z) + bflo(v.w) * bflo(v.w) + bfhi(v.w) * bfhi(v.w); }
            ss = wave_sum(ss, lane); if (lane == 0) rstd[r] = rsqrtf(ss * (1.0f / 2048.0f) + 1e-6f); }
        __syncthreads();
        f32x4 acc[2]; acc[0] = (f32x4){0.f, 0.f, 0.f, 0.f}; acc[1] = acc[0];
        const float rs = rstd[l15];
        bf16x8 Bc[4], Bn[4]; u32x2 f8w[8];
#define RT_LOADB(B, s_) do { const int _k0 = wid * 256 + (s_) * 32 + 8 * g4; _Pragma("unroll") for (int nt = 0; nt < 2; ++nt) { \
            B[nt * 2] = *(const bf16x8*)(WRT + (size_t)(nt * 16 + l15) * 2048 + _k0); B[nt * 2 + 1] = *(const bf16x8*)(WRT + (size_t)(32 + nt * 16 + l15) * 2048 + _k0); } } while (0)
        RT_LOADB(Bc, 0);
#pragma unroll
        for (int s = 0; s < 8; ++s) { const int k0 = wid * 256 + s * 32 + 8 * g4;
            if (s + 1 < 8) RT_LOADB(Bn, s + 1);
            const u32x4 xw = *(const LAS u32x4*)(lds + RT_XR + l15 * RT_XSTRIDE + k0 * 2);
            const f32x4 x0 = (f32x4){bflo(xw.x), bfhi(xw.x), bflo(xw.y), bfhi(xw.y)}, x1 = (f32x4){bflo(xw.z), bfhi(xw.z), bflo(xw.w), bfhi(xw.w)};
            const f32x4 ca = *(const LAS f32x4*)(cg + k0), cb = *(const LAS f32x4*)(cg + k0 + 4), ha = *(const LAS f32x4*)(shl + k0), hb = *(const LAS f32x4*)(shl + k0 + 4);
            const f32x4 u0 = x0 * rs * ca + ha, u1 = x1 * rs * cb + hb;
            u32x4 hi; hi.x = cvt_pk_bf16(u0[0], u0[1]); hi.y = cvt_pk_bf16(u0[2], u0[3]); hi.z = cvt_pk_bf16(u1[0], u1[1]); hi.w = cvt_pk_bf16(u1[2], u1[3]);
            f8w[s].x = cvt4_fp8_sat(u0[0] * FP8_ASCALE, u0[1] * FP8_ASCALE, u0[2] * FP8_ASCALE, u0[3] * FP8_ASCALE); f8w[s].y = cvt4_fp8_sat(u1[0] * FP8_ASCALE, u1[1] * FP8_ASCALE, u1[2] * FP8_ASCALE, u1[3] * FP8_ASCALE);
            u32x4 lo; lo.x = cvt_pk_bf16(u0[0] - bflo(hi.x), u0[1] - bfhi(hi.x)); lo.y = cvt_pk_bf16(u0[2] - bflo(hi.y), u0[3] - bfhi(hi.y));
            lo.z = cvt_pk_bf16(u1[0] - bflo(hi.z), u1[1] - bfhi(hi.z)); lo.w = cvt_pk_bf16(u1[2] - bflo(hi.w), u1[3] - bfhi(hi.w));
            bf16x8 Ah, Al; __builtin_memcpy(&Ah, &hi, 16); __builtin_memcpy(&Al, &lo, 16);
#pragma unroll
            for (int nt = 0; nt < 2; ++nt) { const bf16x8 Bh = Bc[nt * 2], Bl = Bc[nt * 2 + 1];
                acc[nt] = __builtin_amdgcn_mfma_f32_16x16x32_bf16(Ah, Bh, acc[nt], 0, 0, 0); acc[nt] = __builtin_amdgcn_mfma_f32_16x16x32_bf16(Ah, Bl, acc[nt], 0, 0, 0); acc[nt] = __builtin_amdgcn_mfma_f32_16x16x32_bf16(Al, Bh, acc[nt], 0, 0, 0); }
#pragma unroll
            for (int q = 0; q < 4; ++q) Bc[q] = Bn[q]; }
#undef RT_LOADB
#pragma unroll
        for (int s = 0; s < 8; ++s) *(u32x2*)(U2 + (size_t)(row0 + l15) * 2048 + wid * 256 + s * 32 + 8 * g4) = f8w[s];
#pragma unroll
        for (int nt = 0; nt < 2; ++nt)
#pragma unroll
            for (int r = 0; r < 4; ++r) red[(wid * 16 + 4 * g4 + r) * 32 + nt * 16 + l15] = acc[nt][r];
        __syncthreads();
        { const int tok = t >> 5, e = t & 31; float s = p.b_router[e];
#pragma unroll
          for (int w = 0; w < 8; ++w) s += red[(w * 16 + tok) * 32 + e];
          lg[(it * 16 + tok) * 33 + e] = s; }
    }
    __syncthreads();
    if (t < 64) { float v[4]; int ix[4];
#pragma unroll
        for (int k = 0; k < 4; ++k) { float best = -3.0e38f; int bi = 0;
            for (int e = 0; e < 32; ++e) { const float x = lg[t * 33 + e]; bool taken = false;
#pragma unroll
                for (int k2 = 0; k2 < 4; ++k2) taken = taken || (k2 < k && ix[k2] == e);
                if (!taken && x > best) { best = x; bi = e; } }
            v[k] = best; ix[k] = bi; }
        const float e1 = __expf(v[1] - v[0]), e2 = __expf(v[2] - v[0]), e3 = __expf(v[3] - v[0]), inv = 1.0f / (1.0f + e1 + e2 + e3);
        se[t * 4 + 0] = ix[0]; se[t * 4 + 1] = ix[1]; se[t * 4 + 2] = ix[2]; se[t * 4 + 3] = ix[3];
        sp[t * 4 + 0] = inv; sp[t * 4 + 1] = e1 * inv; sp[t * 4 + 2] = e2 * inv; sp[t * 4 + 3] = e3 * inv; }
    __syncthreads();
    if (t < 256) sr[t] = atomicAdd((int*)&lc[se[t]], 1);
    __syncthreads();
    if (t < 32) lbase[t] = (int)atomicAdd((unsigned*)(p.ws + WS_CTRL + CTRL_CNT) + t, (unsigned)lc[t]);
    __syncthreads();
    if (t < 256) { const int e = se[t], pos = lbase[e] + sr[t], tok = blockIdx.x * 64 + (t >> 2);
        ((int*)(p.ws + WS_LIST))[e * 16384 + pos] = tok; ((float*)(p.ws + WS_LPROB))[tok * 4 + (t & 3)] = sp[t];
        ((int*)(p.ws + WS_TKE))[tok * 4 + (t & 3)] = e; ((int*)(p.ws + WS_TKP))[tok * 4 + (t & 3)] = pos; }
    __syncthreads();
}

__device__ __forceinline__ MoeTables moe_tables(const Params& p, LAS unsigned char* lds_tab, int wv) {
    const int t = make_tid(wv);
    LAS int* tp = (LAS int*)lds_tab; LAS int* cnt = tp + 64;
    const unsigned* gc = (const unsigned*)(p.ws + WS_CTRL + CTRL_CNT);
    if (t < 64) {
        const int cv = t < 32 ? (int)__hip_atomic_load(gc + t, __ATOMIC_RELAXED, __HIP_MEMORY_SCOPE_AGENT) : 0;
        int inc = (cv + 255) >> 8;
#pragma unroll
        for (int o = 1; o < 32; o <<= 1) { const int n = __builtin_amdgcn_ds_bpermute((t - o) << 2, inc); if (t >= o) inc += n; }
        if (t < 32) { cnt[t] = cv; tp[t] = inc - ((cv + 255) >> 8); }
        if (t == 31) tp[32] = inc; }
    __syncthreads();
    MoeTables T; T.tp = tp; T.cnt = cnt; T.rows = (LAS const unsigned short*)(tp + 128); T.bias = (LAS const unsigned char*)(tp + 128) + 9216; T.utab = tp + 128 + 18 * 256; return T;
}
template <class Sched> __device__ __forceinline__ void moe_unit_table(const Sched& S, const MoeTables& T, int wv) {
    const int t = make_tid(wv); __syncthreads();
    if (t < 36) { int o[5]; if (S.decode(t, o)) { LAS int* r = (LAS int*)T.utab + t * 8; r[0] = o[0]; r[1] = o[1]; r[2] = o[2]; r[3] = o[3]; r[4] = o[4]; } }
    __syncthreads();
}
template <class Sched> __device__ __forceinline__ void moe_rows_preload(const Params& p, const Sched& S, const MoeTables& T, int wv) {
    const int t = make_tid(wv); LAS unsigned short* rows = (LAS unsigned short*)T.rows; LAS bf16_t* bias = (LAS bf16_t*)T.bias;
    int lv[9]; float bv[9];
#pragma unroll
    for (int j = 0; j < 9; ++j) { const int i = t + NTHR * j, ui = i >> 8, tt = i & 255; LAS const int* r = T.utab + ui * 8;
        const bool ok = ui * NWG + S.c < S.nwg; const int g = ok ? r[0] : 0, pm = ok ? r[1] : 0, pn = ok ? r[2] : 0, cn = ok ? r[4] : 0, q = pm * 256 + tt;
        lv[j] = (q < cn) ? ((const int*)(p.ws + WS_LIST))[g * 16384 + q] : 0;
        bv[j] = p.b_gu[(size_t)g * 4096 + (tt < 128 ? 0 : 2048 - 128) + pn * 128 + tt]; }
#pragma unroll
    for (int j = 0; j < 9; ++j) { const int i = t + NTHR * j; rows[i] = (unsigned short)lv[j]; bias[i] = f2bf(bv[j]); }
    __syncthreads();
}
template <class Sched> __device__ __forceinline__ void moe_bias_preload2(const Params& p, const Sched& S, const MoeTables& T, int wv) {
    const int t = make_tid(wv); LAS float* bias = (LAS float*)T.rows;
    float bv[5];
#pragma unroll
    for (int j = 0; j < 5; ++j) { const int i = t + NTHR * j, ui = i >> 8, tt = i & 255; LAS const int* r = T.utab + ui * 8;
        const bool ok = ui < 9 && ui * NWG + S.c < S.nwg; const int g = ok ? r[0] : 0, pn = ok ? r[2] : 0;
        bv[j] = p.b_down[(size_t)g * 2048 + pn * 256 + tt]; }
#pragma unroll
    for (int j = 0; j < 5; ++j) { const int i = t + NTHR * j; if (i < 9 * 256) bias[i] = bv[j]; }
    __syncthreads();
}

#define FIN_LOAD(W, X, PK, row) do { \
    _Pragma("unroll") for (int k = 0; k < 4; ++k) { const int e = tke[(row) * 4 + k], pos = tkp[(row) * 4 + k]; const size_t sr = (size_t)(T.tp[e] * 256 + pos) * 2048; PK[k] = lpk[(row) * 4 + k] * (1.0f / FP8_YSCALE); \
        _Pragma("unroll") for (int j = 0; j < 4; ++j) W[k][j] = *(const u32x2*)(O2 + sr + (j * 64 + lane) * 8); } \
    _Pragma("unroll") for (int j = 0; j < 4; ++j) { const int col = (j * 64 + lane) * 8; X[j] = *(const u32x4*)(X1 + (size_t)(row) * 2048 + col); } } while (0)
#define FIN_COMPUTE(W, X, PK, row) do { \
    f32x4 v[4][2]; float ss = 0.f; \
    _Pragma("unroll") for (int j = 0; j < 4; ++j) { const int col = (j * 64 + lane) * 8; f32x4 m0 = (f32x4){0.f, 0.f, 0.f, 0.f}, m1 = m0; \
        _Pragma("unroll") for (int k = 0; k < 4; ++k) { const u32x2 w = W[k][j]; const float pk = PK[k]; \
            const f32x2 a0 = __builtin_amdgcn_cvt_pk_f32_fp8((int)w.x, false), a1 = __builtin_amdgcn_cvt_pk_f32_fp8((int)w.x, true), a2 = __builtin_amdgcn_cvt_pk_f32_fp8((int)w.y, false), a3 = __builtin_amdgcn_cvt_pk_f32_fp8((int)w.y, true); \
            m0[0] += pk * a0[0]; m0[1] += pk * a0[1]; m0[2] += pk * a1[0]; m0[3] += pk * a1[1]; \
            m1[0] += pk * a2[0]; m1[1] += pk * a2[1]; m1[2] += pk * a3[0]; m1[3] += pk * a3[1]; } \
        const f32x4 g0 = GG[j][0], g1 = GG[j][1]; \
        v[j][0] = (f32x4){bflo(X[j].x), bfhi(X[j].x), bflo(X[j].y), bfhi(X[j].y)} + g0 * m0; v[j][1] = (f32x4){bflo(X[j].z), bfhi(X[j].z), bflo(X[j].w), bfhi(X[j].w)} + g1 * m1; \
        _Pragma("unroll") for (int e = 0; e < 4; ++e) ss += v[j][0][e] * v[j][0][e] + v[j][1][e] * v[j][1][e]; } \
    ss = wave_sum(ss, lane); const float rstd = rsqrtf(ss * (1.0f / 2048.0f) + 1e-6f); \
    _Pragma("unroll") for (int j = 0; j < 4; ++j) { const int col = (j * 64 + lane) * 8; const f32x4 f0 = FG[j][0], f1 = FG[j][1]; \
        *(f32x4*)(p.out + (size_t)(row) * 2048 + col) = v[j][0] * rstd * f0; *(f32x4*)(p.out + (size_t)(row) * 2048 + col + 4) = v[j][1] * rstd * f1; } } while (0)
__device__ __forceinline__ void phase_final(const Params& p, const MoeTables& T, int wv) {
    const int t = make_tid(wv);
    const int lane = t & 63, wid = t >> 6, row0 = blockIdx.x * 64 + wid * 8;
    const bf16_t* X1 = (const bf16_t*)(p.ws + WS_X1); const unsigned char* O2 = p.ws + WS_OUT2; const float* lpk = (const float*)(p.ws + WS_LPROB);
    const int* tke = (const int*)(p.ws + WS_TKE); const int* tkp = (const int*)(p.ws + WS_TKP);
    f32x4 GG[4][2], FG[4][2];
    { const float* g2 = (const float*)(p.ws + WS_MOD) + (size_t)(row0 >> 11) * 12288 + 5 * 2048;
#pragma unroll
      for (int j = 0; j < 4; ++j) { const int col = (j * 64 + lane) * 8; GG[j][0] = *(const f32x4*)(g2 + col); GG[j][1] = *(const f32x4*)(g2 + col + 4); FG[j][0] = *(const f32x4*)(p.final_g + col); FG[j][1] = *(const f32x4*)(p.final_g + col + 4); } }
    u32x2 wa[4][4], wb[4][4]; u32x4 xa[4], xb[4]; float pa[4], pb[4];
    FIN_LOAD(wa, xa, pa, row0);
#pragma unroll 1
    for (int i = 0; i < 8; i += 2) {
        FIN_LOAD(wb, xb, pb, row0 + i + 1);
        FIN_COMPUTE(wa, xa, pa, row0 + i);
        if (i + 2 < 8) FIN_LOAD(wa, xa, pa, row0 + i + 2);
        FIN_COMPUTE(wb, xb, pb, row0 + i + 1);
    }
}
#ifndef DEV_STAGE
#define DEV_STAGE 9
#endif
#ifndef MOE_ALIGN
#define MOE_ALIGN true
#endif
#ifndef DBL
#define DBL -1
#endif
#define REP(k) for (int _rep = 0; _rep < ((DBL == (k)) ? 2 : 1); ++_rep)
__device__ __forceinline__ void phase_final_simple(const Params& p, const float* src, int wv) {
    const int t = make_tid(wv), lane = t & 63, wid = t >> 6;
    for (int i = 0; i < 8; ++i) { const int row = blockIdx.x * 64 + wid * 8 + i; f32x4 v[8]; float ss = 0.f;
#pragma unroll
        for (int j = 0; j < 8; ++j) { v[j] = *(const f32x4*)(src + (size_t)row * 2048 + (j * 64 + lane) * 4); ss += v[j][0] * v[j][0] + v[j][1] * v[j][1] + v[j][2] * v[j][2] + v[j][3] * v[j][3]; }
        ss = wave_sum(ss, lane); const float rstd = rsqrtf(ss * (1.0f / 2048.0f) + 1e-6f);
#pragma unroll
        for (int j = 0; j < 8; ++j) { const int col = (j * 64 + lane) * 4; *(f32x4*)(p.out + (size_t)row * 2048 + col) = v[j] * rstd * *(const f32x4*)(p.final_g + col); } }
}

__global__ void __launch_bounds__(512, 2) fwd_kernel(Params p) {
    extern __shared__ __attribute__((aligned(16))) unsigned char smem[];
    LAS unsigned char* lds = (LAS unsigned char*)smem;
    volatile LAS unsigned* xbw = (volatile LAS unsigned*)(lds + LDS_BYTES - 16);
    const int wv = __builtin_amdgcn_readfirstlane(threadIdx.x >> 6);
    const bool t0 = (wv == 0 && lane_id() == 0);
    if (t0) { xbw[0] = 0u; xbw[1] = 0u; xbw[2] = 0u; xbw[3] = 0u; }
    __syncthreads();
    XcdBarrier bar = xcd_barrier_post((unsigned*)(p.ws + WS_CTRL), xbw, t0);
    const int c = blockIdx.x;

    phase0(p, lds, wv);
#if DBL == 0
    phase0(p, lds, wv);
#elif DBL > 1000
    phase0<DBL - 1000>(p, lds, wv);
#endif
    xcd_barrier(bar, wv);
    REP(1) phase1(p, lds, wv);
    xcd_barrier(bar, wv);
#if DEV_STAGE == 1
    phase_final_simple(p, p.x, wv);
#else
    if (c < G_INPROJ) { SchedInProj S; S.ws = p.ws; S.c = c; EpiInProj E; E.ws = p.ws; pg8::gemm_phase<EpiInProj, SchedInProj, INPROJ_FP8 ? 1024 : 2048, INPROJ_FP8 ? 1024 : 2048, false, INPROJ_FP8 != 0>(lds, S, E, wv); }
#ifndef STEAL
#define STEAL 1
#endif
#if STEAL
    p0_f8_steal(p, (LAS unsigned*)lds, (LAS unsigned*)(lds + 150000), make_tid(wv), F8_P0 * NWG);
#else
    if (c >= G_INPROJ) { const int first = c - G_INPROJ, stride = NWG - G_INPROJ; p0_f8_range(p, (LAS unsigned*)lds, make_tid(wv), first, stride, (F8_P0 * NWG - first + stride - 1) / stride); }
#endif
    xcd_barrier(bar, wv);
    REP(3) { { SchedS5V S; S.ws = p.ws; S.c = c; EpiS5V E; E.ws = p.ws; pg8::gemm_phase<EpiS5V, SchedS5V, 256, 512, false>(lds, S, E, wv); }
    phase_conv(p, lds, wv); }
#if DBL == 31
    { SchedS5V S; S.ws = p.ws; S.c = c; EpiS5V E; E.ws = p.ws; pg8::gemm_phase<EpiS5V, SchedS5V, 256, 512, false>(lds, S, E, wv); }
#elif DBL == 32
    phase_conv(p, lds, wv);
#endif
    xcd_barrier(bar, wv);
#if DEV_STAGE >= 3
    phase_mlstm(p, lds, wv);
#if DBL == 4
    phase_s5scan(p, wv); phase_mlstm(p, lds, wv);
#endif
#endif
    xcd_barrier(bar, wv);
    REP(5) { { SchedS5Y S; S.ws = p.ws; S.c = c; EpiS5Y E; E.ws = p.ws; E.s5_d = p.s5_d; pg8::gemm_phase<EpiS5Y, SchedS5Y, 512, 512, false>(lds, S, E, wv); }
    phase_hmerge(p, wv); }
#if DBL == 51
    { SchedS5Y S; S.ws = p.ws; S.c = c; EpiS5Y E; E.ws = p.ws; E.s5_d = p.s5_d; pg8::gemm_phase<EpiS5Y, SchedS5Y, 512, 512, false>(lds, S, E, wv); }
#elif DBL == 52
    phase_hmerge(p, wv);
#endif
    xcd_barrier(bar, wv);
    REP(6) { SchedStatic<4> S; S.A = (const char*)(p.ws + WS_SBUF); S.Bt = (const char*)(p.ws + WS_WGLU_T); S.c = c; S.a_tile_bytes = (size_t)256 * 32; S.b_tile_bytes = (size_t)256 * 1024 * 2;
      EpiGLU E; E.ws = p.ws; pg8::gemm_phase<EpiGLU, SchedStatic<4>, 1024, 1024, false, false, 0, true, true>(lds, S, E, wv); }
    xcd_barrier(bar, wv);
    REP(7) { SchedStatic<8> S; S.A = (const char*)(p.ws + WS_CAT); S.Bt = (const char*)(p.ws + WS_WOUT_T); S.c = c; S.a_tile_bytes = (size_t)256 * 2048; S.b_tile_bytes = (size_t)256 * 2048;
      EpiOut E; E.ws = p.ws; E.x = p.x; pg8::gemm_phase<EpiOut, SchedStatic<8>, 1024, 1024, false, true>(lds, S, E, wv); }
#if DBL == 70 || DBL == 71
    xcd_barrier(bar, wv);
    { SchedProbe<8, DBL == 71> S; S.A = (const char*)(p.ws + WS_CAT); S.Bt = (const char*)(p.ws + WS_WOUT_T); S.c = c; S.a_tile_bytes = (size_t)256 * 2048; S.b_tile_bytes = (size_t)256 * 2048;
      EpiOutDummy E; E.ws = p.ws; E.x = p.x; pg8::gemm_phase<EpiOutDummy, SchedProbe<8, DBL == 71>, 1024, 1024, false, true>(lds, S, E, wv); }
#endif
    xcd_barrier(bar, wv);
#if DEV_STAGE < 9
    phase_final_simple(p, (const float*)(p.ws + WS_X1), wv);
#else
    phase_router(p, lds, wv);
    xcd_barrier(bar, wv);
    const MoeTables T = moe_tables(p, lds + 139264, wv);
    { SchedMoE<16> S; S.ws = p.ws; S.c = c; S.T = T; S.A = (const char*)(p.ws + WS_U2); S.Bt = (const char*)(p.ws + WS_WGU_T); S.b_expert_bytes = (size_t)4096 * 2048; S.nwg = __builtin_amdgcn_readfirstlane(T.tp[32]) * 16; moe_unit_table(S, T, wv); moe_rows_preload(p, S, T, wv);
      EpiMoE1 E; E.ws = p.ws; E.b_gu = p.b_gu; E.T = T; pg8::gemm_phase<EpiMoE1, SchedMoE<16>, 1024, 1024, true, true, 0, MOE_ALIGN>(lds, S, E, wv); }
#if DBL == 9
    { SchedMoE<16> S; S.ws = p.ws; S.c = c; S.T = T; S.A = (const char*)(p.ws + WS_U2); S.Bt = (const char*)(p.ws + WS_WGU_T); S.b_expert_bytes = (size_t)4096 * 2048; S.nwg = __builtin_amdgcn_readfirstlane(T.tp[32]) * 16; moe_unit_table(S, T, wv); moe_rows_preload(p, S, T, wv);
      EpiMoE1 E; E.ws = p.ws; E.b_gu = p.b_gu; E.T = T; pg8::gemm_phase<EpiMoE1, SchedMoE<16>, 1024, 1024, true, true, 0, MOE_ALIGN>(lds, S, E, wv); }
#endif
    xcd_barrier(bar, wv);
    REP(10) { SchedMoE2 S; S.ws = p.ws; S.c = c; S.T = T; S.A = (const char*)(p.ws + WS_HID); S.Bt = (const char*)(p.ws + WS_WDN_T); S.b_expert_bytes = (size_t)2048 * 2048; S.nwg = __builtin_amdgcn_readfirstlane(T.tp[32]) * 8; moe_unit_table(S, T, wv); moe_bias_preload2(p, S, T, wv);
      EpiMoE2 E; E.ws = p.ws; E.b_down = p.b_down; E.T = T; E.T.bias = (LAS const unsigned char*)T.rows; pg8::gemm_phase<EpiMoE2, SchedMoE2, 1024, 1024, false, true, 1, MOE_ALIGN>(lds, S, E, wv, (float*)(p.ws + WS_CTRL + 32768)); }
    xcd_barrier(bar, wv);
    REP(11) phase_final(p, T, wv);
#if PROBE_GEMM == 1
    xcd_barrier(bar, wv);
    { const float* dg = (const float*)(p.ws + WS_CTRL + 32768); const float A = dg[PROBE_A], B = dg[PROBE_B]; for (size_t i = (size_t)blockIdx.x * NTHR + make_tid(wv); i < (size_t)NLAT * D; i += (size_t)NWG * NTHR) p.out[i] = (i == 0) ? A : B; }
#endif
#endif
#endif
}

extern "C" void kernel_launch(void* const* d_in, const int* in_sizes, int n_in, void* d_out, int out_size, void* d_ws, size_t ws_size, hipStream_t stream) {
    static int ready = 0;
    if (ready == 0) {
        if (n_in != 29 || out_size != NLAT * D || ws_size < WS_END) { fprintf(stderr, "kernel_launch: unexpected shapes (n_in %d out %d ws %zu need %zu)\n", n_in, out_size, ws_size, (size_t)WS_END); ready = -1; return; }
        if (hipFuncSetAttribute((const void*)fwd_kernel, hipFuncAttributeMaxDynamicSharedMemorySize, LDS_BYTES) != hipSuccess) { fprintf(stderr, "kernel_launch: hipFuncSetAttribute failed\n"); ready = -1; return; }
        ready = 1;
    }
    if (ready < 0) return;
    (void)hipMemsetAsync((char*)d_ws + WS_CTRL, 0, CTRL_BYTES, stream);
    Params p;
    memset(&p, 0, sizeof(p));
    const float** f = (const float**)&p;
    for (int i = 0; i < 29; ++i) f[i] = (const float*)d_in[i];
    p.out = (float*)d_out; p.ws = (unsigned char*)d_ws;
    hipLaunchKernelGGL(fwd_kernel, dim3(NWG), dim3(NTHR), LDS_BYTES, stream, p);
}
```

```cpp
#include <hip/hip_runtime.h>
#include <stdint.h>
#include <stdio.h>
#include <string.h>

#define LAS __attribute__((address_space(3)))
typedef unsigned short bf16_t;
typedef short bf16x8 __attribute__((ext_vector_type(8)));
typedef short s16x4 __attribute__((ext_vector_type(4)));
typedef float f32x4 __attribute__((ext_vector_type(4)));
typedef float f32x2 __attribute__((ext_vector_type(2)));
typedef unsigned u32x4 __attribute__((ext_vector_type(4)));
typedef unsigned u32x2 __attribute__((ext_vector_type(2)));

constexpr int D = 2048, NB = 8, SEQ = 2048, CTXL = 256;
constexpr int NLAT = NB * SEQ;
constexpr int NCTX = NB * CTXL;
constexpr int NTOK = NLAT + NCTX;
constexpr int DIN = 4112;
constexpr int NE = 32, TOPK = 4, DFF = 2048;
constexpr int NWG = 256, NTHR = 512;
constexpr int LDS_BYTES = 163840;
constexpr int MOE_ROWS = 73728;

constexpr size_t al256(size_t x) { return (x + 255) & ~(size_t)255; }
constexpr size_t WS_CTRL  = 0;
constexpr size_t CTRL_BYTES = 65536;
constexpr size_t CTRL_CNT = 16384;
constexpr int MODKS = 16;
constexpr size_t WS_MODP  = WS_CTRL + CTRL_BYTES;
constexpr size_t WS_MOD   = WS_MODP + (size_t)MODKS * 9 * 12288 * 4;
constexpr size_t WS_LB16  = WS_MOD + (size_t)9 * 12288 * 4;
constexpr size_t WS_WRT   = WS_LB16 + 65536;
constexpr size_t WS_WIN_T = WS_WRT + 262144;
constexpr size_t WS_WGLU_T = WS_WIN_T + (size_t)4096 * 2048 * 2;
constexpr size_t WS_WOUT_T = WS_WGLU_T + (size_t)1024 * 1024 * 2;
constexpr size_t WS_BTV   = WS_WOUT_T + (size_t)2048 * 2048 * 2;
constexpr size_t WS_BTY   = WS_BTV + (size_t)64 * 256 * 256 * 2;
constexpr size_t WS_U1    = WS_BTY + (size_t)64 * 256 * 512 * 2;
constexpr size_t WS_GATES = WS_U1 + (size_t)NTOK * 2048 * 2;
constexpr size_t WS_ZQK   = WS_GATES + (size_t)NTOK * 16 * 4;
constexpr size_t WS_QK    = WS_ZQK + (size_t)NTOK * 1024 * 2;
constexpr size_t WS_VBUF  = WS_QK + (size_t)NTOK * 1024 * 2;
constexpr size_t WS_OBUF  = WS_VBUF + (size_t)NTOK * 1024 * 2;
constexpr size_t WS_AS5   = WS_OBUF + (size_t)NLAT * 1024 * 2;
constexpr size_t WS_VS5   = WS_AS5 + (size_t)64 * 1280 * 512 * 2;
constexpr size_t WS_HBUF  = WS_VS5 + (size_t)64 * 1280 * 256 * 4;
constexpr size_t WS_SBUF  = WS_HBUF + (size_t)2 * NLAT * 1024 * 4;
constexpr size_t WS_CAT   = WS_SBUF + (size_t)NLAT * 1024 * 2;
constexpr size_t WS_X1    = WS_CAT + (size_t)NLAT * 2048 * 2;
constexpr size_t WS_U2    = WS_X1 + (size_t)NLAT * 2048 * 4;
constexpr size_t WS_TKE   = WS_U2 + (size_t)NLAT * 2048 * 2;
constexpr size_t WS_TKP   = WS_TKE + (size_t)NLAT * 16;
constexpr size_t WS_LIST  = WS_TKP + (size_t)NLAT * 16;
constexpr size_t WS_LPROB = WS_LIST + (size_t)32 * 16384 * 4;
constexpr size_t WS_HID   = WS_LPROB + (size_t)32 * 16384 * 4;
constexpr size_t WS_OUT2  = WS_HID + (size_t)MOE_ROWS * 2048 * 2;
constexpr size_t WS_WGU_T = WS_OUT2 + (size_t)MOE_ROWS * 2048 * 2;
constexpr size_t WS_WDN_T = WS_WGU_T + (size_t)32 * 4096 * 2048 * 2;
constexpr size_t WS_END   = WS_WDN_T + (size_t)32 * 2048 * 2048 * 2;

struct Params {
    const float *x, *c, *ctx, *c_ctx, *w_ada, *b_ada, *norm1_g, *w_in, *conv_qk, *gate_bias, *head_g,
                *lam_re, *lam_im, *log_dt, *b_re, *b_im, *c_re, *c_im, *s5_d, *w_glu, *w_out, *norm2_g,
                *w_router, *b_router, *w_gu, *b_gu, *w_down, *b_down, *final_g;
    float* out;
    unsigned char* ws;
};

__device__ __forceinline__ unsigned cvt_pk_bf16(float lo, float hi) { unsigned r; asm volatile("v_cvt_pk_bf16_f32 %0, %1, %2" : "=v"(r) : "v"(lo), "v"(hi)); return r; }
__device__ __forceinline__ unsigned cvt4_fp8_raw(float a, float b, float c, float d) { int w = 0; w = __builtin_amdgcn_cvt_pk_fp8_f32(a, b, w, false); w = __builtin_amdgcn_cvt_pk_fp8_f32(c, d, w, true); return (unsigned)w; }
__device__ __forceinline__ float sat_fp8(float x) { return __builtin_amdgcn_fmed3f(x, -448.0f, 448.0f); }
__device__ __forceinline__ unsigned cvt4_fp8(float a, float b, float c, float d) { return cvt4_fp8_raw(a, b, c, d); }
__device__ __forceinline__ unsigned cvt4_fp8_sat(float a, float b, float c, float d) { return cvt4_fp8_raw(sat_fp8(a), sat_fp8(b), sat_fp8(c), sat_fp8(d)); }
constexpr float FP8_WSCALE = 64.0f, FP8_ASCALE = 4.0f, FP8_OSCALE = 1.0f / 256.0f, FP8_YSCALE = 8.0f;
__device__ __forceinline__ bf16_t f2bf(float f) { return (bf16_t)(cvt_pk_bf16(f, 0.f) & 0xffffu); }
__device__ __forceinline__ float bf2f(bf16_t b) { return __uint_as_float(((unsigned)b) << 16); }
__device__ __forceinline__ float bflo(unsigned w) { return __uint_as_float(w << 16); }
__device__ __forceinline__ float bfhi(unsigned w) { return __uint_as_float(w & 0xffff0000u); }
__device__ __forceinline__ float bperm(float v, int srclane) { return __int_as_float(__builtin_amdgcn_ds_bpermute(srclane << 2, __float_as_int(v))); }
__device__ __forceinline__ float wave_sum(float v, int lane) {
#pragma unroll
    for (int o = 32; o >= 1; o >>= 1) v += bperm(v, lane ^ o);
    return v;
}
__device__ __forceinline__ int lane_id() { return (int)__builtin_amdgcn_mbcnt_hi(~0u, __builtin_amdgcn_mbcnt_lo(~0u, 0u)); }
__device__ __forceinline__ int make_tid(int wv) { int l; asm volatile("v_mbcnt_lo_u32_b32 %0, -1, 0\n\tv_mbcnt_hi_u32_b32 %0, -1, %0" : "=v"(l)); return wv * 64 + l; }
__device__ __forceinline__ float sigmoidf_(float x) { return __builtin_amdgcn_rcpf(1.0f + __builtin_amdgcn_exp2f(x * -1.4426950408889634f)); }
__device__ __forceinline__ s16x4 tr_read(unsigned lds_addr) { s16x4 r; asm volatile("ds_read_b64_tr_b16 %0, %1\n\ts_waitcnt lgkmcnt(0)" : "=&v"(r) : "v"(lds_addr) : "memory"); return r; }

#define XB_TMO      128
#define XB_XCNT(j)  (256  + 64 * (j))
#define XB_XSUB(j)  (1280 + 64 * (j))
#define XB_XGEN(j)  (2304 + 64 * (j))
#define XB_TOP      3328
#define XB_TOPGEN   3392
#define XCD_BAR_WORDS 3456
#define XB_SPIN_CAP (1u << 18)

__device__ __forceinline__ unsigned xb_ld(unsigned* p)              { return __hip_atomic_load(p, __ATOMIC_RELAXED, __HIP_MEMORY_SCOPE_AGENT); }
__device__ __forceinline__ unsigned xb_add(unsigned* p, unsigned v) { return __hip_atomic_fetch_add(p, v, __ATOMIC_RELAXED, __HIP_MEMORY_SCOPE_AGENT); }
__device__ __forceinline__ unsigned xb_xcc_id() { return (unsigned)__builtin_amdgcn_s_getreg((3 << 11) | 20) & 0xFu; }
#define XB_SPIN(cond, bar) do { unsigned _sp = 0; while (cond) { __builtin_amdgcn_s_sleep(1); \
    if ((++_sp & 255u) == 0u) { if (xb_ld(&(bar)[XB_TMO])) break; if (_sp > XB_SPIN_CAP) { atomicAdd(&(bar)[XB_TMO], 1u); break; } } } } while (0)

struct XcdBarrier { unsigned* bar; unsigned x; volatile LAS unsigned* st; };

__device__ __forceinline__ XcdBarrier xcd_barrier_post(unsigned* bar, volatile LAS unsigned* st, bool t0) {
    XcdBarrier b; b.bar = bar; b.x = xb_xcc_id(); b.st = st;
    if (t0) (void)xb_add(&bar[XB_XCNT(b.x)], 1u);
    return b;
}
__device__ __forceinline__ void xcd_barrier_complete(unsigned* bar, unsigned x, unsigned& nloc, unsigned& nx) {
    const unsigned G = gridDim.x * gridDim.y * gridDim.z;
    unsigned sum, cnt, mine, sp = 0u;
    for (;;) {
        sum = 0u; cnt = 0u; mine = 0u;
#pragma unroll
        for (unsigned j = 0; j < 16; ++j) { const unsigned c = xb_ld(&bar[XB_XCNT(j)]); sum += c; cnt += (c > 0u) ? 1u : 0u; mine = (j == x) ? c : mine; }
        if (sum == G) break;
        __builtin_amdgcn_s_sleep(1);
        if ((++sp & 255u) == 0u) { if (xb_ld(&bar[XB_TMO])) break; if (sp > XB_SPIN_CAP) { atomicAdd(&bar[XB_TMO], 1u); break; } }
    }
    nloc = mine > 0u ? mine : 1u; nx = cnt > 0u ? cnt : 1u;
}
__device__ __forceinline__ void xcd_barrier(const XcdBarrier& b, int wv) {
    asm volatile("s_waitcnt vmcnt(0)" ::: "memory");
    __syncthreads();
    if (wv == 0 && lane_id() == 0) {
        unsigned* bar = b.bar;
        __builtin_amdgcn_s_waitcnt(0);
        unsigned nloc = b.st[0], nx = b.st[1];
        if (nloc == 0u) { xcd_barrier_complete(bar, b.x, nloc, nx); b.st[0] = nloc; b.st[1] = nx; }
        const unsigned old = xb_add(&bar[XB_XSUB(b.x)], 1u);
        const unsigned gen = old / nloc;
        const unsigned cnt = b.st[2];
        if (old + 1u == (gen + 1u) * nloc) {
            __builtin_amdgcn_fence(__ATOMIC_RELEASE, "agent");
            asm volatile("s_waitcnt vmcnt(0)" ::: "memory");
            const unsigned og = xb_add(&bar[XB_TOP], 1u);
            const unsigned tg = og / nx;
            if (og + 1u == (tg + 1u) * nx) xb_add(&bar[XB_TOPGEN], 1u);
            else XB_SPIN(xb_ld(&bar[XB_TOPGEN]) == tg, bar);
        } else {
            XB_SPIN(xb_ld(&bar[XB_TOPGEN]) == cnt, bar);
        }
        __builtin_amdgcn_fence(__ATOMIC_ACQUIRE, "agent");
        asm volatile("s_waitcnt vmcnt(0)" ::: "memory");
        b.st[2] = cnt + 1u;
    }
    __syncthreads();
}
#define DEV_STAGE 9
#define DBL -1
#define PROBE_GEMM 0
#define PROBE_A 0
#define PROBE_B 1
#define F8SWZ_OFF 0
#define INPROJ_FP8 1
#define STEAL 1
__device__ __forceinline__ void conv_supertile(const float* __restrict__ src, int ld_src, int srccol, int k0, bf16_t* __restrict__ dst, int K, LAS unsigned* buf, int t) {
    const int c4 = t & 63, kq = t >> 6;
    f32x4 a[4], b[4];
#pragma unroll
    for (int i = 0; i < 4; ++i) { const int kp = kq + 8 * i; const float* r = src + (size_t)(k0 + 2 * kp) * ld_src + srccol; a[i] = *(const f32x4*)r; b[i] = *(const f32x4*)(r + ld_src); }
#pragma unroll
    for (int i = 0; i < 4; ++i) { const int kp = kq + 8 * i;
#pragma unroll
        for (int j = 0; j < 4; ++j) buf[(4 * c4 + j) * 33 + kp] = cvt_pk_bf16(a[i][j], b[i][j]); }
    __syncthreads();
    const int n = t >> 1, hf = t & 1;
    bf16_t* d = dst + (size_t)n * K + k0 + 32 * hf;
#pragma unroll
    for (int q = 0; q < 4; ++q) { u32x4 o;
#pragma unroll
        for (int e = 0; e < 4; ++e) o[e] = buf[n * 33 + 16 * hf + 4 * q + e];
        *(u32x4*)(d + 8 * q) = o; }
    __syncthreads();
}

__device__ __forceinline__ void p0_gemv_item(const Params& p, int id, LAS unsigned char* lds, int t) {
    const int cb = id % 48, ks = id / 48;
    LAS float* sv = (LAS float*)lds;
    LAS float* red = sv + 9 * 256;
    for (int i = t; i < 9 * 256; i += NTHR) { const int r = i >> 8, kk = i & 255; if (kk < 128) { const float cv = (r < 8) ? p.c[r * 2048 + ks * 128 + kk] : p.c_ctx[ks * 128 + kk]; sv[i] = cv / (1.0f + __expf(-cv)); } }
    __syncthreads();
    const int col4 = t & 63, w = t >> 6;
    f32x4 acc[9];
#pragma unroll
    for (int r = 0; r < 9; ++r) acc[r] = (f32x4){0.f, 0.f, 0.f, 0.f};
    const float* wp = p.w_ada + (size_t)(ks * 128 + w) * 12288 + cb * 256 + col4 * 4;
#pragma unroll 8
    for (int i = 0; i < 16; ++i) { const f32x4 wv = *(const f32x4*)(wp + (size_t)i * 8 * 12288); const int kk = w + 8 * i;
#pragma unroll
        for (int r = 0; r < 9; ++r) acc[r] += sv[r * 256 + kk] * wv; }
#pragma unroll
    for (int r = 0; r < 9; ++r) *(LAS f32x4*)(red + (w * 9 + r) * 256 + col4 * 4) = acc[r];
    __syncthreads();
    float* modp = (float*)(p.ws + WS_MODP);
    for (int i = t; i < 9 * 256; i += NTHR) { const int r = i >> 8, col = i & 255; float s = 0.f;
#pragma unroll
        for (int ww = 0; ww < 8; ++ww) s += red[(ww * 9 + r) * 256 + col];
        modp[(size_t)(ks * 9 + r) * 12288 + cb * 256 + col] = s; }
    __syncthreads();
}

template <int CUT = 0> __device__ __forceinline__ void p0_s5_item(const Params& p, int g, LAS unsigned char* lds, int t) {
    constexpr int CCS = 34, KTS = 272;
    LAS float* LBP = (LAS float*)lds;
    LAS float* BBr = LBP + 2 * 17 * 64 * 2;
    LAS float* BBi = BBr + 2 * 64 * 16;
    LAS float* CC = BBi + 2 * 64 * 16;
    LAS float* KT = CC + 2 * 64 * CCS;
    if (t < 128) {
        const int d = t >> 6, pp = t & 63, gi = (d * 64 + g) * 64 + pp;
        const float lre = fminf(p.lam_re[gi], -1e-4f), lim = p.lam_im[gi], dt = __expf(p.log_dt[d * 64 + g]);
        const float mag = expf(lre * dt), ang = lim * dt;
        float sn, cs; sincosf(ang, &sn, &cs);
        const float lbr = mag * cs, lbi = mag * sn;
        const float den = lre * lre + lim * lim, nr = lbr - 1.0f;
        const float cre = (nr * lre + lbi * lim) / den, cim = (lbi * lre - nr * lim) / den;
        float pr = 1.f, pi = 0.f;
        for (int tau = 0; tau <= 16; ++tau) { LBP[((d * 17 + tau) * 64 + pp) * 2] = pr; LBP[((d * 17 + tau) * 64 + pp) * 2 + 1] = pi; const float nr2 = pr * lbr - pi * lbi, ni2 = pr * lbi + pi * lbr; pr = nr2; pi = ni2; }
        float* lb16 = (float*)(p.ws + WS_LB16);
        lb16[gi * 2] = LBP[((d * 17 + 16) * 64 + pp) * 2]; lb16[gi * 2 + 1] = LBP[((d * 17 + 16) * 64 + pp) * 2 + 1];
        for (int h = 0; h < 16; ++h) { const float br = p.b_re[(size_t)gi * 16 + h], bi = p.b_im[(size_t)gi * 16 + h];
            BBr[(d * 64 + pp) * 16 + h] = cre * br - cim * bi; BBi[(d * 64 + pp) * 16 + h] = cre * bi + cim * br; }
    }
    for (int i = t; i < 2 * 16 * 64; i += NTHR) { const int d = i >> 10, h = (i >> 6) & 15, pp = i & 63; const size_t gi = ((size_t)(d * 64 + g) * 16 + h) * 64 + pp;
        CC[(d * 64 + pp) * CCS + h * 2] = p.c_re[gi]; CC[(d * 64 + pp) * CCS + h * 2 + 1] = p.c_im[gi]; }
    __syncthreads();
    if (CUT == 1) return;
    { const int d = t >> 8, tau = (t >> 4) & 15, h = t & 15; f32x4 a4[4];
#pragma unroll
      for (int q = 0; q < 4; ++q) a4[q] = (f32x4){0.f, 0.f, 0.f, 0.f};
#pragma unroll 2
      for (int pp = 0; pp < 64; ++pp) { const float cr = CC[(d * 64 + pp) * CCS + h * 2], ci = CC[(d * 64 + pp) * CCS + h * 2 + 1];
          const float lr = LBP[((d * 17 + tau) * 64 + pp) * 2], li = LBP[((d * 17 + tau) * 64 + pp) * 2 + 1];
          const float wr = cr * lr - ci * li, nwi = -(cr * li + ci * lr);
          LAS const f32x4* br = (LAS const f32x4*)(BBr + (d * 64 + pp) * 16); LAS const f32x4* bi = (LAS const f32x4*)(BBi + (d * 64 + pp) * 16);
#pragma unroll
          for (int q = 0; q < 4; ++q) { a4[q] += br[q] * wr; a4[q] += bi[q] * nwi; } }
#pragma unroll
      for (int q = 0; q < 4; ++q) *(LAS f32x4*)(KT + (d * 16 + tau) * KTS + h * 16 + q * 4) = a4[q]; }
    __syncthreads();
    if (CUT == 2) return;
    unsigned* bty = (unsigned*)(p.ws + WS_BTY) + (size_t)g * 256 * 256;
    for (int i = t; i < 256 * 64; i += NTHR) { const int n = i >> 6, k8 = (i & 63) * 8, tt = n >> 4, h = n & 15; float v[8];
        if (k8 < 256) { const int s = k8 >> 4, h2 = k8 & 15; f32x4 a0 = (f32x4){0.f, 0.f, 0.f, 0.f}, a1 = a0;
            if (s <= tt) { LAS const float* kt = KT + (0 * 16 + (tt - s)) * KTS + h * 16 + h2; a0 += *(LAS const f32x4*)kt; a1 += *(LAS const f32x4*)(kt + 4); }
            if (s >= tt) { LAS const float* kt = KT + (1 * 16 + (s - tt)) * KTS + h * 16 + h2; a0 += *(LAS const f32x4*)kt; a1 += *(LAS const f32x4*)(kt + 4); }
            v[0] = a0[0]; v[1] = a0[1]; v[2] = a0[2]; v[3] = a0[3]; v[4] = a1[0]; v[5] = a1[1]; v[6] = a1[2]; v[7] = a1[3];
        } else { const int kk = k8 - 256, d = kk >> 7, reim = (kk >> 6) & 1, pp0 = kk & 63, pw = d == 0 ? tt + 1 : 16 - tt;
#pragma unroll
            for (int e = 0; e < 8; ++e) { const int pp = pp0 + e;
                const float cr = CC[(d * 64 + pp) * CCS + h * 2], ci = CC[(d * 64 + pp) * CCS + h * 2 + 1];
                const float lr = LBP[((d * 17 + pw) * 64 + pp) * 2], li = LBP[((d * 17 + pw) * 64 + pp) * 2 + 1];
                v[e] = reim == 0 ? (cr * lr - ci * li) : -(cr * li + ci * lr); } }
        u32x4 o; o.x = cvt_pk_bf16(v[0], v[1]); o.y = cvt_pk_bf16(v[2], v[3]); o.z = cvt_pk_bf16(v[4], v[5]); o.w = cvt_pk_bf16(v[6], v[7]);
        *(u32x4*)(bty + n * 256 + (k8 >> 1)) = o; }
    if (CUT == 3) { __syncthreads(); return; }
    unsigned* btv = (unsigned*)(p.ws + WS_BTV) + (size_t)g * 256 * 128;
    for (int i = t; i < 256 * 32; i += NTHR) { const int n = i >> 5, k8 = (i & 31) * 8, d = n >> 7, reim = (n >> 6) & 1, pp = n & 63, s = k8 >> 4, h2 = k8 & 15, pw = d == 0 ? 15 - s : s;
        const float lr = LBP[((d * 17 + pw) * 64 + pp) * 2], li = LBP[((d * 17 + pw) * 64 + pp) * 2 + 1];
        LAS const float* br = BBr + (d * 64 + pp) * 16 + h2; LAS const float* bi = BBi + (d * 64 + pp) * 16 + h2; float v[8];
#pragma unroll
        for (int e = 0; e < 8; ++e) v[e] = reim == 0 ? (lr * br[e] - li * bi[e]) : (lr * bi[e] + li * br[e]);
        u32x4 o; o.x = cvt_pk_bf16(v[0], v[1]); o.y = cvt_pk_bf16(v[2], v[3]); o.z = cvt_pk_bf16(v[4], v[5]); o.w = cvt_pk_bf16(v[6], v[7]);
        *(u32x4*)(btv + n * 128 + (k8 >> 1)) = o; }
    __syncthreads();
}

#ifndef INPROJ_FP8
#define INPROJ_FP8 1
#endif
constexpr int F8_TILES = 16384 + 8192, F8_PER_WG = F8_TILES / NWG  , F8_MLSTM = 36  , F8_P0 = F8_PER_WG - F8_MLSTM;
constexpr int G_INPROJ = 144;
struct TileF8 { const float* src; unsigned char* dst; int ld_src; };
__device__ __forceinline__ TileF8 p0_f8_tile(const Params& p, int j) {
    TileF8 T;
    if (j < 16384) { const int nb = j & 31, kb = (j >> 5) & 15, e = j >> 9, pnb = nb >> 1, hf = nb & 1;
        T.src = p.w_gu + (size_t)e * 2048 * 4096 + (size_t)(kb * 128) * 4096 + hf * 2048 + pnb * 128; T.ld_src = 4096;
        T.dst = p.ws + WS_WGU_T + ((size_t)e * 4096 + pnb * 256 + hf * 128) * 2048 + kb * 128; }
    else if (j >= F8_TILES + 256) { const int jj = j - F8_TILES - 256, nb = jj & 31, kb = jj >> 5, n0 = nb * 128;
        T.src = p.w_in + (size_t)(kb * 128) * DIN + (n0 < 3072 ? n0 : n0 + 16); T.ld_src = DIN;
        T.dst = p.ws + WS_WIN_T + (size_t)n0 * 2048 + kb * 128; }
    else if (j >= F8_TILES) { const int jj = j - F8_TILES, nb = jj & 15, kb = jj >> 4;
        T.src = p.w_out + (size_t)(kb * 128) * 2048 + nb * 128; T.ld_src = 2048;
        T.dst = p.ws + WS_WOUT_T + (size_t)(nb * 128) * 2048 + kb * 128; }
    else { const int jj = j - 16384, nb = jj & 15, kb = (jj >> 4) & 15, e = jj >> 8;
        T.src = p.w_down + (size_t)e * 2048 * 2048 + (size_t)(kb * 128) * 2048 + nb * 128; T.ld_src = 2048;
        T.dst = p.ws + WS_WDN_T + ((size_t)e * 2048 + nb * 128) * 2048 + kb * 128; }
    return T;
}
#define P0F8_LOAD(R, T) do { const float* _s = (T).src + (size_t)(kq * 8) * (T).ld_src + c4 * 4; _Pragma("unroll") for (int i = 0; i < 8; ++i) R[i] = *(const f32x4*)(_s + (size_t)i * (T).ld_src); } while (0)
__device__ __forceinline__ void p0_f8_to_lds(const f32x4 (&r)[8], LAS unsigned* buf, int t) {
    const int c4 = t & 31, kq = t >> 5;
#pragma unroll
    for (int j = 0; j < 4; ++j) { u32x2 w; w.x = cvt4_fp8(r[0][j] * FP8_WSCALE, r[1][j] * FP8_WSCALE, r[2][j] * FP8_WSCALE, r[3][j] * FP8_WSCALE); w.y = cvt4_fp8(r[4][j] * FP8_WSCALE, r[5][j] * FP8_WSCALE, r[6][j] * FP8_WSCALE, r[7][j] * FP8_WSCALE);
        *(LAS u32x2*)(buf + (4 * c4 + j) * 34 + 2 * kq) = w; }
}
__device__ __forceinline__ void p0_f8_store(unsigned char* dst, LAS const unsigned* buf, int t) {
    const int n = t >> 2, q = t & 3; u32x2 o[4];
#pragma unroll
    for (int e = 0; e < 4; ++e) o[e] = *(const LAS u32x2*)(buf + n * 34 + 8 * q + 2 * e);
    unsigned char* d = dst + (size_t)n * 2048 + 32 * q;
    *(u32x4*)d = (u32x4){o[0].x, o[0].y, o[1].x, o[1].y}; *(u32x4*)(d + 16) = (u32x4){o[2].x, o[2].y, o[3].x, o[3].y};
}
__device__ __forceinline__ void p0_f8_process(const f32x4 (&r)[8], unsigned char* dst, LAS unsigned* buf, int t) { p0_f8_to_lds(r, buf, t); __syncthreads(); p0_f8_store(dst, buf, t); __syncthreads(); }
__device__ __forceinline__ void p0_f8_range(const Params& p, LAS unsigned* buf, int t, int first, int stride, int count) {
    const int c4 = t & 31, kq = t >> 5;
    f32x4 ra[8], rb[8], rc[8];
    TileF8 Ta = p0_f8_tile(p, first), Tb = p0_f8_tile(p, first + stride), Tc = Ta;
    P0F8_LOAD(ra, Ta); if (count > 1) P0F8_LOAD(rb, Tb);
    for (int i = 0; i < count; i += 3) {
        if (i + 2 < count) { Tc = p0_f8_tile(p, first + stride * (i + 2)); P0F8_LOAD(rc, Tc); }
        p0_f8_process(ra, Ta.dst, buf, t);
        if (i + 3 < count) { Ta = p0_f8_tile(p, first + stride * (i + 3)); P0F8_LOAD(ra, Ta); }
        if (i + 1 < count) p0_f8_process(rb, Tb.dst, buf, t);
        if (i + 4 < count) { Tb = p0_f8_tile(p, first + stride * (i + 4)); P0F8_LOAD(rb, Tb); }
        if (i + 2 < count) p0_f8_process(rc, Tc.dst, buf, t);
    }
}

constexpr size_t CTRL_STEAL = 49152;
__device__ __forceinline__ void p0_f8_steal(const Params& p, LAS unsigned* buf, LAS unsigned* slot, int t, int total) {
    const int c4 = t & 31, kq = t >> 5;
    unsigned* counter = (unsigned*)(p.ws + WS_CTRL + CTRL_STEAL);
    unsigned pend = 0;
    if (t == 0) { const unsigned b0 = atomicAdd(counter, 3u); const unsigned b1 = atomicAdd(counter, 3u); slot[0] = b0; slot[1] = b1; }
    __syncthreads();
    int base = __builtin_amdgcn_readfirstlane((int)slot[0]);
    if (base >= total) return;
    f32x4 ra[8], rb[8], rc[8];
    TileF8 Ta = p0_f8_tile(p, base), Tb = p0_f8_tile(p, base + 1), Tc = Ta;
    P0F8_LOAD(ra, Ta); P0F8_LOAD(rb, Tb);
    for (int i = 0;; ++i) {
        if (t == 0) pend = atomicAdd(counter, 3u);
        Tc = p0_f8_tile(p, base + 2); P0F8_LOAD(rc, Tc);
        p0_f8_process(ra, Ta.dst, buf, t);
        const int nb = __builtin_amdgcn_readfirstlane((int)slot[(i + 1) & 1]);
        if (nb < total) { Ta = p0_f8_tile(p, nb); P0F8_LOAD(ra, Ta); }
        p0_f8_process(rb, Tb.dst, buf, t);
        if (nb < total) { Tb = p0_f8_tile(p, nb + 1); P0F8_LOAD(rb, Tb); }
        if (t == 0) slot[i & 1] = pend;
        p0_f8_process(rc, Tc.dst, buf, t);
        if (nb >= total) break;
        base = nb;
    }
}

constexpr int P0_GEMV = 48 * MODKS, P0_S5 = 64, P0_RT = 1;
constexpr int P0_SPECIAL = P0_GEMV + P0_S5 + P0_RT;
constexpr int P0_WIN = 16 * 32, P0_WGLU = 4 * 16, P0_WOUT = 8 * 32, P0_WGU = 32 * 16 * 32, P0_WDN = 32 * 8 * 32;
constexpr int P0_TOTAL = P0_SPECIAL + P0_WGLU + (INPROJ_FP8 ? 0 : P0_WIN);

static_assert(INPROJ_FP8 == 1 && P0_GEMV == 4 * (NWG - P0_S5), "phase0 assignment");
template <int MASK = 7> __device__ __forceinline__ void phase0(const Params& p, LAS unsigned char* lds, int wv) {
    const int t = make_tid(wv), c = blockIdx.x;
    LAS unsigned* buf = (LAS unsigned*)lds;
    if (c < P0_S5) { if (MASK & 2) p0_s5_item<(MASK >> 4)>(p, c, lds, t); }
    else {
        if (MASK & 1) for (int i = 0; i < 4; ++i) p0_gemv_item(p, (c - P0_S5) + (NWG - P0_S5) * i, lds, t);
        if ((MASK & 2) && c >= NWG - P0_WGLU) { const int j = c - (NWG - P0_WGLU), nb = j & 3, kb = j >> 2, c4 = t & 63;
            conv_supertile(p.w_glu, 1024, nb * 256 + 4 * c4, kb * 64, (bf16_t*)(p.ws + WS_WGLU_T) + (size_t)nb * 256 * 1024, 1024, buf, t); }
    }
    if ((MASK & 2) && t < 256) {
        bf16_t* wrt = (bf16_t*)(p.ws + WS_WRT);
        const int i = c * 256 + t, k = i >> 5, e = i & 31; const float w = p.w_router[i]; const bf16_t hi = f2bf(w); const bf16_t lo = f2bf(w - bf2f(hi));
        wrt[e * 2048 + k] = hi; wrt[(32 + e) * 2048 + k] = lo; }
    if (!(MASK & 4)) return;
    p0_f8_range(p, buf, t, F8_TILES + blockIdx.x, NWG, 1);
    if (INPROJ_FP8) p0_f8_range(p, buf, t, F8_TILES + 256 + blockIdx.x, NWG, 2);
}

__device__ __forceinline__ void p1_load_vecs(const Params& p, int modrow, LAS float* scv, LAS float* shv, int t) {
    const float* modp = (const float*)(p.ws + WS_MODP) + (size_t)modrow * 12288 + t * 4;
    f32x4 sh = *(const f32x4*)(p.b_ada + t * 4), sc = *(const f32x4*)(p.b_ada + 2048 + t * 4) + 1.0f;
#pragma unroll
    for (int ks = 0; ks < MODKS; ++ks) { sh += *(const f32x4*)(modp + (size_t)ks * 9 * 12288); sc += *(const f32x4*)(modp + (size_t)ks * 9 * 12288 + 2048); }
    *(LAS f32x4*)(scv + t * 4) = sc * *(const f32x4*)(p.norm1_g + t * 4); *(LAS f32x4*)(shv + t * 4) = sh;
}
__device__ __forceinline__ void p1_load(const float* __restrict__ xrow, int lane, f32x4 (&v)[8]) {
#pragma unroll
    for (int i = 0; i < 8; ++i) v[i] = *(const f32x4*)(xrow + (i * 64 + lane) * 4);
}
__device__ __forceinline__ void p1_row(const Params& p, const f32x4 (&v)[8], int urow, LAS const unsigned char* wgl, LAS const float* scv, LAS const float* shv, int lane) {
    float ss = 0.f;
#pragma unroll
    for (int i = 0; i < 8; ++i) ss += v[i][0] * v[i][0] + v[i][1] * v[i][1] + v[i][2] * v[i][2] + v[i][3] * v[i][3];
    ss = wave_sum(ss, lane);
    const float rstd = rsqrtf(ss * (1.0f / 2048.0f) + 1e-6f);
    float acc[16];
#pragma unroll
    for (int j = 0; j < 16; ++j) acc[j] = 0.f;
#if INPROJ_FP8
    unsigned char* urow_p = p.ws + WS_U1 + (size_t)urow * 2048;
#else
    bf16_t* urow_p = (bf16_t*)(p.ws + WS_U1) + (size_t)urow * 2048;
#endif
#pragma unroll
    for (int i = 0; i < 8; ++i) { const int m = i * 64 + lane;
        const f32x4 sc = *(LAS const f32x4*)(scv + m * 4), sh = *(LAS const f32x4*)(shv + m * 4);
        const f32x4 u = v[i] * rstd * sc + sh;
#if INPROJ_FP8
        *(unsigned*)(urow_p + m * 4) = cvt4_fp8_sat(u[0] * FP8_ASCALE, u[1] * FP8_ASCALE, u[2] * FP8_ASCALE, u[3] * FP8_ASCALE);
#else
        { u32x2 w; w.x = cvt_pk_bf16(u[0], u[1]); w.y = cvt_pk_bf16(u[2], u[3]); *(u32x2*)(urow_p + m * 4) = w; }
#endif
        asm volatile("" ::: "memory");
#pragma unroll
        for (int j = 0; j < 4; ++j) {
#pragma unroll
            for (int q = 0; q < 4; ++q) { const f32x4 wv = *(LAS const f32x4*)(wgl + m * 272 + j * 64 + q * 16);
                acc[q * 4 + 0] += u[j] * wv[0]; acc[q * 4 + 1] += u[j] * wv[1]; acc[q * 4 + 2] += u[j] * wv[2]; acc[q * 4 + 3] += u[j] * wv[3]; } }
    }
    float r8[8], r4[4], r2[2], r1;
    { const bool up = (lane & 32) != 0;
#pragma unroll
      for (int j = 0; j < 8; ++j) { const float keep = up ? acc[j + 8] : acc[j], send = up ? acc[j] : acc[j + 8]; r8[j] = keep + bperm(send, lane ^ 32); } }
    { const bool up = (lane & 16) != 0;
#pragma unroll
      for (int j = 0; j < 4; ++j) { const float keep = up ? r8[j + 4] : r8[j], send = up ? r8[j] : r8[j + 4]; r4[j] = keep + bperm(send, lane ^ 16); } }
    { const bool up = (lane & 8) != 0;
#pragma unroll
      for (int j = 0; j < 2; ++j) { const float keep = up ? r4[j + 2] : r4[j], send = up ? r4[j] : r4[j + 2]; r2[j] = keep + bperm(send, lane ^ 8); } }
    { const bool up = (lane & 4) != 0; const float keep = up ? r2[1] : r2[0], send = up ? r2[0] : r2[1]; r1 = keep + bperm(send, lane ^ 4); }
    r1 += bperm(r1, lane ^ 2); r1 += bperm(r1, lane ^ 1);
    if ((lane & 3) == 0) { const int gi = ((lane >> 5) & 1) * 8 + ((lane >> 4) & 1) * 4 + ((lane >> 3) & 1) * 2 + ((lane >> 2) & 1);
        float gv = 15.0f * tanhf((r1 + p.gate_bias[gi]) * (1.0f / 15.0f));
        if ((gi >> 2) & 1) gv = fminf(gv, 0.f) - log1pf(__expf(-fabsf(gv)));
        ((float*)(p.ws + WS_GATES))[(size_t)urow * 16 + gi] = gv; }
}
__device__ __forceinline__ void phase1(const Params& p, LAS unsigned char* lds, int wv) {
    const int t = make_tid(wv);
    const int lane = t & 63, wid = t >> 6, wg = blockIdx.x;
    { const float* modp = (const float*)(p.ws + WS_MODP); float* mod = (float*)(p.ws + WS_MOD);
      for (int i = wg * NTHR + t; i < 9 * 12288; i += NWG * NTHR) { const int r = i / 12288, j = i - r * 12288; float s = p.b_ada[j];
#pragma unroll
          for (int ks = 0; ks < MODKS; ++ks) s += modp[(size_t)(ks * 9 + r) * 12288 + j];
          mod[i] = s; } }
    LAS unsigned char* wgl = lds;
    LAS float* scv = (LAS float*)(lds + 139264);
    LAS float* shv = scv + 2048;
    for (int i = t; i < 2048 * 4; i += NTHR) { const int k = i >> 2, q = i & 3; *(LAS f32x4*)(wgl + (k >> 2) * 272 + (k & 3) * 64 + q * 16) = *(const f32x4*)(p.w_in + (size_t)k * DIN + 3072 + q * 4); }
    const int b = wg >> 5;
    p1_load_vecs(p, b, scv, shv, t);
    __syncthreads();
    { f32x4 va[8], vb[8]; p1_load(p.x + (size_t)(wg * 64 + wid) * 2048, lane, va);
#pragma unroll 1
      for (int r = wid; r < 64; r += 16) { const int row = wg * 64 + r;
          p1_load(p.x + (size_t)(row + 8) * 2048, lane, vb);
          p1_row(p, va, row, wgl, scv, shv, lane);
          if (r + 16 < 64) p1_load(p.x + (size_t)(row + 16) * 2048, lane, va);
          p1_row(p, vb, row + 8, wgl, scv, shv, lane); } }
    __syncthreads();
    p1_load_vecs(p, 8, scv, shv, t);
    __syncthreads();
    { const int row = wg * 8 + wid; f32x4 va[8]; p1_load(p.ctx + (size_t)row * 2048, lane, va); p1_row(p, va, NLAT + row, wgl, scv, shv, lane); }
    __syncthreads();
}
namespace pg8 {
constexpr int BM = 256, BK = 64, HALF = 128, HTB = HALF * BK * 2, STAGE_BYTES = 8 * HTB, NXCD = 8;
__host__ __device__ __forceinline__ int lds_byte(int r, int c) { const int st = (r >> 4) * 2 + (c >> 5), rr = r & 15, cc = c & 31, ob = rr * 64 + cc * 2; return st * 1024 + (ob ^ (((ob >> 9) & 1) << 5)); }
__host__ __device__ __forceinline__ void stage_rc(int b, int& R, int& C) { const int st = b / 1024, sb = b % 1024, swz = sb ^ (((sb >> 9) & 1) << 5); R = (st >> 1) * 16 + swz / 64; C = (st & 1) * 32 + (swz % 64) / 2; }
__host__ __device__ __forceinline__ int perm32(int rho) { const int n = rho >> 4, i = rho & 15; return 8 * (i >> 2) + 4 * n + (i & 3); }
#ifndef F8SWZ_OFF
#define F8SWZ_OFF 0
#endif
__host__ __device__ __forceinline__ int f8swz(int r) { if (F8SWZ_OFF) return 0; const int q = (r >> 1) & 7; return q ^ ((((q + 2) >> 2) & 1) << 1); }
__host__ __device__ __forceinline__ int lds_byte8(int r, int s) { return (r >> 4) * 2048 + (r & 15) * 128 + 16 * (s ^ f8swz(r & 15)); }
__host__ __device__ __forceinline__ void stage_rc8(int b, int& R, int& C) { const int blk = b >> 11, p = b & 2047, rr = p >> 7; R = blk * 16 + rr; C = 8 * (((p >> 4) & 7) ^ f8swz(rr)); }
struct Unit { int pm, pn, g, rb, cn, ui; };
__device__ __forceinline__ int xcd_chunk(int L, int nwg) { const int q = nwg / NXCD, r = nwg % NXCD, xcd = L % NXCD, off = L / NXCD; return (xcd < r ? xcd * (q + 1) : r * (q + 1) + (xcd - r) * q) + off; }

__device__ __forceinline__ const char* uni_ptr(const char* p) { const unsigned lo = __builtin_amdgcn_readfirstlane((unsigned)(size_t)p), hi = __builtin_amdgcn_readfirstlane((unsigned)((size_t)p >> 32)); return (const char*)(((size_t)hi << 32) | lo); }
typedef int i32x8 __attribute__((ext_vector_type(8)));
typedef int i32x4 __attribute__((ext_vector_type(4)));
#ifndef PROBE_GEMM
#define PROBE_GEMM 0
#endif
template <class Epi, class Sched, int K, int LDA, bool GATHER, bool FP8 = false, int PRB = 0, bool ALIGN_EPI = true, bool ABLK = false>
__device__ __forceinline__ void gemm_phase(LAS unsigned char* lds, const Sched& S, const Epi& E, int wv, float* diag = nullptr) {
    unsigned long long pk = 0, pe = 0, pt = 0;
    const int tid = make_tid(wv);
    const int wid = wv, lane = tid & 63, wr = wid >> 2, wc = wid & 3, fr = lane & 15, fq = lane >> 4;
    constexpr int nt = K / BK;
    int R0, C0, R1, C1;
    if constexpr (FP8) { stage_rc8(tid * 16, R0, C0); stage_rc8(tid * 16 + 8192, R1, C1); } else { stage_rc(tid * 16, R0, C0); stage_rc(tid * 16 + 8192, R1, C1); }
    unsigned voffB[2];
    { const int Rb0 = Epi::PERM ? ((R0 & ~31) + perm32(R0 & 31)) : R0, Rb1 = Epi::PERM ? ((R1 & ~31) + perm32(R1 & 31)) : R1;
      voffB[0] = (unsigned)(Rb0 * K + C0) * 2u; voffB[1] = (unsigned)(Rb1 * K + C1) * 2u; }
    unsigned offC[2][2];
    constexpr size_t kstep = (size_t)(BK * 2);
    constexpr size_t ABLK_GSTR = (size_t)16384 * 32;
    constexpr size_t kstepA = ABLK ? 4 * ABLK_GSTR : kstep;
    constexpr size_t hstepB = (size_t)HALF * K * 2;
    constexpr size_t hstepA = GATHER ? 0 : (ABLK ? (size_t)HALF * 32 : (size_t)HALF * LDA * 2);
    const unsigned ldsb = (unsigned)(size_t)lds + (unsigned)wid * 1024u;
    const int aoff = FP8 ? lds_byte8(wr * 64 + fr, 2 * fq) : lds_byte(wr * 64 + fr, fq * 8), boff = FP8 ? lds_byte8(wc * 32 + fr, 2 * fq) : lds_byte(wc * 32 + fr, fq * 8);
    const int aoffx = aoff ^ 16, boffx = boff ^ 16;
#define PG8_SA(b, h) (((b) * 2 + (h)) * HTB)
#define PG8_SB(b, h) ((4 + (b) * 2 + (h)) * HTB)
#define PG8_STAGE(bufoff, gbase, voff) do { _Pragma("unroll") for (int _i = 0; _i < 2; ++_i) { unsigned _keep; \
        asm volatile("s_mov_b32 %0, m0\n\ts_mov_b32 m0, %2\n\ts_nop 0\n\tglobal_load_lds_dwordx4 %1, %3\n\ts_mov_b32 m0, %0" : "=&s"(_keep) : "v"((voff)[_i]), "s"(ldsb + (unsigned)((bufoff) + _i * 8192)), "s"((const char*)(gbase)) : "memory"); } } while (0)
#define PG8_LDA(dst, b, h) do { _Pragma("unroll") for (int m = 0; m < 4; ++m) { if constexpr (FP8) { const i32x4 _l = *(const LAS i32x4*)(lds + PG8_SA(b, h) + aoff + m * 2048), _h = *(const LAS i32x4*)(lds + PG8_SA(b, h) + aoffx + m * 2048); dst##8[m] = __builtin_shufflevector(_l, _h, 0, 1, 2, 3, 4, 5, 6, 7); } \
        else { _Pragma("unroll") for (int k = 0; k < 2; ++k) dst[m][k] = *(const LAS bf16x8*)(lds + PG8_SA(b, h) + aoff + m * 2048 + k * 1024); } } } while (0)
#define PG8_LDB(dst, b, h) do { _Pragma("unroll") for (int n = 0; n < 2; ++n) { if constexpr (FP8) { const i32x4 _l = *(const LAS i32x4*)(lds + PG8_SB(b, h) + boff + n * 2048), _h = *(const LAS i32x4*)(lds + PG8_SB(b, h) + boffx + n * 2048); dst##8[n] = __builtin_shufflevector(_l, _h, 0, 1, 2, 3, 4, 5, 6, 7); } \
        else { _Pragma("unroll") for (int k = 0; k < 2; ++k) dst[n][k] = *(const LAS bf16x8*)(lds + PG8_SB(b, h) + boff + n * 2048 + k * 1024); } } } while (0)
#define PG8_MMA(ai, bj, At, Bt) do { __builtin_amdgcn_s_setprio(1); _Pragma("unroll") for (int m = 0; m < 4; ++m) _Pragma("unroll") for (int n = 0; n < 2; ++n) { \
        if constexpr (FP8) { acc[ai][bj][m][n] = __builtin_amdgcn_mfma_scale_f32_16x16x128_f8f6f4(Bt##8[n], At##8[m], acc[ai][bj][m][n], 0, 0, 0, 0, 0, 0); } \
        else { _Pragma("unroll") for (int k = 0; k < 2; ++k) acc[ai][bj][m][n] = __builtin_amdgcn_mfma_f32_16x16x32_bf16(Bt[n][k], At[m][k], acc[ai][bj][m][n], 0, 0, 0); } } \
        __builtin_amdgcn_s_setprio(0); } while (0)
#define PG8_WAIT_V(n) asm volatile("s_waitcnt vmcnt(" #n ")" ::: "memory")
#define PG8_WAIT_L(n) asm volatile("s_waitcnt lgkmcnt(" #n ")" ::: "memory")
#define PG8_BAR __builtin_amdgcn_s_barrier()
#define PG8_SCHED __builtin_amdgcn_sched_barrier(0)
    Unit cur, nxt; int ui = 0;
    if (!S.next(0, cur)) return;
    f32x4 acc[2][2][4][2];
#pragma unroll
    for (int a = 0; a < 2; ++a)
#pragma unroll
        for (int b = 0; b < 2; ++b)
#pragma unroll
            for (int m = 0; m < 4; ++m)
#pragma unroll
                for (int n = 0; n < 2; ++n) acc[a][b][m][n] = (f32x4){0.f, 0.f, 0.f, 0.f};
    bf16x8 At[FP8 ? 1 : 4][2], B0[FP8 ? 1 : 2][2], B1[FP8 ? 1 : 2][2]; i32x8 At8[FP8 ? 4 : 1], B08[FP8 ? 2 : 1], B18[FP8 ? 2 : 1];
    const char* cA = uni_ptr(S.a_ptr(cur)); const char* cB = uni_ptr(S.b_ptr(cur));
    if constexpr (GATHER) S.a_rows(0, wv, offC);
    else if constexpr (ABLK) { offC[0][0] = (unsigned)((C0 >> 4) * ABLK_GSTR + R0 * 32 + (C0 & 15) * 2); offC[0][1] = (unsigned)((C1 >> 4) * ABLK_GSTR + R1 * 32 + (C1 & 15) * 2); offC[1][0] = offC[0][0]; offC[1][1] = offC[0][1]; }
    else { offC[0][0] = (unsigned)(R0 * LDA + C0) * 2u; offC[0][1] = (unsigned)(R1 * LDA + C1) * 2u; offC[1][0] = offC[0][0]; offC[1][1] = offC[0][1]; }
    PG8_STAGE(PG8_SB(0, 0), cB, voffB); PG8_STAGE(PG8_SB(0, 1), cB + hstepB, voffB); PG8_STAGE(PG8_SA(0, 0), cA, offC[0]); PG8_STAGE(PG8_SA(0, 1), cA + hstepA, offC[1]);
    if (wr == 1) PG8_BAR;
    PG8_WAIT_V(2); PG8_BAR;
    PG8_STAGE(PG8_SB(1, 0), cB + kstep, voffB); PG8_STAGE(PG8_SA(1, 0), cA + kstepA, offC[0]); PG8_STAGE(PG8_SB(1, 1), cB + hstepB + kstep, voffB);
    PG8_WAIT_V(6); PG8_BAR;
    for (;;) {
        if (PRB && PROBE_GEMM == 3) { Unit dummy; (void)S.next(ui + 1 + (int)(pt & 1), dummy); asm volatile("" :: "s"(dummy.pm), "s"(dummy.pn), "s"(dummy.g)); }
        const bool has_next = S.next(ui + 1, nxt);
        const char* nA = has_next ? uni_ptr(S.a_ptr(nxt)) : cA; const char* nB = has_next ? uni_ptr(S.b_ptr(nxt)) : cB;
        if (PRB && PROBE_GEMM) { const unsigned long long now = wall_clock64(); if (pt) pe += now - pt; pt = now; }
#pragma unroll 1
        for (int t = 0; t < nt; t += 2) {
            const bool last = (t == nt - 2);
            const char* a1 = cA + (size_t)(t + 1) * kstepA;
            const char* a2 = last ? nA : cA + (size_t)(t + 2) * kstepA; const char* b2 = last ? nB : cB + (size_t)(t + 2) * kstep;
            const char* a3 = a2 + kstepA; const char* b3 = b2 + kstep;
            unsigned o2[2][2];
            if constexpr (GATHER) { if (last && has_next) S.a_rows(ui + 1, wv, o2); else { o2[0][0] = offC[0][0]; o2[0][1] = offC[0][1]; o2[1][0] = offC[1][0]; o2[1][1] = offC[1][1]; } }
            else { o2[0][0] = offC[0][0]; o2[0][1] = offC[0][1]; o2[1][0] = offC[1][0]; o2[1][1] = offC[1][1]; }
            PG8_LDB(B0, 0, 0); PG8_LDB(B1, 0, 1); PG8_SCHED; PG8_LDA(At, 0, 0); PG8_STAGE(PG8_SA(1, 1), a1 + hstepA, offC[1]);
            PG8_WAIT_V(8); PG8_WAIT_L(0); PG8_BAR; PG8_MMA(0, 0, At, B0); PG8_MMA(0, 1, At, B1); PG8_BAR; PG8_SCHED;
            PG8_LDA(At, 0, 1); PG8_STAGE(PG8_SB(0, 0), b2, voffB); PG8_STAGE(PG8_SB(0, 1), b2 + hstepB, voffB); PG8_STAGE(PG8_SA(0, 0), a2, o2[0]);
            PG8_WAIT_V(8); PG8_WAIT_L(0); PG8_BAR; PG8_MMA(1, 0, At, B0); PG8_MMA(1, 1, At, B1); PG8_BAR; PG8_SCHED;
            PG8_LDB(B0, 1, 0); PG8_LDB(B1, 1, 1); PG8_SCHED; PG8_LDA(At, 1, 0); PG8_STAGE(PG8_SA(0, 1), a2 + hstepA, o2[1]);
            PG8_WAIT_V(8); PG8_WAIT_L(0); PG8_BAR; PG8_MMA(0, 0, At, B0); PG8_MMA(0, 1, At, B1); PG8_BAR; PG8_SCHED;
            PG8_LDA(At, 1, 1); PG8_STAGE(PG8_SB(1, 0), b3, voffB); PG8_STAGE(PG8_SB(1, 1), b3 + hstepB, voffB); PG8_STAGE(PG8_SA(1, 0), a3, o2[0]);
            PG8_WAIT_V(8); PG8_WAIT_L(0); PG8_BAR; PG8_MMA(1, 0, At, B0); PG8_MMA(1, 1, At, B1); PG8_BAR; PG8_SCHED;
        }
        if (PRB && PROBE_GEMM) { const unsigned long long now = wall_clock64(); pk += now - pt; pt = now; }
        if constexpr (ALIGN_EPI) { if (wr == 0) PG8_BAR; }
        { const int l2 = make_tid(wv) & 63;
          E(acc, cur, wr, wc, l2 & 15, l2 >> 4);
          if (PRB && PROBE_GEMM == 2) { const int l3 = make_tid(wv) & 63; E(acc, cur, wr, wc, l3 & 15, l3 >> 4); } }
        if (!has_next) break;
#pragma unroll
        for (int a = 0; a < 2; ++a)
#pragma unroll
            for (int b = 0; b < 2; ++b)
#pragma unroll
                for (int m = 0; m < 4; ++m)
#pragma unroll
                    for (int n = 0; n < 2; ++n) acc[a][b][m][n] = (f32x4){0.f, 0.f, 0.f, 0.f};
        cur = nxt; cA = nA; cB = nB; ++ui;
        if constexpr (GATHER) S.a_rows(ui, wv, offC);
        if constexpr (ALIGN_EPI) { if (wr == 1) PG8_BAR; }
    }
    PG8_WAIT_V(0);
    if constexpr (!ALIGN_EPI) { if (wr == 0) PG8_BAR; }
    PG8_BAR;
    if (PRB && PROBE_GEMM) { const unsigned long long now = wall_clock64(); pe += now - pt; if (blockIdx.x == PRB - 1 && tid == 0) { diag[0] = (float)pk * 0.01f; diag[1] = (float)pe * 0.01f; } }
#undef PG8_SA
#undef PG8_SB
#undef PG8_STAGE
#undef PG8_LDA
#undef PG8_LDB
#undef PG8_MMA
#undef PG8_WAIT_V
#undef PG8_WAIT_L
#undef PG8_BAR
#undef PG8_SCHED
}
}
using pg8::Unit;
typedef f32x4 AccT[2][2][4][2];

struct SchedInProj {
    const unsigned char* ws; int c;
    __device__ __forceinline__ bool next(int i, Unit& u) const {
        const int L = i * G_INPROJ + c; if (L >= 1104) return false;
        const int w = pg8::xcd_chunk(L, 1104);
        if (w < 1024) { const int gid = w >> 7, r = w & 127; u.pm = gid * 8 + (r & 7); u.pn = r >> 3; }
        else { const int j = w - 1024, q = j >> 3; u.pm = 64 + (j & 7); u.pn = q < 6 ? 2 + q : 6 + q; }
        u.g = 0; return true;
    }
    __device__ __forceinline__ const char* a_ptr(const Unit& u) const { return (const char*)(ws + WS_U1) + (size_t)u.pm * 256 * 2048 * (INPROJ_FP8 ? 1 : 2); }
    __device__ __forceinline__ const char* b_ptr(const Unit& u) const { return (const char*)(ws + WS_WIN_T) + (size_t)u.pn * 256 * 2048 * (INPROJ_FP8 ? 1 : 2); }
};
constexpr float IP_SCALE = INPROJ_FP8 ? FP8_OSCALE : 1.0f;
struct EpiInProj {
    static constexpr bool PERM = true;
    unsigned char* ws;
    __device__ __forceinline__ void operator()(const AccT& acc, const Unit& u, int wr, int wc, int fr, int fq) const {
        if (u.pn < 12) {
            const size_t wsb = u.pn < 4 ? WS_ZQK : (u.pn < 8 ? WS_VBUF : WS_OBUF);
            char* base = (char*)pg8::uni_ptr((const char*)(ws + wsb + (size_t)u.pm * 256 * 2048 + (u.pn & 3) * 512));
            const unsigned vo = (unsigned)((wr * 64 + fr) * 2048 + wc * 64 + 16 * fq);
#pragma unroll
            for (int ai = 0; ai < 2; ++ai)
#pragma unroll
                for (int m = 0; m < 4; ++m)
#pragma unroll
                    for (int bj = 0; bj < 2; ++bj) {
                        const f32x4 v0 = acc[ai][bj][m][0] * IP_SCALE, v1 = acc[ai][bj][m][1] * IP_SCALE;
                        u32x4 w; w.x = cvt_pk_bf16(v0[0], v0[1]); w.y = cvt_pk_bf16(v0[2], v0[3]); w.z = cvt_pk_bf16(v1[0], v1[1]); w.w = cvt_pk_bf16(v1[2], v1[3]);
                        *(u32x4*)(base + (vo + (unsigned)((ai * 128 + m * 16) * 2048 + bj * 256))) = w; }
        } else {
            const unsigned vo = (unsigned)(((fq >> 1) * (1280 * 512) + fr * 16 + 8 * (fq & 1)) * 2);
#pragma unroll
            for (int ai = 0; ai < 2; ++ai)
#pragma unroll
                for (int m = 0; m < 4; ++m) {
                    const int rowb = u.pm * 256 + ai * 128 + wr * 64 + m * 16; int crow;
                    if (rowb < NLAT) crow = (rowb >> 11) * 128 + ((rowb & 2047) >> 4); else { const int rr = rowb - NLAT; crow = 1024 + (rr >> 8) * 16 + ((rr & 255) >> 4); }
#pragma unroll
                    for (int bj = 0; bj < 2; ++bj) {
                        const f32x4 v0 = acc[ai][bj][m][0] * IP_SCALE, v1 = acc[ai][bj][m][1] * IP_SCALE;
                        u32x4 w; w.x = cvt_pk_bf16(v0[0], v0[1]); w.y = cvt_pk_bf16(v0[2], v0[3]); w.z = cvt_pk_bf16(v1[0], v1[1]); w.w = cvt_pk_bf16(v1[2], v1[3]);
                        char* base = (char*)pg8::uni_ptr((const char*)(ws + WS_AS5 + (size_t)((((u.pn - 12) * 16 + bj * 8 + wc * 2) * 1280 + crow) * 512) * 2));
                        *(u32x4*)(base + vo) = w; }
                }
        }
    }
};

struct SchedS5V {
    const unsigned char* ws; int c;
    __device__ __forceinline__ bool next(int i, Unit& u) const { const int L = i * NWG + c; if (L >= 320) return false; const int w = pg8::xcd_chunk(L, 320); u.g = w / 5; u.pm = w % 5; u.pn = 0; return true; }
    __device__ __forceinline__ const char* a_ptr(const Unit& u) const { return (const char*)(ws + WS_AS5) + ((size_t)u.g * 1280 + u.pm * 256) * 512 * 2; }
    __device__ __forceinline__ const char* b_ptr(const Unit& u) const { return (const char*)(ws + WS_BTV) + (size_t)u.g * 256 * 256 * 2; }
};
struct EpiS5V {
    static constexpr bool PERM = false;
    unsigned char* ws;
    __device__ __forceinline__ void operator()(const AccT& acc, const Unit& u, int wr, int wc, int fr, int fq) const {
        float* base = (float*)(ws + WS_VS5) + ((size_t)u.g * 1280 + u.pm * 256) * 256;
#pragma unroll
        for (int ai = 0; ai < 2; ++ai)
#pragma unroll
            for (int m = 0; m < 4; ++m) { float* rowp = base + (size_t)(ai * 128 + wr * 64 + m * 16 + fr) * 256 + wc * 32 + 4 * fq;
#pragma unroll
                for (int bj = 0; bj < 2; ++bj)
#pragma unroll
                    for (int n = 0; n < 2; ++n) *(f32x4*)(rowp + bj * 128 + n * 16) = acc[ai][bj][m][n]; }
    }
};

struct SchedS5Y {
    const unsigned char* ws; int c;
    __device__ __forceinline__ bool next(int i, Unit& u) const { const int L = i * NWG + c; if (L >= 256) return false; const int w = pg8::xcd_chunk(L, 256); u.g = w >> 2; u.pm = w & 3; u.pn = 0; return true; }
    __device__ __forceinline__ const char* a_ptr(const Unit& u) const { return (const char*)(ws + WS_AS5) + ((size_t)u.g * 1280 + u.pm * 256) * 512 * 2; }
    __device__ __forceinline__ const char* b_ptr(const Unit& u) const { return (const char*)(ws + WS_BTY) + (size_t)u.g * 256 * 512 * 2; }
};
__device__ __forceinline__ float gelu_tanh(float x) { const float u = 0.7978845608028654f * (x + 0.044715f * x * x * x); const float e = __builtin_amdgcn_exp2f(u * 2.8853900817779268f); const float th = 1.0f - 2.0f * __builtin_amdgcn_rcpf(e + 1.0f); return 0.5f * x * (1.0f + th); }
struct EpiS5Y {
    static constexpr bool PERM = true;
    unsigned char* ws; const float* s5_d;
    __device__ __forceinline__ void operator()(const AccT& acc, const Unit& u, int wr, int wc, int fr, int fq) const {
        f32x4 dd[2][2];
#pragma unroll
        for (int bj = 0; bj < 2; ++bj) { const int h0 = (bj * 128 + wc * 32 + 8 * fq) & 15; dd[bj][0] = *(const f32x4*)(s5_d + u.g * 16 + h0); dd[bj][1] = *(const f32x4*)(s5_d + u.g * 16 + h0 + 4); }
        u32x4 ub[2][4];
#define S5Y_LOAD(q, B) do { _Pragma("unroll") for (int mm = 0; mm < 2; ++mm) _Pragma("unroll") for (int bj = 0; bj < 2; ++bj) { const int ai = (q) >> 1, m = ((q) & 1) * 2 + mm; \
            const int cr = u.pm * 256 + ai * 128 + wr * 64 + m * 16 + fr, nn = bj * 128 + wc * 32 + 8 * fq; \
            B[mm * 2 + bj] = *(const u32x4*)((const bf16_t*)(ws + WS_AS5) + ((size_t)u.g * 1280 + cr) * 512 + nn); } } while (0)
        S5Y_LOAD(0, ub[0]);
#pragma unroll
        for (int q = 0; q < 4; ++q) {
            if (q + 1 < 4) S5Y_LOAD(q + 1, ub[(q + 1) & 1]);
#pragma unroll
            for (int mm = 0; mm < 2; ++mm)
#pragma unroll
                for (int bj = 0; bj < 2; ++bj) { const int ai = q >> 1, m = (q & 1) * 2 + mm;
                    const int cr = u.pm * 256 + ai * 128 + wr * 64 + m * 16 + fr, b = cr >> 7, cb = cr & 127;
                    const int nn = bj * 128 + wc * 32 + 8 * fq, tt = nn >> 4, h0 = nn & 15;
                    const u32x4 uw = ub[q & 1][mm * 2 + bj]; const f32x4 d0 = dd[bj][0], d1 = dd[bj][1];
                    const f32x4 y0 = acc[ai][bj][m][0], y1 = acc[ai][bj][m][1];
                    float s[8];
                    s[0] = gelu_tanh(y0[0] + d0[0] * bflo(uw.x)); s[1] = gelu_tanh(y0[1] + d0[1] * bfhi(uw.x)); s[2] = gelu_tanh(y0[2] + d0[2] * bflo(uw.y)); s[3] = gelu_tanh(y0[3] + d0[3] * bfhi(uw.y));
                    s[4] = gelu_tanh(y1[0] + d1[0] * bflo(uw.z)); s[5] = gelu_tanh(y1[1] + d1[1] * bfhi(uw.z)); s[6] = gelu_tanh(y1[2] + d1[2] * bflo(uw.w)); s[7] = gelu_tanh(y1[3] + d1[3] * bfhi(uw.w));
                    u32x4 w; w.x = cvt_pk_bf16(s[0], s[1]); w.y = cvt_pk_bf16(s[2], s[3]); w.z = cvt_pk_bf16(s[4], s[5]); w.w = cvt_pk_bf16(s[6], s[7]);
                    *(u32x4*)((bf16_t*)(ws + WS_SBUF) + ((size_t)u.g * 16384 + b * 2048 + cb * 16 + tt) * 16 + h0) = w; }
        }
#undef S5Y_LOAD
    }
};

template <int NN> struct SchedStatic {
    const char* A; const char* Bt; int c; size_t a_tile_bytes, b_tile_bytes;
    __device__ __forceinline__ bool next(int i, Unit& u) const { constexpr int nwg = 64 * NN; const int L = i * NWG + c; if (L >= nwg) return false;
        const int w = pg8::xcd_chunk(L, nwg); const int nig = 8 * NN, gid = w / nig, r = w % nig; u.pm = gid * 8 + (r & 7); u.pn = r >> 3; u.g = 0; return true; }
    __device__ __forceinline__ const char* a_ptr(const Unit& u) const { return A + (size_t)u.pm * a_tile_bytes; }
    __device__ __forceinline__ const char* b_ptr(const Unit& u) const { return Bt + (size_t)u.pn * b_tile_bytes; }
};
struct EpiGLU {
    static constexpr bool PERM = true;
    unsigned char* ws;
    __device__ __forceinline__ void operator()(const AccT& acc, const Unit& u, int wr, int wc, int fr, int fq) const {
        u32x4 sb[2][4];
#define GLU_LOAD(q, B) do { _Pragma("unroll") for (int mm = 0; mm < 2; ++mm) _Pragma("unroll") for (int bj = 0; bj < 2; ++bj) { const int ai = (q) >> 1, m = ((q) & 1) * 2 + mm; \
            const int row = u.pm * 256 + ai * 128 + wr * 64 + m * 16 + fr, col = u.pn * 256 + bj * 128 + wc * 32 + 8 * fq; \
            B[mm * 2 + bj] = *(const u32x4*)((const bf16_t*)(ws + WS_SBUF) + ((size_t)(col >> 4) * 16384 + row) * 16 + (col & 15)); } } while (0)
        GLU_LOAD(0, sb[0]);
#pragma unroll
        for (int q = 0; q < 4; ++q) {
            if (q + 1 < 4) GLU_LOAD(q + 1, sb[(q + 1) & 1]);
#pragma unroll
            for (int mm = 0; mm < 2; ++mm)
#pragma unroll
                for (int bj = 0; bj < 2; ++bj) { const int ai = q >> 1, m = (q & 1) * 2 + mm;
                    const int row = u.pm * 256 + ai * 128 + wr * 64 + m * 16 + fr, col = u.pn * 256 + bj * 128 + wc * 32 + 8 * fq;
                    const u32x4 sw = sb[q & 1][mm * 2 + bj];
                    const f32x4 a0 = acc[ai][bj][m][0], a1 = acc[ai][bj][m][1];
                    u32x2 w;
                    w.x = cvt4_fp8_sat(bflo(sw.x) * sigmoidf_(a0[0]) * FP8_ASCALE, bfhi(sw.x) * sigmoidf_(a0[1]) * FP8_ASCALE, bflo(sw.y) * sigmoidf_(a0[2]) * FP8_ASCALE, bfhi(sw.y) * sigmoidf_(a0[3]) * FP8_ASCALE);
                    w.y = cvt4_fp8_sat(bflo(sw.z) * sigmoidf_(a1[0]) * FP8_ASCALE, bfhi(sw.z) * sigmoidf_(a1[1]) * FP8_ASCALE, bflo(sw.w) * sigmoidf_(a1[2]) * FP8_ASCALE, bfhi(sw.w) * sigmoidf_(a1[3]) * FP8_ASCALE);
                    *(u32x2*)(ws + WS_CAT + (size_t)row * 2048 + 1024 + col) = w; }
        }
#undef GLU_LOAD
    }
};
struct EpiOut {
    static constexpr bool PERM = true;
    unsigned char* ws; const float* x;
    __device__ __forceinline__ void operator()(const AccT& acc, const Unit& u, int wr, int wc, int fr, int fq) const {
        const float* g1 = (const float*)(ws + WS_MOD) + (size_t)(u.pm >> 3) * 12288 + 2 * 2048;
        const int col0 = u.pn * 256 + wc * 32 + 8 * fq;
        f32x4 gv[2][2];
#pragma unroll
        for (int bj = 0; bj < 2; ++bj)
#pragma unroll
            for (int n = 0; n < 2; ++n) gv[bj][n] = *(const f32x4*)(g1 + col0 + bj * 128 + n * 4);
        f32x4 xb[2][8];
#define OUT_LOAD(q, B) do { _Pragma("unroll") for (int mm = 0; mm < 2; ++mm) _Pragma("unroll") for (int bj = 0; bj < 2; ++bj) { const int ai = (q) >> 1, m = ((q) & 1) * 2 + mm; \
            const size_t ro = (size_t)(u.pm * 256 + ai * 128 + wr * 64 + m * 16 + fr) * 2048 + col0; \
            B[(mm * 2 + bj) * 2] = *(const f32x4*)(x + ro + bj * 128); B[(mm * 2 + bj) * 2 + 1] = *(const f32x4*)(x + ro + bj * 128 + 4); } } while (0)
        OUT_LOAD(0, xb[0]);
#pragma unroll
        for (int q = 0; q < 4; ++q) {
            if (q + 1 < 4) OUT_LOAD(q + 1, xb[(q + 1) & 1]);
#pragma unroll
            for (int mm = 0; mm < 2; ++mm)
#pragma unroll
                for (int bj = 0; bj < 2; ++bj) { const int ai = q >> 1, m = (q & 1) * 2 + mm;
                    const size_t ro = (size_t)(u.pm * 256 + ai * 128 + wr * 64 + m * 16 + fr) * 2048 + col0;
                    const f32x4 xv0 = xb[q & 1][(mm * 2 + bj) * 2], xv1 = xb[q & 1][(mm * 2 + bj) * 2 + 1];
                    const f32x4 r0 = xv0 + gv[bj][0] * (acc[ai][bj][m][0] * FP8_OSCALE), r1 = xv1 + gv[bj][1] * (acc[ai][bj][m][1] * FP8_OSCALE);
                    u32x4 w; w.x = cvt_pk_bf16(r0[0], r0[1]); w.y = cvt_pk_bf16(r0[2], r0[3]); w.z = cvt_pk_bf16(r1[0], r1[1]); w.w = cvt_pk_bf16(r1[2], r1[3]);
                    *(u32x4*)((bf16_t*)(ws + WS_X1) + ro + bj * 128) = w; }
        }
#undef OUT_LOAD
    }
};

struct EpiOutDummy {
    static constexpr bool PERM = false;
    unsigned char* ws; const float* x;
    __device__ __forceinline__ void operator()(const AccT& acc, const Unit& u, int wr, int wc, int fr, int fq) const {
        const float* g1 = (const float*)(ws + WS_MOD) + (size_t)(u.pm >> 3) * 12288 + 2 * 2048;
        const int col0 = u.pn * 256 + wc * 32 + 4 * fq;
#pragma unroll
        for (int ai = 0; ai < 2; ++ai)
#pragma unroll
            for (int m = 0; m < 4; ++m) { const size_t ro = (size_t)(u.pm * 256 + ai * 128 + wr * 64 + m * 16 + fr) * 2048 + col0;
#pragma unroll
                for (int bj = 0; bj < 2; ++bj)
#pragma unroll
                    for (int n = 0; n < 2; ++n) { const f32x4 xv = *(const f32x4*)(x + ro + bj * 128 + n * 16); const f32x4 gv = *(const f32x4*)(g1 + col0 + bj * 128 + n * 16);
                        *(f32x4*)((float*)(ws + WS_HID) + ro + bj * 128 + n * 16) = xv + gv * (acc[ai][bj][m][n] * FP8_OSCALE); } }
    }
};
template <int NN, bool HOT> struct SchedProbe : SchedStatic<NN> {
    __device__ __forceinline__ const char* a_ptr(const Unit& u) const { return HOT ? this->A : this->A + (size_t)u.pm * this->a_tile_bytes; }
    __device__ __forceinline__ const char* b_ptr(const Unit& u) const { return HOT ? this->Bt : this->Bt + (size_t)u.pn * this->b_tile_bytes; }
};
struct MoeTables { LAS const int* tp; LAS const int* cnt; LAS const unsigned short* rows; LAS const int* utab; LAS const unsigned char* bias; };
template <int NN  > struct SchedMoE {
    const unsigned char* ws; int c; MoeTables T; const char* A; const char* Bt; size_t b_expert_bytes; int nwg;
    __device__ __forceinline__ bool decode(int i, int (&o)[5]) const {
        const int L = i * NWG + c; if (L >= nwg) return false;
        const int w = pg8::xcd_chunk(L, nwg);
        int e = 0;
#pragma unroll
        for (int j = 1; j < 32; ++j) e = (w >= T.tp[j] * NN) ? j : e;
        const int t0 = T.tp[e], t1 = T.tp[e + 1], q = w - t0 * NN, mt = t1 - t0;
        o[0] = e; o[1] = q % mt; o[2] = q / mt; o[3] = t0; o[4] = T.cnt[e]; return true;
    }
    __device__ __forceinline__ bool next(int i, Unit& u) const {
        if (i * NWG + c >= nwg) return false;
        LAS const int* r = T.utab + i * 8;
        u.g = __builtin_amdgcn_readfirstlane(r[0]); u.pm = __builtin_amdgcn_readfirstlane(r[1]); u.pn = __builtin_amdgcn_readfirstlane(r[2]); u.rb = __builtin_amdgcn_readfirstlane(r[3]); u.cn = __builtin_amdgcn_readfirstlane(r[4]); u.ui = i; return true;
    }
    __device__ __forceinline__ const char* a_ptr(const Unit& u) const { return A; }
    __device__ __forceinline__ const char* b_ptr(const Unit& u) const { return Bt + (size_t)u.g * b_expert_bytes + (size_t)u.pn * 256 * 2048; }
    __device__ __forceinline__ void a_rows(int ui, int wv, unsigned (&off)[2][2]) const {
        const int tid = make_tid(wv); int R0, C0, R1, C1; pg8::stage_rc8(tid * 16, R0, C0); pg8::stage_rc8(tid * 16 + 8192, R1, C1);
        LAS const unsigned short* rw = T.rows + ui * 256;
        const int t00 = rw[R0], t01 = rw[R1], t10 = rw[R0 + 128], t11 = rw[R1 + 128];
        off[0][0] = (unsigned)(t00 * 1024 + C0) * 2u; off[0][1] = (unsigned)(t01 * 1024 + C1) * 2u; off[1][0] = (unsigned)(t10 * 1024 + C0) * 2u; off[1][1] = (unsigned)(t11 * 1024 + C1) * 2u;
    }
};
struct SchedMoE2 : SchedMoE<8> {
    __device__ __forceinline__ const char* a_ptr(const Unit& u) const { return A + (size_t)(u.rb + u.pm) * 256 * 2048; }
};
struct EpiMoE1 {
    static constexpr bool PERM = true;
    unsigned char* ws; const float* b_gu; MoeTables T;
    __device__ __forceinline__ void operator()(const AccT& acc, const Unit& u, int wr, int wc, int fr, int fq) const {
        const int hc = u.pn * 128 + wc * 32 + 8 * fq;
        const __amdgpu_buffer_rsrc_t hrs = __builtin_amdgcn_make_buffer_rsrc((void*)pg8::uni_ptr((const char*)(ws + WS_HID + (size_t)(u.rb + u.pm) * 256 * 2048)), 0, 256 * 2048, 0x00020000);
        const int hvo = (wr * 64 + fr) * 2048 + hc;
        f32x4 bgv[2], buv[2];
#pragma unroll
        for (int n = 0; n < 2; ++n) {
            LAS const unsigned char* bl = T.bias + u.ui * 512 + (wc * 32 + 8 * fq + 4 * n) * 2;
            const u32x2 bgw = *(LAS const u32x2*)bl, buw = *(LAS const u32x2*)(bl + 256);
            bgv[n] = (f32x4){bflo(bgw.x), bfhi(bgw.x), bflo(bgw.y), bfhi(bgw.y)}; buv[n] = (f32x4){bflo(buw.x), bfhi(buw.x), bflo(buw.y), bfhi(buw.y)}; }
#pragma unroll
        for (int ai = 0; ai < 2; ++ai)
#pragma unroll
            for (int m = 0; m < 4; ++m) { u32x2 w8;
#pragma unroll
                for (int n = 0; n < 2; ++n) {
                    const f32x4 g0 = acc[ai][0][m][n] * FP8_OSCALE + bgv[n], u0 = acc[ai][1][m][n] * FP8_OSCALE + buv[n];
                    f32x4 ga, ua;
#pragma unroll
                    for (int j = 0; j < 4; ++j) { ga[j] = fminf(g0[j], 7.0f); ua[j] = __builtin_amdgcn_fmed3f(u0[j], -7.0f, 7.0f); }
                    f32x4 ex = ga * (-1.702f * 1.4426950408889634f);
#pragma unroll
                    for (int j = 0; j < 4; ++j) ex[j] = __builtin_amdgcn_exp2f(ex[j]);
                    f32x4 den = ex + 1.0f;
#pragma unroll
                    for (int j = 0; j < 4; ++j) den[j] = __builtin_amdgcn_rcpf(den[j]);
                    const f32x4 h = (ua * FP8_ASCALE + FP8_ASCALE) * ga * den;
                    w8[n] = cvt4_fp8(h[0], h[1], h[2], h[3]); }
                __builtin_amdgcn_raw_buffer_store_b64(w8, hrs, hvo, (ai * 128 + m * 16) * 2048, 0); }
    }
};
struct EpiMoE2 {
    static constexpr bool PERM = true;
    unsigned char* ws; const float* b_down; MoeTables T;
    __device__ __forceinline__ void operator()(const AccT& acc, const Unit& u, int wr, int wc, int fr, int fq) const {
        const __amdgpu_buffer_rsrc_t ors = __builtin_amdgcn_make_buffer_rsrc((void*)pg8::uni_ptr((const char*)(ws + WS_OUT2 + (size_t)(u.rb + u.pm) * 256 * 2048 + (size_t)u.pn * 256)), 0, 256 * 2048, 0x00020000);
        const int ovo = (wr * 64 + fr) * 2048 + (wc * 4 + fq) * 16;
        f32x4 bb[2][2];
#pragma unroll
        for (int bj = 0; bj < 2; ++bj) { LAS const float* bl = (LAS const float*)T.bias + u.ui * 256 + bj * 128 + wc * 32 + 8 * fq;
            bb[bj][0] = *(LAS const f32x4*)bl * FP8_YSCALE; bb[bj][1] = *(LAS const f32x4*)(bl + 4) * FP8_YSCALE; }
#pragma unroll
        for (int ai = 0; ai < 2; ++ai)
#pragma unroll
            for (int m = 0; m < 4; ++m) { u32x4 w;
#pragma unroll
                for (int bj = 0; bj < 2; ++bj) {
                    const f32x4 v0 = acc[ai][bj][m][0] * (FP8_OSCALE * FP8_YSCALE) + bb[bj][0], v1 = acc[ai][bj][m][1] * (FP8_OSCALE * FP8_YSCALE) + bb[bj][1];
                    w[bj * 2] = cvt4_fp8(v0[0], v0[1], v0[2], v0[3]); w[bj * 2 + 1] = cvt4_fp8(v1[0], v1[1], v1[2], v1[3]); }
                __builtin_amdgcn_raw_buffer_store_b128(w, ors, ovo, (ai * 128 + m * 16) * 2048, 0);
                asm volatile("" ::: "memory");
            }
    }
};
#define CV_GEO(row) const bool lat = (row) < NLAT; int bbase, gr, gc, ncol, nrowmax; \
    if (lat) { const int l = (row) & 2047; bbase = (row) - l; gr = l >> 6; gc = l & 63; ncol = 64; nrowmax = 32; } \
    else { const int rr = (row) - NLAT, l = rr & 255; bbase = (row) - l; gr = 0; gc = l; ncol = 256; nrowmax = 1; }
#define CV_LOAD(Z, row) do { CV_GEO(row) \
    _Pragma("unroll") for (int dy = -1; dy <= 1; ++dy) _Pragma("unroll") for (int dx = -1; dx <= 1; ++dx) { const int r2 = gr + dy, c2 = gc + dx; \
        if (r2 >= 0 && r2 < nrowmax && c2 >= 0 && c2 < ncol) Z[(dy + 1) * 3 + dx + 1] = *(const u32x4*)(z + (size_t)(bbase + r2 * ncol + c2) * 1024 + ch0); } } while (0)
#define CV_COMPUTE(Z, row) do { CV_GEO(row) float acc[8]; \
    _Pragma("unroll") for (int j = 0; j < 8; ++j) acc[j] = 0.f; \
    _Pragma("unroll") for (int dy = -1; dy <= 1; ++dy) _Pragma("unroll") for (int dx = -1; dx <= 1; ++dx) { const int r2 = gr + dy, c2 = gc + dx; \
        if (r2 >= 0 && r2 < nrowmax && c2 >= 0 && c2 < ncol) { const u32x4 zv = Z[(dy + 1) * 3 + dx + 1]; \
            LAS const float* w = cw + ((dy + 1) * 3 + (dx + 1)) * 1024 + ch0; const f32x4 w0 = *(LAS const f32x4*)w, w1 = *(LAS const f32x4*)(w + 4); \
            acc[0] += w0[0] * bflo(zv.x); acc[1] += w0[1] * bfhi(zv.x); acc[2] += w0[2] * bflo(zv.y); acc[3] += w0[3] * bfhi(zv.y); \
            acc[4] += w1[0] * bflo(zv.z); acc[5] += w1[1] * bfhi(zv.z); acc[6] += w1[2] * bflo(zv.w); acc[7] += w1[3] * bfhi(zv.w); } } \
    _Pragma("unroll") for (int j = 0; j < 8; ++j) acc[j] = acc[j] * sigmoidf_(acc[j]) * sc; \
    u32x4 o; o.x = cvt_pk_bf16(acc[0], acc[1]); o.y = cvt_pk_bf16(acc[2], acc[3]); o.z = cvt_pk_bf16(acc[4], acc[5]); o.w = cvt_pk_bf16(acc[6], acc[7]); \
    *(u32x4*)(qk + (size_t)(row) * 1024 + ch0) = o; } while (0)
__device__ __forceinline__ void phase_conv(const Params& p, LAS unsigned char* lds, int wv) {
    const int t = make_tid(wv);
    LAS float* cw = (LAS float*)lds;
    for (int i = t; i < 9216; i += NTHR) cw[i] = p.conv_qk[i];
    __syncthreads();
    const bf16_t* z = (const bf16_t*)(p.ws + WS_ZQK);
    bf16_t* qk = (bf16_t*)(p.ws + WS_QK);
    const int cg = t & 127, rsub = t >> 7, ch0 = cg * 8;
    const float sc = ch0 >= 512 ? 0.08838834764831845f : 1.0f;
    constexpr int CONV_A = 20, CONV_B = 72 - 3 * CONV_A;
    const int c = blockIdx.x, nit = c < 64 ? CONV_B : CONV_A, item0 = c < 64 ? c * CONV_B : 64 * CONV_B + (c - 64) * CONV_A;
    u32x4 za[9], zb[9];
    CV_LOAD(za, 4 * item0 + rsub);
#pragma unroll 1
    for (int it = 0; it < nit; it += 2) {
        const int row = 4 * (item0 + it) + rsub, row1 = row + 4;
        CV_LOAD(zb, row1);
        CV_COMPUTE(za, row);
        if (it + 2 < nit) CV_LOAD(za, row1 + 4);
        CV_COMPUTE(zb, row1);
    }
    __syncthreads();
}

__device__ __forceinline__ void phase_s5scan(const Params& p, int wv) {
    const int t = make_tid(wv); if (t >= 256) return;
    const int idx = blockIdx.x * 256 + t, pp = idx & 63, b = (idx >> 6) & 7, dir = (idx >> 9) & 1, g = idx >> 10;
    const float* lb16 = (const float*)(p.ws + WS_LB16) + (size_t)((dir * 64 + g) * 64 + pp) * 2;
    const float ar = lb16[0], ai = lb16[1];
    const float* V = (const float*)(p.ws + WS_VS5) + (size_t)g * 1280 * 256 + dir * 128 + pp;
    bf16_t* X = (bf16_t*)(p.ws + WS_AS5) + (size_t)g * 1280 * 512 + 256 + dir * 128 + pp;
    float xr = 0.f, xi = 0.f;
    {   float vr[16], vi[16];
#pragma unroll
        for (int k = 0; k < 16; ++k) { const int cix = dir ? 15 - k : k; const float* v = V + (size_t)(1024 + b * 16 + cix) * 256; vr[k] = v[0]; vi[k] = v[64]; }
#pragma unroll
        for (int k = 0; k < 16; ++k) { const float nr = ar * xr - ai * xi + vr[k], ni = ar * xi + ai * xr + vi[k]; xr = nr; xi = ni; } }
    for (int blk = 0; blk < 8; ++blk) {
        float vr[16], vi[16];
#pragma unroll
        for (int k = 0; k < 16; ++k) { const int cc = blk * 16 + k, cix = dir ? 127 - cc : cc; const float* v = V + (size_t)(b * 128 + cix) * 256; vr[k] = v[0]; vi[k] = v[64]; }
#pragma unroll
        for (int k = 0; k < 16; ++k) { const int cc = blk * 16 + k, cix = dir ? 127 - cc : cc; bf16_t* x = X + (size_t)(b * 128 + cix) * 512; x[0] = f2bf(xr); x[64] = f2bf(xi);
            const float nr = ar * xr - ai * xi + vr[k], ni = ar * xi + ai * xr + vi[k]; xr = nr; xi = ni; }
    }
}

template <int OFF1> __device__ __forceinline__ bf16x8 tr_frag(unsigned addr) {
    s16x4 a, b;
    asm volatile("ds_read_b64_tr_b16 %0, %2\n\tds_read_b64_tr_b16 %1, %2 offset:%3\n\ts_waitcnt lgkmcnt(0)" : "=&v"(a), "=&v"(b) : "v"(addr), "i"(OFF1) : "memory");
    bf16x8 r; r[0] = a[0]; r[1] = a[1]; r[2] = a[2]; r[3] = a[3]; r[4] = b[0]; r[5] = b[1]; r[6] = b[2]; r[7] = b[3]; return r;
}
struct TrF { s16x4 a, b; };
template <int OFF1> __device__ __forceinline__ void tr_issue(unsigned addr, TrF& f) {
    asm volatile("ds_read_b64_tr_b16 %0, %2\n\tds_read_b64_tr_b16 %1, %2 offset:%3" : "=&v"(f.a), "=&v"(f.b) : "v"(addr), "i"(OFF1) : "memory");
}
__device__ __forceinline__ bf16x8 tr_val(const TrF& f) { return __builtin_shufflevector(f.a, f.b, 0, 1, 2, 3, 4, 5, 6, 7); }
#define TR_W2(x) "+v"(x.a), "+v"(x.b)
#define TR_WAIT4(f0, f1, f2, f3) asm volatile("s_waitcnt lgkmcnt(0)" : TR_W2(f0), TR_W2(f1), TR_W2(f2), TR_W2(f3) :: "memory")
#define TR_WAIT2(f0, f1) asm volatile("s_waitcnt lgkmcnt(0)" : TR_W2(f0), TR_W2(f1) :: "memory")
#define TR_WAIT12(f0, f1, f2, f3, f4, f5, f6, f7, f8, f9, f10, f11) asm volatile("s_waitcnt lgkmcnt(0)" : TR_W2(f0), TR_W2(f1), TR_W2(f2), TR_W2(f3), TR_W2(f4), TR_W2(f5), TR_W2(f6), TR_W2(f7), TR_W2(f8), TR_W2(f9), TR_W2(f10), TR_W2(f11) :: "memory")
constexpr int ML_QS = 0, ML_KS = 17408, ML_VS = 34816, ML_WVS = 46080, ML_SS = 57344, ML_CS = 66560, ML_VEC = 89088, ML_F8 = 90624, ML_HS = 108032;
__device__ __forceinline__ void phase_mlstm(const Params& p, LAS unsigned char* lds, int wv) {
    const int t = make_tid(wv);
    const int lane = t & 63, wid = wv, c = blockIdx.x;
    const int bh = c & 31, b = bh >> 2, hd = bh & 3, dq = c >> 5, dir = dq >> 2, qt = dq & 3;
    const int l15 = lane & 15, g4 = lane >> 4, q4 = (lane & 15) >> 2, p4 = lane & 3;
    LAS float* vec = (LAS float*)(lds + ML_VEC);
    const unsigned ldsb = (unsigned)(size_t)lds;
    for (int i = t; i < 128 * 176 / 4; i += NTHR) ((LAS unsigned*)(lds + ML_CS))[i] = 0u;
    for (int i = t; i < 64 * 8; i += NTHR) { const int s = i >> 3, w = i & 7; ((LAS unsigned*)(lds + ML_VS + s * 176 + 128))[w] = (w == 0) ? 0x00003f80u : 0u; ((LAS unsigned*)(lds + ML_WVS + s * 176 + 128))[w] = 0u; }
    const bf16_t* QK = (const bf16_t*)(p.ws + WS_QK); const bf16_t* VB = (const bf16_t*)(p.ws + WS_VBUF); const float* GT = (const float*)(p.ws + WS_GATES);
    bf16_t* HB = (bf16_t*)(p.ws + WS_HBUF) + (size_t)dir * NLAT * 1024;
    f32x4 accC[5];
#pragma unroll
    for (int v = 0; v < 5; ++v) accC[v] = (f32x4){0.f, 0.f, 0.f, 0.f};
    float m0 = 0.f;
    u32x4 rq[2], rk[2], rv; float rig = 0.f, rlf = 0.f;
    auto tokbase = [&](int st) -> int { if (st < 4) { const int cc = dir ? 3 - st : st; return NLAT + b * 256 + cc * 64; } const int cc = dir ? 31 - (st - 4) : (st - 4); return b * 2048 + cc * 64; };
    auto issue = [&](int st) {
        const int base = tokbase(st);
#pragma unroll
        for (int i = 0; i < 2; ++i) { const int id = t + 512 * i, j = id >> 4, ch = id & 15; const size_t row = (size_t)(base + (dir ? 63 - j : j));
            if (st >= 4) rq[i] = *(const u32x4*)(QK + row * 1024 + hd * 128 + ch * 8);
            rk[i] = *(const u32x4*)(QK + row * 1024 + 512 + hd * 128 + ch * 8); }
        { const int j = t >> 3, ch = t & 7; const size_t row = (size_t)(base + (dir ? 63 - j : j)); rv = *(const u32x4*)(VB + row * 1024 + hd * 256 + qt * 64 + ch * 8); }
        if (t < 64) { const size_t row = (size_t)(base + (dir ? 63 - t : t)); rig = GT[row * 16 + (2 * dir) * 4 + hd]; rlf = GT[row * 16 + (2 * dir + 1) * 4 + hd]; }
    };
    issue(0);
    LAS unsigned* f8buf = (LAS unsigned*)(lds + ML_F8); f32x4 cvr[8];
    { const int c4 = t & 31, kq = t >> 5; const TileF8 T0 = p0_f8_tile(p, blockIdx.x + NWG * F8_P0); P0F8_LOAD(cvr, T0); }
    __syncthreads();
    for (int st = 0; st < 36; ++st) {
        const bool lat = st >= 4;
        const int base = tokbase(st);
#pragma unroll
        for (int i = 0; i < 2; ++i) { const int id = t + 512 * i, j = id >> 4, ch = id & 15;
            if (lat) *(LAS u32x4*)(lds + ML_QS + j * 272 + ch * 16) = rq[i];
            *(LAS u32x4*)(lds + ML_KS + j * 272 + ch * 16) = rk[i]; }
        { const int j = t >> 3, ch = t & 7; *(LAS u32x4*)(lds + ML_VS + j * 176 + ch * 16) = rv; }
        if (wid == 0) {
            float bc = rlf;
#pragma unroll
            for (int o = 1; o < 64; o <<= 1) { const float n = bperm(bc, lane - o); if (lane >= o) bc += n; }
            const float gtot = bperm(bc, 63);
            const float beta = rig - bc;
            float pm = beta;
#pragma unroll
            for (int o = 1; o < 64; o <<= 1) { const float n = bperm(pm, lane - o); if (lane >= o) pm = fmaxf(pm, n); }
            const float mm = fmaxf(m0, pm);
            const float mloc = gtot + bperm(pm, 63);
            const float mnew = fmaxf(gtot + m0, mloc);
            vec[lane] = -mm; vec[64 + lane] = beta; vec[128 + lane] = __expf(m0 - mm); vec[192 + lane] = __expf(-(bc + mm)); vec[256 + lane] = __expf(gtot + beta - mnew);
            if (lane == 0) vec[320] = __expf(gtot + m0 - mnew);
            m0 = mnew;
        }
        if (st + 1 < 36) issue(st + 1);
        p0_f8_to_lds(cvr, f8buf, t);
        if (st + 1 < F8_MLSTM) { const int c4 = t & 31, kq = t >> 5; const TileF8 Tn = p0_f8_tile(p, blockIdx.x + NWG * (F8_P0 + st + 1)); P0F8_LOAD(cvr, Tn); }
        __syncthreads();
        if (lat) {
            const int jt = wid >> 1, st0 = (2 * wid) & 3;
            bf16x8 Aq[4], Bk[2][4]; float be[2], aj[4];
#pragma unroll
            for (int ks = 0; ks < 4; ++ks) { Aq[ks] = *(const LAS bf16x8*)(lds + ML_QS + (jt * 16 + l15) * 272 + (ks * 32 + 8 * g4) * 2);
#pragma unroll
                for (int ii = 0; ii < 2; ++ii) Bk[ii][ks] = *(const LAS bf16x8*)(lds + ML_KS + ((st0 + ii) * 16 + l15) * 272 + (ks * 32 + 8 * g4) * 2); }
#pragma unroll
            for (int ii = 0; ii < 2; ++ii) be[ii] = vec[64 + (st0 + ii) * 16 + l15];
#pragma unroll
            for (int r = 0; r < 4; ++r) aj[r] = vec[jt * 16 + 4 * g4 + r];
            f32x4 a4[2];
#pragma unroll
            for (int ii = 0; ii < 2; ++ii) { a4[ii] = (f32x4){0.f, 0.f, 0.f, 0.f};
                if (st0 + ii <= jt) {
#pragma unroll
                    for (int ks = 0; ks < 4; ++ks) a4[ii] = __builtin_amdgcn_mfma_f32_16x16x32_bf16(Aq[ks], Bk[ii][ks], a4[ii], 0, 0, 0); } }
#pragma unroll
            for (int ii = 0; ii < 2; ++ii) { const int sp = (st0 + ii) * 16 + l15;
#pragma unroll
                for (int r = 0; r < 4; ++r) { const int jp = jt * 16 + 4 * g4 + r; const float v = (sp <= jp) ? a4[ii][r] * __expf(aj[r] + be[ii]) : 0.f;
                    *(LAS bf16_t*)(lds + ML_SS + jp * 144 + sp * 2) = f2bf(v); } }
        }
        { const int s = t >> 3, ch = t & 7; const float w = vec[256 + s]; const u32x4 vv = *(const LAS u32x4*)(lds + ML_VS + s * 176 + ch * 16); u32x4 o;
          o.x = cvt_pk_bf16(w * bflo(vv.x), w * bfhi(vv.x)); o.y = cvt_pk_bf16(w * bflo(vv.y), w * bfhi(vv.y)); o.z = cvt_pk_bf16(w * bflo(vv.z), w * bfhi(vv.z)); o.w = cvt_pk_bf16(w * bflo(vv.w), w * bfhi(vv.w));
          *(LAS u32x4*)(lds + ML_WVS + s * 176 + ch * 16) = o;
          if (t < 64) *(LAS bf16_t*)(lds + ML_WVS + t * 176 + 128) = f2bf(vec[256 + t]); }
        { const TileF8 Tc = p0_f8_tile(p, blockIdx.x + NWG * (F8_P0 + st)); p0_f8_store(Tc.dst, f8buf, t); }
        __syncthreads();
        TrF k0, k1, w00, w01, w10, w11, w20, w21, w30, w31, w40, w41;
#define ML_WV(vt, ks, f) tr_issue<4 * 176>(ldsb + ML_WVS + ((ks) * 32 + 8 * g4 + q4) * 176 + ((vt) * 16 + 4 * p4) * 2, f)
#define ML_SU_FIRST() do { tr_issue<4 * 272>(ldsb + ML_KS + (0 * 32 + 8 * g4 + q4) * 272 + (wid * 16 + 4 * p4) * 2, k0); tr_issue<4 * 272>(ldsb + ML_KS + (1 * 32 + 8 * g4 + q4) * 272 + (wid * 16 + 4 * p4) * 2, k1); \
            ML_WV(0, 0, w00); ML_WV(0, 1, w01); } while (0)
        if (lat) {
            const int jt = wid >> 1; f32x4 o3[3];
            bf16x8 Aq[4], As[2];
#pragma unroll
            for (int ks = 0; ks < 4; ++ks) Aq[ks] = *(const LAS bf16x8*)(lds + ML_QS + (jt * 16 + l15) * 272 + (ks * 32 + 8 * g4) * 2);
#pragma unroll
            for (int ks = 0; ks < 2; ++ks) As[ks] = *(const LAS bf16x8*)(lds + ML_SS + (jt * 16 + l15) * 144 + (ks * 32 + 8 * g4) * 2);
            TrF cc[2][4], vv[2][2];
#define ML_ISSUE(ti, B) do { const int vt = ((ti) == 2) ? 4 : ((wid & 1) * 2 + (ti)); \
                _Pragma("unroll") for (int ks = 0; ks < 4; ++ks) tr_issue<4 * 176>(ldsb + ML_CS + (ks * 32 + 8 * g4 + q4) * 176 + (vt * 16 + 4 * p4) * 2, cc[B][ks]); \
                _Pragma("unroll") for (int ks = 0; ks < 2; ++ks) tr_issue<4 * 176>(ldsb + ML_VS + (ks * 32 + 8 * g4 + q4) * 176 + (vt * 16 + 4 * p4) * 2, vv[B][ks]); } while (0)
            ML_ISSUE(0, 0);
#pragma unroll
            for (int ti = 0; ti < 3; ++ti) { const int B = ti & 1;
                f32x4 a4 = (f32x4){0.f, 0.f, 0.f, 0.f};
                if (ti + 1 < 3) { ML_ISSUE(ti + 1, (ti + 1) & 1);
                    asm volatile("s_waitcnt lgkmcnt(12)" : TR_W2(cc[B][0]), TR_W2(cc[B][1]), TR_W2(cc[B][2]), TR_W2(cc[B][3]), TR_W2(vv[B][0]), TR_W2(vv[B][1]) :: "memory"); }
                else { ML_SU_FIRST();
                    asm volatile("s_waitcnt lgkmcnt(8)" : TR_W2(cc[B][0]), TR_W2(cc[B][1]), TR_W2(cc[B][2]), TR_W2(cc[B][3]), TR_W2(vv[B][0]), TR_W2(vv[B][1]) :: "memory"); }
                a4 = __builtin_amdgcn_mfma_f32_16x16x32_bf16(Aq[0], tr_val(cc[B][0]), a4, 0, 0, 0); a4 = __builtin_amdgcn_mfma_f32_16x16x32_bf16(Aq[1], tr_val(cc[B][1]), a4, 0, 0, 0);
                a4 = __builtin_amdgcn_mfma_f32_16x16x32_bf16(Aq[2], tr_val(cc[B][2]), a4, 0, 0, 0); a4 = __builtin_amdgcn_mfma_f32_16x16x32_bf16(Aq[3], tr_val(cc[B][3]), a4, 0, 0, 0);
#pragma unroll
                for (int r = 0; r < 4; ++r) a4[r] *= vec[128 + jt * 16 + 4 * g4 + r];
                a4 = __builtin_amdgcn_mfma_f32_16x16x32_bf16(As[0], tr_val(vv[B][0]), a4, 0, 0, 0); a4 = __builtin_amdgcn_mfma_f32_16x16x32_bf16(As[1], tr_val(vv[B][1]), a4, 0, 0, 0);
                o3[ti] = a4; }
#undef ML_ISSUE
            float inv[4];
#pragma unroll
            for (int r = 0; r < 4; ++r) { const float dn = bperm(o3[2][r], lane & 48); inv[r] = 1.0f / fmaxf(fabsf(dn), vec[192 + jt * 16 + 4 * g4 + r]); }
#pragma unroll
            for (int ti = 0; ti < 2; ++ti) { const int vt = (wid & 1) * 2 + ti;
#pragma unroll
                for (int r = 0; r < 4; ++r) { const int jp = jt * 16 + 4 * g4 + r; *(LAS bf16_t*)(lds + ML_HS + jp * 144 + (vt * 16 + l15) * 2) = f2bf(o3[ti][r] * inv[r]); } }
        }
        { const float sprev = vec[320];
          if (!lat) ML_SU_FIRST();
          ML_WV(1, 0, w10); ML_WV(1, 1, w11); ML_WV(2, 0, w20); ML_WV(2, 1, w21); ML_WV(3, 0, w30); ML_WV(3, 1, w31); ML_WV(4, 0, w40); ML_WV(4, 1, w41);
#pragma unroll
          for (int vt = 0; vt < 5; ++vt) accC[vt] *= sprev;
          asm volatile("s_waitcnt lgkmcnt(15)" : TR_W2(k0), TR_W2(k1), TR_W2(w00), TR_W2(w01) :: "memory");
          const bf16x8 K0 = tr_val(k0), K1 = tr_val(k1);
          accC[0] = __builtin_amdgcn_mfma_f32_16x16x32_bf16(tr_val(w00), K0, accC[0], 0, 0, 0); accC[0] = __builtin_amdgcn_mfma_f32_16x16x32_bf16(tr_val(w01), K1, accC[0], 0, 0, 0);
          TR_WAIT2(w10, w11); TR_WAIT4(w20, w21, w30, w31); TR_WAIT2(w40, w41);
          accC[1] = __builtin_amdgcn_mfma_f32_16x16x32_bf16(tr_val(w10), K0, accC[1], 0, 0, 0); accC[1] = __builtin_amdgcn_mfma_f32_16x16x32_bf16(tr_val(w11), K1, accC[1], 0, 0, 0);
          accC[2] = __builtin_amdgcn_mfma_f32_16x16x32_bf16(tr_val(w20), K0, accC[2], 0, 0, 0); accC[2] = __builtin_amdgcn_mfma_f32_16x16x32_bf16(tr_val(w21), K1, accC[2], 0, 0, 0);
          accC[3] = __builtin_amdgcn_mfma_f32_16x16x32_bf16(tr_val(w30), K0, accC[3], 0, 0, 0); accC[3] = __builtin_amdgcn_mfma_f32_16x16x32_bf16(tr_val(w31), K1, accC[3], 0, 0, 0);
          accC[4] = __builtin_amdgcn_mfma_f32_16x16x32_bf16(tr_val(w40), K0, accC[4], 0, 0, 0); accC[4] = __builtin_amdgcn_mfma_f32_16x16x32_bf16(tr_val(w41), K1, accC[4], 0, 0, 0); }
#undef ML_SU_FIRST
#undef ML_WV
        __syncthreads();
        if (lat) { const int j = t >> 3, ch = t & 7; const size_t row = (size_t)(base + (dir ? 63 - j : j)); *(u32x4*)(HB + row * 1024 + hd * 256 + qt * 64 + ch * 8) = *(const LAS u32x4*)(lds + ML_HS + j * 144 + ch * 16); }
#pragma unroll
        for (int vt = 0; vt < 5; ++vt) { u32x2 w; w.x = cvt_pk_bf16(accC[vt][0], accC[vt][1]); w.y = cvt_pk_bf16(accC[vt][2], accC[vt][3]);
            *(LAS u32x2*)(lds + ML_CS + (wid * 16 + l15) * 176 + (vt * 16 + 4 * g4) * 2) = w; }
    }
    __syncthreads();
}

#define HM_LOAD(HA, HB, OW, row) do { _Pragma("unroll") for (int hd = 0; hd < 4; ++hd) { const int col = hd * 256 + lane * 4; \
        HA[hd] = *(const u32x2*)(H0 + (size_t)(row) * 1024 + col); HB[hd] = *(const u32x2*)(H1 + (size_t)(row) * 1024 + col); OW[hd] = *(const u32x2*)(O + (size_t)(row) * 1024 + col); } } while (0)
#define HM_COMPUTE(HA, HB, OW, row) do { _Pragma("unroll") for (int hd = 0; hd < 4; ++hd) { const int col = hd * 256 + lane * 4; const u32x2 ha = HA[hd], hb = HB[hd], ow = OW[hd]; \
        const f32x4 h = (f32x4){bflo(ha.x) + bflo(hb.x), bfhi(ha.x) + bfhi(hb.x), bflo(ha.y) + bflo(hb.y), bfhi(ha.y) + bfhi(hb.y)}; \
        const float ss = wave_sum(h[0] * h[0] + h[1] * h[1] + h[2] * h[2] + h[3] * h[3], lane); \
        const float rstd = rsqrtf(ss * (1.0f / 256.0f) + 1e-6f); \
        const float o0 = h[0] * rstd * gg[hd][0] * sigmoidf_(bflo(ow.x)), o1 = h[1] * rstd * gg[hd][1] * sigmoidf_(bfhi(ow.x)), o2 = h[2] * rstd * gg[hd][2] * sigmoidf_(bflo(ow.y)), o3 = h[3] * rstd * gg[hd][3] * sigmoidf_(bfhi(ow.y)); \
        *(unsigned*)(CAT + (size_t)(row) * 2048 + col) = cvt4_fp8_sat(o0 * FP8_ASCALE, o1 * FP8_ASCALE, o2 * FP8_ASCALE, o3 * FP8_ASCALE); } } while (0)
__device__ __forceinline__ void phase_hmerge(const Params& p, int wv) {
    const int t = make_tid(wv);
    const int lane = t & 63, row0 = blockIdx.x * 64 + wv * 8;
    const bf16_t* H0 = (const bf16_t*)(p.ws + WS_HBUF); const bf16_t* H1 = H0 + (size_t)NLAT * 1024;
    const bf16_t* O = (const bf16_t*)(p.ws + WS_OBUF); unsigned char* CAT = p.ws + WS_CAT;
    f32x4 gg[4];
#pragma unroll
    for (int hd = 0; hd < 4; ++hd) gg[hd] = *(const f32x4*)(p.head_g + hd * 256 + lane * 4);
    u32x2 a0[4], b0[4], o0v[4], a1[4], b1[4], o1v[4];
    HM_LOAD(a0, b0, o0v, row0);
#pragma unroll 1
    for (int i = 0; i < 8; i += 2) {
        HM_LOAD(a1, b1, o1v, row0 + i + 1);
        HM_COMPUTE(a0, b0, o0v, row0 + i);
        if (i + 2 < 8) HM_LOAD(a0, b0, o0v, row0 + i + 2);
        HM_COMPUTE(a1, b1, o1v, row0 + i + 1);
    }
}
constexpr int RT_XR = 0, RT_XSTRIDE = 4112, RT_RED = 16 * RT_XSTRIDE  , RT_LG = RT_RED + 8 * 16 * 32 * 4  , RT_RSTD = RT_LG + 64 * 33 * 4  , RT_SEL = RT_RSTD + 64, RT_CG = RT_SEL + 4096  , RT_SH = RT_CG + 8192;
__device__ __forceinline__ void phase_router(const Params& p, LAS unsigned char* lds, int wv) {
    const int t = make_tid(wv);
    const int lane = t & 63, wid = wv, l15 = lane & 15, g4 = lane >> 4;
    const bf16_t* X1 = (const bf16_t*)(p.ws + WS_X1); unsigned char* U2 = p.ws + WS_U2; const bf16_t* WRT = (const bf16_t*)(p.ws + WS_WRT);
    LAS float* red = (LAS float*)(lds + RT_RED); LAS float* lg = (LAS float*)(lds + RT_LG); LAS float* rstd = (LAS float*)(lds + RT_RSTD);
    LAS int* se = (LAS int*)(lds + RT_SEL); LAS float* sp = (LAS float*)(lds + RT_SEL + 1024); LAS int* sr = (LAS int*)(lds + RT_SEL + 2048); LAS int* lc = (LAS int*)(lds + RT_SEL + 3072); LAS int* lbase = lc + 32;
    LAS float* cg = (LAS float*)(lds + RT_CG); LAS float* shl = (LAS float*)(lds + RT_SH);
    const int bidx = blockIdx.x >> 5;
    const float* mod = (const float*)(p.ws + WS_MOD) + (size_t)bidx * 12288; const float* sh2 = mod + 3 * 2048; const float* sc2 = mod + 4 * 2048;
    if (t < 32) lc[t] = 0;
    { const int c = t * 4; const f32x4 g = *(const f32x4*)(p.norm2_g + c), sv = *(const f32x4*)(sc2 + c), hv = *(const f32x4*)(sh2 + c); *(LAS f32x4*)(cg + c) = g * (sv + 1.0f); *(LAS f32x4*)(shl + c) = hv; }
    const int pr = t >> 8, pc = t & 255;
    u32x4 pre[8];
#pragma unroll
    for (int i = 0; i < 8; ++i) pre[i] = *(const u32x4*)(X1 + (size_t)(blockIdx.x * 64 + pr + 2 * i) * 2048 + pc * 8);
#pragma unroll 1
    for (int it = 0; it < 4; ++it) {
        const int row0 = blockIdx.x * 64 + it * 16;
#pragma unroll
        for (int i = 0; i < 8; ++i) *(LAS u32x4*)(lds + RT_XR + (pr + 2 * i) * RT_XSTRIDE + pc * 16) = pre[i];
        __syncthreads();
        if (it < 3) {
#pragma unroll
            for (int i = 0; i < 8; ++i) pre[i] = *(const u32x4*)(X1 + (size_t)(row0 + 16 + pr + 2 * i) * 2048 + pc * 8); }
#pragma unroll
        for (int rr = 0; rr < 2; ++rr) { const int r = wid * 2 + rr; float ss = 0.f;
#pragma unroll
            for (int i = 0; i < 4; ++i) { const u32x4 v = *(const LAS u32x4*)(lds + RT_XR + r * RT_XSTRIDE + (i * 64 + lane) * 16);
                ss += bflo(v.x) * bflo(v.x) + bfhi(v.x) * bfhi(v.x) + bflo(v.y) * bflo(v.y) + bfhi(v.y) * bfhi(v.y) + bflo(v.z) * bflo(v.z) + bfhi(v.z) * bfhi(v.z) + bflo(v.w) * bflo(v.w) + bfhi(v.w) * bfhi(v.w); }
            ss = wave_sum(ss, lane); if (lane == 0) rstd[r] = rsqrtf(ss * (1.0f / 2048.0f) + 1e-6f); }
        __syncthreads();
        f32x4 acc[2]; acc[0] = (f32x4){0.f, 0.f, 0.f, 0.f}; acc[1] = acc[0];
        const float rs = rstd[l15];
        bf16x8 Bc[4], Bn[4]; u32x2 f8w[8];
#define RT_LOADB(B, s_) do { const int _k0 = wid * 256 + (s_) * 32 + 8 * g4; _Pragma("unroll") for (int nt = 0; nt < 2; ++nt) { \
            B[nt * 2] = *(const bf16x8*)(WRT + (size_t)(nt * 16 + l15) * 2048 + _k0); B[nt * 2 + 1] = *(const bf16x8*)(WRT + (size_t)(32 + nt * 16 + l15) * 2048 + _k0); } } while (0)
        RT_LOADB(Bc, 0);
#pragma unroll
        for (int s = 0; s < 8; ++s) { const int k0 = wid * 256 + s * 32 + 8 * g4;
            if (s + 1 < 8) RT_LOADB(Bn, s + 1);
            const u32x4 xw = *(const LAS u32x4*)(lds + RT_XR + l15 * RT_XSTRIDE + k0 * 2);
            const f32x4 x0 = (f32x4){bflo(xw.x), bfhi(xw.x), bflo(xw.y), bfhi(xw.y)}, x1 = (f32x4){bflo(xw.z), bfhi(xw.z), bflo(xw.w), bfhi(xw.w)};
            const f32x4 ca = *(const LAS f32x4*)(cg + k0), cb = *(const LAS f32x4*)(cg + k0 + 4), ha = *(const LAS f32x4*)(shl + k0), hb = *(const LAS f32x4*)(shl + k0 + 4);
            const f32x4 u0 = x0 * rs * ca + ha, u1 = x1 * rs * cb + hb;
            u32x4 hi; hi.x = cvt_pk_bf16(u0[0], u0[1]); hi.y = cvt_pk_bf16(u0[2], u0[3]); hi.z = cvt_pk_bf16(u1[0], u1[1]); hi.w = cvt_pk_bf16(u1[2], u1[3]);
            f8w[s].x = cvt4_fp8_sat(u0[0] * FP8_ASCALE, u0[1] * FP8_ASCALE, u0[2] * FP8_ASCALE, u0[3] * FP8_ASCALE); f8w[s].y = cvt4_fp8_sat(u1[0] * FP8_ASCALE, u1[1] * FP8_ASCALE, u1[2] * FP8_ASCALE, u1[3] * FP8_ASCALE);
            u32x4 lo; lo.x = cvt_pk_bf16(u0[0] - bflo(hi.x), u0[1] - bfhi(hi.x)); lo.y = cvt_pk_bf16(u0[2] - bflo(hi.y), u0[3] - bfhi(hi.y));
            lo.z = cvt_pk_bf16(u1[0] - bflo(hi.z), u1[1] - bfhi(hi.z)); lo.w = cvt_pk_bf16(u1[2] - bflo(hi.w), u1[3] - bfhi(hi.w));
            bf16x8 Ah, Al; __builtin_memcpy(&Ah, &hi, 16); __builtin_memcpy(&Al, &lo, 16);
#pragma unroll
            for (int nt = 0; nt < 2; ++nt) { const bf16x8 Bh = Bc[nt * 2], Bl = Bc[nt * 2 + 1];
                acc[nt] = __builtin_amdgcn_mfma_f32_16x16x32_bf16(Ah, Bh, acc[nt], 0, 0, 0); acc[nt] = __builtin_amdgcn_mfma_f32_16x16x32_bf16(Ah, Bl, acc[nt], 0, 0, 0); acc[nt] = __builtin_amdgcn_mfma_f32_16x16x32_bf16(Al, Bh, acc[nt], 0, 0, 0); }
#pragma unroll
            for (int q = 0; q < 4; ++q) Bc[q] = Bn[q]; }
#undef RT_LOADB
#pragma unroll
        for (int s = 0; s < 8; ++s) *(u32x2*)(U2 + (size_t)(row0 + l15) * 2048 + wid * 256 + s * 32 + 8 * g4) = f8w[s];
#pragma unroll
        for (int nt = 0; nt < 2; ++nt)
#pragma unroll
            for (int r = 0; r < 4; ++r) red[(wid * 16 + 4 * g4 + r) * 32 + nt * 16 + l15] = acc[nt][r];
        __syncthreads();
        { const int tok = t >> 5, e = t & 31; float s = p.b_router[e];
#pragma unroll
          for (int w = 0; w < 8; ++w) s += red[(w * 16 + tok) * 32 + e];
          lg[(it * 16 + tok) * 33 + e] = s; }
    }
    __syncthreads();
    if (t < 64) { float v[4]; int ix[4];
#pragma unroll
        for (int k = 0; k < 4; ++k) { float best = -3.0e38f; int bi = 0;
            for (int e = 0; e < 32; ++e) { const float x = lg[t * 33 + e]; bool taken = false;
#pragma unroll
                for (int k2 = 0; k2 < 4; ++k2) taken = taken || (k2 < k && ix[k2] == e);
                if (!taken && x > best) { best = x; bi = e; } }
            v[k] = best; ix[k] = bi; }
        const float e1 = __expf(v[1] - v[0]), e2 = __expf(v[2] - v[0]), e3 = __expf(v[3] - v[0]), inv = 1.0f / (1.0f + e1 + e2 + e3);
        se[t * 4 + 0] = ix[0]; se[t * 4 + 1] = ix[1]; se[t * 4 + 2] = ix[2]; se[t * 4 + 3] = ix[3];
        sp[t * 4 + 0] = inv; sp[t * 4 + 1] = e1 * inv; sp[t * 4 + 2] = e2 * inv; sp[t * 4 + 3] = e3 * inv; }
    __syncthreads();
    if (t < 256) sr[t] = atomicAdd((int*)&lc[se[t]], 1);
    __syncthreads();
    if (t < 32) lbase[t] = (int)atomicAdd((unsigned*)(p.ws + WS_CTRL + CTRL_CNT) + t, (unsigned)lc[t]);
    __syncthreads();
    if (t < 256) { const int e = se[t], pos = lbase[e] + sr[t], tok = blockIdx.x * 64 + (t >> 2);
        ((int*)(p.ws + WS_LIST))[e * 16384 + pos] = tok; ((float*)(p.ws + WS_LPROB))[tok * 4 + (t & 3)] = sp[t];
        ((int*)(p.ws + WS_TKE))[tok * 4 + (t & 3)] = e; ((int*)(p.ws + WS_TKP))[tok * 4 + (t & 3)] = pos; }
    __syncthreads();
}

__device__ __forceinline__ MoeTables moe_tables(const Params& p, LAS unsigned char* lds_tab, int wv) {
    const int t = make_tid(wv);
    LAS int* tp = (LAS int*)lds_tab; LAS int* cnt = tp + 64;
    const unsigned* gc = (const unsigned*)(p.ws + WS_CTRL + CTRL_CNT);
    if (t < 64) {
        const int cv = t < 32 ? (int)__hip_atomic_load(gc + t, __ATOMIC_RELAXED, __HIP_MEMORY_SCOPE_AGENT) : 0;
        int inc = (cv + 255) >> 8;
#pragma unroll
        for (int o = 1; o < 32; o <<= 1) { const int n = __builtin_amdgcn_ds_bpermute((t - o) << 2, inc); if (t >= o) inc += n; }
        if (t < 32) { cnt[t] = cv; tp[t] = inc - ((cv + 255) >> 8); }
        if (t == 31) tp[32] = inc; }
    __syncthreads();
    MoeTables T; T.tp = tp; T.cnt = cnt; T.rows = (LAS const unsigned short*)(tp + 128); T.bias = (LAS const unsigned char*)(tp + 128) + 9216; T.utab = tp + 128 + 18 * 256; return T;
}
template <class Sched> __device__ __forceinline__ void moe_unit_table(const Sched& S, const MoeTables& T, int wv) {
    const int t = make_tid(wv); __syncthreads();
    if (t < 36) { int o[5]; if (S.decode(t, o)) { LAS int* r = (LAS int*)T.utab + t * 8; r[0] = o[0]; r[1] = o[1]; r[2] = o[2]; r[3] = o[3]; r[4] = o[4]; } }
    __syncthreads();
}
template <class Sched> __device__ __forceinline__ void moe_rows_preload(const Params& p, const Sched& S, const MoeTables& T, int wv) {
    const int t = make_tid(wv); LAS unsigned short* rows = (LAS unsigned short*)T.rows; LAS bf16_t* bias = (LAS bf16_t*)T.bias;
    int lv[9]; float bv[9];
#pragma unroll
    for (int j = 0; j < 9; ++j) { const int i = t + NTHR * j, ui = i >> 8, tt = i & 255; LAS const int* r = T.utab + ui * 8;
        const bool ok = ui * NWG + S.c < S.nwg; const int g = ok ? r[0] : 0, pm = ok ? r[1] : 0, pn = ok ? r[2] : 0, cn = ok ? r[4] : 0, q = pm * 256 + tt;
        lv[j] = (q < cn) ? ((const int*)(p.ws + WS_LIST))[g * 16384 + q] : 0;
        bv[j] = p.b_gu[(size_t)g * 4096 + (tt < 128 ? 0 : 2048 - 128) + pn * 128 + tt]; }
#pragma unroll
    for (int j = 0; j < 9; ++j) { const int i = t + NTHR * j; rows[i] = (unsigned short)lv[j]; bias[i] = f2bf(bv[j]); }
    __syncthreads();
}
template <class Sched> __device__ __forceinline__ void moe_bias_preload2(const Params& p, const Sched& S, const MoeTables& T, int wv) {
    const int t = make_tid(wv); LAS float* bias = (LAS float*)T.rows;
    float bv[5];
#pragma unroll
    for (int j = 0; j < 5; ++j) { const int i = t + NTHR * j, ui = i >> 8, tt = i & 255; LAS const int* r = T.utab + ui * 8;
        const bool ok = ui < 9 && ui * NWG + S.c < S.nwg; const int g = ok ? r[0] : 0, pn = ok ? r[2] : 0;
        bv[j] = p.b_down[(size_t)g * 2048 + pn * 256 + tt]; }
#pragma unroll
    for (int j = 0; j < 5; ++j) { const int i = t + NTHR * j; if (i < 9 * 256) bias[i] = bv[j]; }
    __syncthreads();
}

#define FIN_LOAD(W, X, PK, row) do { \
    _Pragma("unroll") for (int k = 0; k < 4; ++k) { const int e = tke[(row) * 4 + k], pos = tkp[(row) * 4 + k]; const size_t sr = (size_t)(T.tp[e] * 256 + pos) * 2048; PK[k] = lpk[(row) * 4 + k] * (1.0f / FP8_YSCALE); \
        _Pragma("unroll") for (int j = 0; j < 4; ++j) W[k][j] = *(const u32x2*)(O2 + sr + (j * 2 + (lane >> 5)) * 256 + (lane & 15) * 16 + ((lane >> 4) & 1) * 8); } \
    _Pragma("unroll") for (int j = 0; j < 4; ++j) { const int col = (j * 64 + lane) * 8; X[j] = *(const u32x4*)(X1 + (size_t)(row) * 2048 + col); } } while (0)
#define FIN_COMPUTE(W, X, PK, row) do { \
    f32x4 v[4][2]; float ss = 0.f; \
    _Pragma("unroll") for (int j = 0; j < 4; ++j) { const int col = (j * 64 + lane) * 8; f32x4 m0 = (f32x4){0.f, 0.f, 0.f, 0.f}, m1 = m0; \
        _Pragma("unroll") for (int k = 0; k < 4; ++k) { const u32x2 w = W[k][j]; const float pk = PK[k]; \
            const f32x2 a0 = __builtin_amdgcn_cvt_pk_f32_fp8((int)w.x, false), a1 = __builtin_amdgcn_cvt_pk_f32_fp8((int)w.x, true), a2 = __builtin_amdgcn_cvt_pk_f32_fp8((int)w.y, false), a3 = __builtin_amdgcn_cvt_pk_f32_fp8((int)w.y, true); \
            m0[0] += pk * a0[0]; m0[1] += pk * a0[1]; m0[2] += pk * a1[0]; m0[3] += pk * a1[1]; \
            m1[0] += pk * a2[0]; m1[1] += pk * a2[1]; m1[2] += pk * a3[0]; m1[3] += pk * a3[1]; } \
        const f32x4 g0 = GG[j][0], g1 = GG[j][1]; \
        v[j][0] = (f32x4){bflo(X[j].x), bfhi(X[j].x), bflo(X[j].y), bfhi(X[j].y)} + g0 * m0; v[j][1] = (f32x4){bflo(X[j].z), bfhi(X[j].z), bflo(X[j].w), bfhi(X[j].w)} + g1 * m1; \
        _Pragma("unroll") for (int e = 0; e < 4; ++e) ss += v[j][0][e] * v[j][0][e] + v[j][1][e] * v[j][1][e]; } \
    ss = wave_sum(ss, lane); const float rstd = rsqrtf(ss * (1.0f / 2048.0f) + 1e-6f); \
    _Pragma("unroll") for (int j = 0; j < 4; ++j) { const int col = (j * 64 + lane) * 8; const f32x4 f0 = FG[j][0], f1 = FG[j][1]; \
        *(f32x4*)(p.out + (size_t)(row) * 2048 + col) = v[j][0] * rstd * f0; *(f32x4*)(p.out + (size_t)(row) * 2048 + col + 4) = v[j][1] * rstd * f1; } } while (0)
__device__ __forceinline__ void phase_final(const Params& p, const MoeTables& T, int wv) {
    const int t = make_tid(wv);
    const int lane = t & 63, wid = t >> 6, row0 = blockIdx.x * 64 + wid * 8;
    const bf16_t* X1 = (const bf16_t*)(p.ws + WS_X1); const unsigned char* O2 = p.ws + WS_OUT2; const float* lpk = (const float*)(p.ws + WS_LPROB);
    const int* tke = (const int*)(p.ws + WS_TKE); const int* tkp = (const int*)(p.ws + WS_TKP);
    f32x4 GG[4][2], FG[4][2];
    { const float* g2 = (const float*)(p.ws + WS_MOD) + (size_t)(row0 >> 11) * 12288 + 5 * 2048;
#pragma unroll
      for (int j = 0; j < 4; ++j) { const int col = (j * 64 + lane) * 8; GG[j][0] = *(const f32x4*)(g2 + col); GG[j][1] = *(const f32x4*)(g2 + col + 4); FG[j][0] = *(const f32x4*)(p.final_g + col); FG[j][1] = *(const f32x4*)(p.final_g + col + 4); } }
    u32x2 wa[4][4], wb[4][4]; u32x4 xa[4], xb[4]; float pa[4], pb[4];
    FIN_LOAD(wa, xa, pa, row0);
#pragma unroll 1
    for (int i = 0; i < 8; i += 2) {
        FIN_LOAD(wb, xb, pb, row0 + i + 1);
        FIN_COMPUTE(wa, xa, pa, row0 + i);
        if (i + 2 < 8) FIN_LOAD(wa, xa, pa, row0 + i + 2);
        FIN_COMPUTE(wb, xb, pb, row0 + i + 1);
    }
}
#ifndef DEV_STAGE
#define DEV_STAGE 9
#endif
#ifndef MOE_ALIGN
#define MOE_ALIGN true
#endif
#ifndef DBL
#define DBL -1
#endif
#define REP(k) for (int _rep = 0; _rep < ((DBL == (k)) ? 2 : 1); ++_rep)
__device__ __forceinline__ void phase_final_simple(const Params& p, const float* src, int wv) {
    const int t = make_tid(wv), lane = t & 63, wid = t >> 6;
    for (int i = 0; i < 8; ++i) { const int row = blockIdx.x * 64 + wid * 8 + i; f32x4 v[8]; float ss = 0.f;
#pragma unroll
        for (int j = 0; j < 8; ++j) { v[j] = *(const f32x4*)(src + (size_t)row * 2048 + (j * 64 + lane) * 4); ss += v[j][0] * v[j][0] + v[j][1] * v[j][1] + v[j][2] * v[j][2] + v[j][3] * v[j][3]; }
        ss = wave_sum(ss, lane); const float rstd = rsqrtf(ss * (1.0f / 2048.0f) + 1e-6f);
#pragma unroll
        for (int j = 0; j < 8; ++j) { const int col = (j * 64 + lane) * 4; *(f32x4*)(p.out + (size_t)row * 2048 + col) = v[j] * rstd * *(const f32x4*)(p.final_g + col); } }
}

__global__ void __launch_bounds__(512, 2) fwd_kernel(Params p) {
    extern __shared__ __attribute__((aligned(16))) unsigned char smem[];
    LAS unsigned char* lds = (LAS unsigned char*)smem;
    volatile LAS unsigned* xbw = (volatile LAS unsigned*)(lds + LDS_BYTES - 16);
    const int wv = __builtin_amdgcn_readfirstlane(threadIdx.x >> 6);
    const bool t0 = (wv == 0 && lane_id() == 0);
    if (t0) { xbw[0] = 0u; xbw[1] = 0u; xbw[2] = 0u; xbw[3] = 0u; }
    __syncthreads();
    XcdBarrier bar = xcd_barrier_post((unsigned*)(p.ws + WS_CTRL), xbw, t0);
    const int c = blockIdx.x;

    phase0(p, lds, wv);
#if DBL == 0
    phase0(p, lds, wv);
#elif DBL > 1000
    phase0<DBL - 1000>(p, lds, wv);
#endif
    xcd_barrier(bar, wv);
    REP(1) phase1(p, lds, wv);
    xcd_barrier(bar, wv);
#if DEV_STAGE == 1
    phase_final_simple(p, p.x, wv);
#else
    if (c < G_INPROJ) { SchedInProj S; S.ws = p.ws; S.c = c; EpiInProj E; E.ws = p.ws; pg8::gemm_phase<EpiInProj, SchedInProj, INPROJ_FP8 ? 1024 : 2048, INPROJ_FP8 ? 1024 : 2048, false, INPROJ_FP8 != 0>(lds, S, E, wv); }
#ifndef STEAL
#define STEAL 1
#endif
#if STEAL
    p0_f8_steal(p, (LAS unsigned*)lds, (LAS unsigned*)(lds + 150000), make_tid(wv), F8_P0 * NWG);
#else
    if (c >= G_INPROJ) { const int first = c - G_INPROJ, stride = NWG - G_INPROJ; p0_f8_range(p, (LAS unsigned*)lds, make_tid(wv), first, stride, (F8_P0 * NWG - first + stride - 1) / stride); }
#endif
    xcd_barrier(bar, wv);
    REP(3) { { SchedS5V S; S.ws = p.ws; S.c = c; EpiS5V E; E.ws = p.ws; pg8::gemm_phase<EpiS5V, SchedS5V, 256, 512, false>(lds, S, E, wv); }
    phase_conv(p, lds, wv); }
#if DBL == 31
    { SchedS5V S; S.ws = p.ws; S.c = c; EpiS5V E; E.ws = p.ws; pg8::gemm_phase<EpiS5V, SchedS5V, 256, 512, false>(lds, S, E, wv); }
#elif DBL == 32
    phase_conv(p, lds, wv);
#endif
    xcd_barrier(bar, wv);
#if DEV_STAGE >= 3
    phase_s5scan(p, wv);
    phase_mlstm(p, lds, wv);
#if DBL == 4
    phase_s5scan(p, wv); phase_mlstm(p, lds, wv);
#endif
#endif
    xcd_barrier(bar, wv);
    REP(5) { { SchedS5Y S; S.ws = p.ws; S.c = c; EpiS5Y E; E.ws = p.ws; E.s5_d = p.s5_d; pg8::gemm_phase<EpiS5Y, SchedS5Y, 512, 512, false>(lds, S, E, wv); }
    phase_hmerge(p, wv); }
#if DBL == 51
    { SchedS5Y S; S.ws = p.ws; S.c = c; EpiS5Y E; E.ws = p.ws; E.s5_d = p.s5_d; pg8::gemm_phase<EpiS5Y, SchedS5Y, 512, 512, false>(lds, S, E, wv); }
#elif DBL == 52
    phase_hmerge(p, wv);
#endif
    xcd_barrier(bar, wv);
    REP(6) { SchedStatic<4> S; S.A = (const char*)(p.ws + WS_SBUF); S.Bt = (const char*)(p.ws + WS_WGLU_T); S.c = c; S.a_tile_bytes = (size_t)256 * 32; S.b_tile_bytes = (size_t)256 * 1024 * 2;
      EpiGLU E; E.ws = p.ws; pg8::gemm_phase<EpiGLU, SchedStatic<4>, 1024, 1024, false, false, 0, true, true>(lds, S, E, wv); }
    xcd_barrier(bar, wv);
    REP(7) { SchedStatic<8> S; S.A = (const char*)(p.ws + WS_CAT); S.Bt = (const char*)(p.ws + WS_WOUT_T); S.c = c; S.a_tile_bytes = (size_t)256 * 2048; S.b_tile_bytes = (size_t)256 * 2048;
      EpiOut E; E.ws = p.ws; E.x = p.x; pg8::gemm_phase<EpiOut, SchedStatic<8>, 1024, 1024, false, true>(lds, S, E, wv); }
#if DBL == 70 || DBL == 71
    xcd_barrier(bar, wv);
    { SchedProbe<8, DBL == 71> S; S.A = (const char*)(p.ws + WS_CAT); S.Bt = (const char*)(p.ws + WS_WOUT_T); S.c = c; S.a_tile_bytes = (size_t)256 * 2048; S.b_tile_bytes = (size_t)256 * 2048;
      EpiOutDummy E; E.ws = p.ws; E.x = p.x; pg8::gemm_phase<EpiOutDummy, SchedProbe<8, DBL == 71>, 1024, 1024, false, true>(lds, S, E, wv); }
#endif
    xcd_barrier(bar, wv);
#if DEV_STAGE < 9
    phase_final_simple(p, (const float*)(p.ws + WS_X1), wv);
#else
    phase_router(p, lds, wv);
    xcd_barrier(bar, wv);
    const MoeTables T = moe_tables(p, lds + 139264, wv);
    { SchedMoE<16> S; S.ws = p.ws; S.c = c; S.T = T; S.A = (const char*)(p.ws + WS_U2); S.Bt = (const char*)(p.ws + WS_WGU_T); S.b_expert_bytes = (size_t)4096 * 2048; S.nwg = __builtin_amdgcn_readfirstlane(T.tp[32]) * 16; moe_unit_table(S, T, wv); moe_rows_preload(p, S, T, wv);
      EpiMoE1 E; E.ws = p.ws; E.b_gu = p.b_gu; E.T = T; pg8::gemm_phase<EpiMoE1, SchedMoE<16>, 1024, 1024, true, true, 0, MOE_ALIGN>(lds, S, E, wv); }
#if DBL == 9
    { SchedMoE<16> S; S.ws = p.ws; S.c = c; S.T = T; S.A = (const char*)(p.ws + WS_U2); S.Bt = (const char*)(p.ws + WS_WGU_T); S.b_expert_bytes = (size_t)4096 * 2048; S.nwg = __builtin_amdgcn_readfirstlane(T.tp[32]) * 16; moe_unit_table(S, T, wv); moe_rows_preload(p, S, T, wv);
      EpiMoE1 E; E.ws = p.ws; E.b_gu = p.b_gu; E.T = T; pg8::gemm_phase<EpiMoE1, SchedMoE<16>, 1024, 1024, true, true, 0, MOE_ALIGN>(lds, S, E, wv); }
#endif
    xcd_barrier(bar, wv);
    REP(10) { SchedMoE2 S; S.ws = p.ws; S.c = c; S.T = T; S.A = (const char*)(p.ws + WS_HID); S.Bt = (const char*)(p.ws + WS_WDN_T); S.b_expert_bytes = (size_t)2048 * 2048; S.nwg = __builtin_amdgcn_readfirstlane(T.tp[32]) * 8; moe_unit_table(S, T, wv); moe_bias_preload2(p, S, T, wv);
      EpiMoE2 E; E.ws = p.ws; E.b_down = p.b_down; E.T = T; E.T.bias = (LAS const unsigned char*)T.rows; pg8::gemm_phase<EpiMoE2, SchedMoE2, 1024, 1024, false, true, 1, MOE_ALIGN>(lds, S, E, wv, (float*)(p.ws + WS_CTRL + 32768)); }
    xcd_barrier(bar, wv);
    REP(11) phase_final(p, T, wv);
#if PROBE_GEMM == 1
    xcd_barrier(bar, wv);
    { const float* dg = (const float*)(p.ws + WS_CTRL + 32768); const float A = dg[PROBE_A], B = dg[PROBE_B]; for (size_t i = (size_t)blockIdx.x * NTHR + make_tid(wv); i < (size_t)NLAT * D; i += (size_t)NWG * NTHR) p.out[i] = (i == 0) ? A : B; }
#endif
#endif
#endif
}

extern "C" void kernel_launch(void* const* d_in, const int* in_sizes, int n_in, void* d_out, int out_size, void* d_ws, size_t ws_size, hipStream_t stream) {
    static int ready = 0;
    if (ready == 0) {
        if (n_in != 29 || out_size != NLAT * D || ws_size < WS_END) { fprintf(stderr, "kernel_launch: unexpected shapes (n_in %d out %d ws %zu need %zu)\n", n_in, out_size, ws_size, (size_t)WS_END); ready = -1; return; }
        if (hipFuncSetAttribute((const void*)fwd_kernel, hipFuncAttributeMaxDynamicSharedMemorySize, LDS_BYTES) != hipSuccess) { fprintf(stderr, "kernel_launch: hipFuncSetAttribute failed\n"); ready = -1; return; }
        ready = 1;
    }
    if (ready < 0) return;
    (void)hipMemsetAsync((char*)d_ws + WS_CTRL, 0, CTRL_BYTES, stream);
    Params p;
    memset(&p, 0, sizeof(p));
    const float** f = (const float**)&p;
    for (int i = 0; i < 29; ++i) f[i] = (const float*)d_in[i];
    p.out = (float*)d_out; p.ws = (unsigned char*)d_ws;
    hipLaunchKernelGGL(fwd_kernel, dim3(NWG), dim3(NTHR), LDS_BYTES, stream, p);
}
```
